# Optimizing an MI355X kernel written in HIP

```python
import math
import jax, jax.numpy as jnp
from jax import lax
import numpy as np

D_MODEL = 2048
BATCH = 2
SEQ = 8192
DEPTH = 2

N_A_LAYERS = DEPTH // 2
N_B_LAYERS = DEPTH - N_A_LAYERS

S5_GROUP = 16
S5_GROUPS = D_MODEL // S5_GROUP
S5_STATE = 64

NSA_HEADS = 16
NSA_HEAD_DIM = D_MODEL // NSA_HEADS
NSA_KV_HEADS = 4
NSA_REP = NSA_HEADS // NSA_KV_HEADS
CMP_LEN = 32
CMP_STRIDE = 16
SEL_LEN = 64
SEL_TOPN = 16
WINDOW = 512
Q_BLOCK = 128
N_GATES = 3
N_KV_SLOTS = 6

MEM_TOKENS = 256
MEM_HEADS = 4
MEM_HEAD_DIM = D_MODEL // MEM_HEADS

D_FF = 4 * D_MODEL

DN_ALPHA = float((2 * DEPTH) ** 0.25)
DN_BETA = float((8 * DEPTH) ** -0.25)
LN_EPS = 1e-5
NEG_BIG = -1e30
SEL_FORCE = 1e9

kernel_name = 'hybrid_s5_nsa_yoco_deepnorm'


def layer_norm(x, g, b):
    xf = x.astype(jnp.float32)
    mu = jnp.mean(xf, axis=-1, keepdims=True)
    var = jnp.mean(jnp.square(xf - mu), axis=-1, keepdims=True)
    y = (xf - mu) * lax.rsqrt(var + LN_EPS)
    return (y * g.astype(jnp.float32) + b.astype(jnp.float32)).astype(x.dtype)


def post_norm(x, h, g, b):
    return layer_norm(DN_ALPHA * x + h, g, b)


def masked_softmax(s, mask):
    s = jnp.where(mask, s.astype(jnp.float32), NEG_BIG)
    m = jnp.max(s, axis=-1, keepdims=True)
    p = jnp.where(mask, jnp.exp(s - m), 0.0)
    return p / jnp.maximum(jnp.sum(p, axis=-1, keepdims=True), 1e-30)


def s5_mixer(x, w_in, a_re, a_im, log_dt, b_re, b_im, c_re, c_im, d_skip, w_glu, w_out):
    bsz, seq, _ = x.shape
    f32 = jnp.float32
    u = (x @ w_in).astype(f32).reshape(bsz, seq, S5_GROUPS, S5_GROUP)
    dt = jnp.exp(log_dt.astype(f32))[:, None]
    lr = a_re.astype(f32)
    li = a_im.astype(f32)
    mag = jnp.exp(lr * dt)
    ab_re = mag * jnp.cos(li * dt)
    ab_im = mag * jnp.sin(li * dt)
    den = lr * lr + li * li
    nr = ab_re - 1.0
    ni = ab_im
    f_re = (nr * lr + ni * li) / den
    f_im = (ni * lr - nr * li) / den
    br = b_re.astype(f32)
    bi = b_im.astype(f32)
    bb_re = f_re[..., None] * br - f_im[..., None] * bi
    bb_im = f_re[..., None] * bi + f_im[..., None] * br
    bu_re = jnp.einsum('blgh,gph->blgp', u, bb_re)
    bu_im = jnp.einsum('blgh,gph->blgp', u, bb_im)
    a_seq_re = jnp.broadcast_to(ab_re[None, None], (1, seq) + ab_re.shape)
    a_seq_im = jnp.broadcast_to(ab_im[None, None], (1, seq) + ab_im.shape)

    def combine(e_i, e_j):
        ar_i, ai_i, br_i, bi_i = e_i
        ar_j, ai_j, br_j, bi_j = e_j
        return (ar_j * ar_i - ai_j * ai_i,
                ar_j * ai_i + ai_j * ar_i,
                ar_j * br_i - ai_j * bi_i + br_j,
                ar_j * bi_i + ai_j * br_i + bi_j)

    _, _, s_re, s_im = lax.associative_scan(combine, (a_seq_re, a_seq_im, bu_re, bu_im), axis=1)
    y = (jnp.einsum('blgp,ghp->blgh', s_re, c_re.astype(f32))
         - jnp.einsum('blgp,ghp->blgh', s_im, c_im.astype(f32)))
    y = y + d_skip.astype(f32).reshape(S5_GROUPS, S5_GROUP) * u
    y = jax.nn.gelu(y.reshape(bsz, seq, D_MODEL)).astype(x.dtype)
    gl = y @ w_glu
    val, gate = jnp.split(gl, 2, axis=-1)
    return (val * jax.nn.sigmoid(gate)) @ w_out


def nsa_shared_kv(x, kv_w, cmp_pos_k, cmp_w1_k, cmp_w2_k, cmp_pos_v, cmp_w1_v, cmp_w2_v):
    bsz, seq, _ = x.shape
    kvh, hd = NSA_KV_HEADS, NSA_HEAD_DIM
    kv = (x @ kv_w).reshape(bsz, seq, N_KV_SLOTS, kvh, hd)
    k_c, v_c, k_s, v_s, k_w, v_w = [kv[:, :, i] for i in range(N_KV_SLOTS)]
    n_cmp = (seq - CMP_LEN) // CMP_STRIDE + 1
    idx = np.arange(n_cmp)[:, None] * CMP_STRIDE + np.arange(CMP_LEN)[None, :]

    def compress(t, pos, w1, w2):
        blk = t[:, idx] + pos[None, None, :, None, :]
        blk = jnp.moveaxis(blk, 3, 2).reshape(bsz, n_cmp, kvh, CMP_LEN * hd)
        return jax.nn.gelu(blk @ w1) @ w2

    k_cmp = compress(k_c, cmp_pos_k, cmp_w1_k, cmp_w2_k)
    v_cmp = compress(v_c, cmp_pos_v, cmp_w1_v, cmp_w2_v)
    n_sel = seq // SEL_LEN
    k_sel = k_s.reshape(bsz, n_sel, SEL_LEN, kvh, hd).transpose(0, 3, 1, 2, 4)
    v_sel = v_s.reshape(bsz, n_sel, SEL_LEN, kvh, hd).transpose(0, 3, 1, 2, 4)
    pad = ((0, 0), (WINDOW, 0), (0, 0), (0, 0))
    k_win = jnp.pad(k_w, pad)
    v_win = jnp.pad(v_w, pad)
    return k_cmp, v_cmp, k_sel, v_sel, k_win, v_win


def nsa_mixer(x, k_cmp, v_cmp, k_sel, v_sel, k_win, v_win, w_qg, w_o):
    bsz, seq, _ = x.shape
    H, G, R, hd = NSA_HEADS, NSA_KV_HEADS, NSA_REP, NSA_HEAD_DIM
    qg = x @ w_qg
    q = qg[..., :H * hd].reshape(bsz, seq, G, R, hd) * (hd ** -0.5)
    gates = jax.nn.sigmoid(qg[..., H * hd:].astype(jnp.float32)).reshape(bsz, seq, G, R, N_GATES)
    n_qb = seq // Q_BLOCK
    q_blocks = q.reshape(bsz, n_qb, Q_BLOCK, G, R, hd).swapaxes(0, 1)
    g_blocks = gates.reshape(bsz, n_qb, Q_BLOCK, G, R, N_GATES).swapaxes(0, 1)
    starts = jnp.arange(n_qb, dtype=jnp.int32) * Q_BLOCK

    n_cmp = k_cmp.shape[1]
    n_sel = k_sel.shape[2]
    top_n = min(SEL_TOPN, n_sel)
    cmp_end = jnp.arange(n_cmp, dtype=jnp.int32) * CMP_STRIDE + CMP_LEN - 1
    cs = np.arange(n_cmp) * CMP_STRIDE
    ss = np.arange(n_sel) * SEL_LEN
    sel_map = jnp.asarray(((cs[:, None] < ss[None, :] + SEL_LEN)
                           & (cs[:, None] + CMP_LEN > ss[None, :])).astype(np.float32))
    sel_ids = jnp.arange(n_sel, dtype=jnp.int32)
    b_ix = jnp.arange(bsz)[:, None, None, None]
    g_ix = jnp.arange(G)[None, :, None, None]
    win_off = jnp.arange(WINDOW + Q_BLOCK, dtype=jnp.int32) - WINDOW

    def one_block(args):
        qb, gb, s0 = args
        t = s0 + jnp.arange(Q_BLOCK, dtype=jnp.int32)
        sc = jnp.einsum('bqgrd,bcgd->bgrqc', qb, k_cmp)
        pc = masked_softmax(sc, cmp_end[None, :] <= t[:, None])
        o_cmp = jnp.einsum('bgrqc,bcgd->bqgrd', pc.astype(v_cmp.dtype), v_cmp)
        imp = jnp.einsum('bgrqc,cs->bgqs', pc, sel_map)
        cur = (t // SEL_LEN)[:, None]
        valid = sel_ids[None, :] * SEL_LEN <= t[:, None]
        forced = (sel_ids[None, :] == 0) | (sel_ids[None, :] == cur) | (sel_ids[None, :] == cur - 1)
        imp = jnp.where(forced, SEL_FORCE, jnp.where(valid, imp, -SEL_FORCE))
        _, sel_idx = lax.top_k(imp, top_n)
        ks = k_sel[b_ix, g_ix, sel_idx].reshape(bsz, G, Q_BLOCK, top_n * SEL_LEN, hd)
        vs = v_sel[b_ix, g_ix, sel_idx].reshape(bsz, G, Q_BLOCK, top_n * SEL_LEN, hd)
        kpos = (sel_idx[..., None] * SEL_LEN + jnp.arange(SEL_LEN, dtype=jnp.int32)).reshape(
            bsz, G, Q_BLOCK, top_n * SEL_LEN)
        s_sel = jnp.einsum('bqgrd,bgqkd->bgrqk', qb, ks)
        p_sel = masked_softmax(s_sel, (kpos <= t[None, None, :, None])[:, :, None])
        o_slc = jnp.einsum('bgrqk,bgqkd->bqgrd', p_sel.astype(vs.dtype), vs)
        kw = lax.dynamic_slice_in_dim(k_win, s0, WINDOW + Q_BLOCK, axis=1)
        vw = lax.dynamic_slice_in_dim(v_win, s0, WINDOW + Q_BLOCK, axis=1)
        kp = s0 + win_off
        mw = (kp[None, :] <= t[:, None]) & (kp[None, :] > t[:, None] - WINDOW) & (kp[None, :] >= 0)
        s_w = jnp.einsum('bqgrd,bkgd->bgrqk', qb, kw)
        p_w = masked_softmax(s_w, mw)
        o_win = jnp.einsum('bgrqk,bkgd->bqgrd', p_w.astype(vw.dtype), vw)
        out = gb[..., 0:1] * o_cmp + gb[..., 1:2] * o_slc + gb[..., 2:3] * o_win
        return out.astype(x.dtype)

    o = lax.map(one_block, (q_blocks, g_blocks, starts))
    o = o.swapaxes(0, 1).reshape(bsz, seq, H * hd)
    return o @ w_o


def memory_attention(x, mem, w_q, w_kv, w_o):
    bsz, seq, _ = x.shape
    n_mem = mem.shape[1]
    q = (x @ w_q).reshape(bsz, seq, MEM_HEADS, MEM_HEAD_DIM)
    kv = (mem @ w_kv).reshape(bsz, n_mem, 2, MEM_HEADS, MEM_HEAD_DIM)
    k = kv[:, :, 0]
    v = kv[:, :, 1]
    s = jnp.einsum('blhd,bmhd->bhlm', q, k).astype(jnp.float32) * (MEM_HEAD_DIM ** -0.5)
    p = jax.nn.softmax(s, axis=-1).astype(v.dtype)
    o = jnp.einsum('bhlm,bmhd->blhd', p, v).reshape(bsz, seq, D_MODEL)
    return o @ w_o


def sq_relu_mlp(x, w_up, w_down):
    return jnp.square(jax.nn.relu(x @ w_up)) @ w_down


def _normal(key, shape, scale):
    return jax.random.normal(key, shape, jnp.float32) * scale


def setup_inputs(seed: int = 0) -> dict:
    key = jax.random.key(seed)
    ks = jax.random.split(key, 29)
    nA, nB, D = N_A_LAYERS, N_B_LAYERS, D_MODEL
    G, P, GS = S5_GROUPS, S5_STATE, S5_GROUP
    H, hd, kvh = NSA_HEADS, NSA_HEAD_DIM, NSA_KV_HEADS
    n_idx = jnp.arange(P, dtype=jnp.float32)[None, None, :]
    inp = {}
    inp['x'] = _normal(ks[0], (BATCH, SEQ, D), 1.0)
    inp['mem'] = _normal(ks[1], (BATCH, MEM_TOKENS, D), 1.0)
    inp['s5_w_in'] = _normal(ks[2], (nA, D, D), D ** -0.5)
    inp['s5_a_re'] = -0.5 + _normal(ks[3], (nA, G, P), 0.01)
    inp['s5_a_im'] = math.pi * n_idx + _normal(ks[4], (nA, G, P), 0.01)
    inp['s5_log_dt'] = jax.random.uniform(ks[5], (nA, G), jnp.float32, math.log(1e-3), math.log(1e-1))
    inp['s5_b_re'] = _normal(ks[6], (nA, G, P, GS), (2 * GS) ** -0.5)
    inp['s5_b_im'] = _normal(ks[7], (nA, G, P, GS), (2 * GS) ** -0.5)
    inp['s5_c_re'] = _normal(ks[8], (nA, G, GS, P), P ** -0.5)
    inp['s5_c_im'] = _normal(ks[9], (nA, G, GS, P), P ** -0.5)
    inp['s5_d'] = _normal(ks[10], (nA, D), 1.0)
    inp['s5_w_glu'] = _normal(ks[11], (nA, D, 2 * D), D ** -0.5)
    inp['s5_w_out'] = _normal(ks[12], (nA, D, D), DN_BETA * D ** -0.5)
    inp['kv_w'] = _normal(ks[13], (D, N_KV_SLOTS * kvh * hd), D ** -0.5)
    inp['cmp_pos_k'] = _normal(ks[14], (CMP_LEN, hd), 0.02)
    inp['cmp_w1_k'] = _normal(ks[15], (CMP_LEN * hd, hd), (CMP_LEN * hd) ** -0.5)
    inp['cmp_w2_k'] = _normal(ks[16], (hd, hd), hd ** -0.5)
    inp['cmp_pos_v'] = _normal(ks[17], (CMP_LEN, hd), 0.02)
    inp['cmp_w1_v'] = _normal(ks[18], (CMP_LEN * hd, hd), (CMP_LEN * hd) ** -0.5)
    inp['cmp_w2_v'] = _normal(ks[19], (hd, hd), hd ** -0.5)
    inp['nsa_w_qg'] = _normal(ks[20], (nB, D, H * hd + N_GATES * H), D ** -0.5)
    inp['nsa_w_o'] = _normal(ks[21], (nB, H * hd, D), DN_BETA * (H * hd) ** -0.5)
    inp['mem_w_q'] = _normal(ks[22], (DEPTH, D, D), D ** -0.5)
    inp['mem_w_kv'] = _normal(ks[23], (DEPTH, D, 2 * D), D ** -0.5)
    inp['mem_w_o'] = _normal(ks[24], (DEPTH, D, D), DN_BETA * D ** -0.5)
    inp['mlp_w_up'] = _normal(ks[25], (DEPTH, D, D_FF), D ** -0.5)
    inp['mlp_w_down'] = _normal(ks[26], (DEPTH, D_FF, D), DN_BETA * D_FF ** -0.5)
    inp['ln_g'] = 1.0 + _normal(ks[27], (DEPTH, 3, D), 0.02)
    inp['ln_b'] = _normal(ks[28], (DEPTH, 3, D), 0.02)
    return inp


def reference(x, mem, s5_w_in, s5_a_re, s5_a_im, s5_log_dt, s5_b_re, s5_b_im, s5_c_re, s5_c_im, s5_d,
              s5_w_glu, s5_w_out, kv_w, cmp_pos_k, cmp_w1_k, cmp_w2_k, cmp_pos_v, cmp_w1_v, cmp_w2_v,
              nsa_w_qg, nsa_w_o, mem_w_q, mem_w_kv, mem_w_o, mlp_w_up, mlp_w_down, ln_g, ln_b):
    for layer in range(DEPTH):
        if layer < N_A_LAYERS:
            i = layer
            h = s5_mixer(x, s5_w_in[i], s5_a_re[i], s5_a_im[i], s5_log_dt[i], s5_b_re[i], s5_b_im[i],
                         s5_c_re[i], s5_c_im[i], s5_d[i], s5_w_glu[i], s5_w_out[i])
        else:
            i = layer - N_A_LAYERS
            if i == 0:
                k_cmp, v_cmp, k_sel, v_sel, k_win, v_win = nsa_shared_kv(
                    x, kv_w, cmp_pos_k, cmp_w1_k, cmp_w2_k, cmp_pos_v, cmp_w1_v, cmp_w2_v)
            h = nsa_mixer(x, k_cmp, v_cmp, k_sel, v_sel, k_win, v_win, nsa_w_qg[i], nsa_w_o[i])
        x = post_norm(x, h, ln_g[layer, 0], ln_b[layer, 0])
        x = post_norm(x, memory_attention(x, mem, mem_w_q[layer], mem_w_kv[layer], mem_w_o[layer]),
                      ln_g[layer, 1], ln_b[layer, 1])
        x = post_norm(x, sq_relu_mlp(x, mlp_w_up[layer], mlp_w_down[layer]), ln_g[layer, 2], ln_b[layer, 2])
    return x
```

```cpp
#include <hip/hip_runtime.h>
#include <hip/hip_cooperative_groups.h>
#include <cstdio>
#include <cstdint>
namespace cg = cooperative_groups;

#define LAS __attribute__((address_space(3)))
typedef unsigned short bf16_t;
typedef short bf16x8 __attribute__((ext_vector_type(8)));
typedef float f32x4 __attribute__((ext_vector_type(4)));
typedef float f32x2 __attribute__((ext_vector_type(2)));
typedef float f32x16 __attribute__((ext_vector_type(16)));
typedef unsigned u32x4 __attribute__((ext_vector_type(4)));
typedef unsigned u32x2 __attribute__((ext_vector_type(2)));

constexpr int SEQ = 8192, BATCH = 2, DM = 2048, MTOK = BATCH * SEQ, DFF = 8192;
constexpr float LN_EPS = 1e-5f;
constexpr float DN_ALPHA = 1.4142135623730951f;
constexpr int NWAVES = 8, NTHREADS = 512;
constexpr int LDS_BYTES = 147456;

constexpr size_t MiB = 1u << 20;
constexpr size_t WS_WIN = 0;
constexpr size_t WS_WGLU = WS_WIN + 8 * MiB;
constexpr size_t WS_WOUT = WS_WGLU + 16 * MiB;
constexpr size_t WS_WKVQ = WS_WOUT + 8 * MiB;
constexpr size_t WS_WNO = WS_WKVQ + 22 * MiB;
constexpr size_t WS_WMQ = WS_WNO + 8 * MiB;
constexpr size_t WS_WMKV = WS_WMQ + 16 * MiB;
constexpr size_t WS_WMO = WS_WMKV + 32 * MiB;
constexpr size_t WS_WUP = WS_WMO + 16 * MiB;
constexpr size_t WS_WDN = WS_WUP + 64 * MiB;
constexpr size_t WS_WC1 = WS_WDN + 64 * MiB;
constexpr size_t WS_XB = WS_WC1 + 2 * MiB;
constexpr size_t WS_OVL = WS_XB + 64 * MiB;
constexpr size_t WS_MISC = WS_OVL + 256 * MiB;
constexpr size_t WS_END = WS_MISC + 64 * MiB;
constexpr size_t OV_T1 = WS_OVL;
constexpr size_t OV_T2 = WS_OVL + 64 * MiB;
constexpr size_t OV_T3 = WS_OVL + 128 * MiB;
constexpr size_t OV_KV = WS_OVL + 128 * MiB;
constexpr size_t OV_HID = WS_OVL;
constexpr size_t MS_MEMB = WS_MISC;
constexpr size_t MS_MKV = WS_MISC + 2 * MiB;
constexpr size_t MS_MK = WS_MISC + 2 * MiB;
constexpr size_t MS_MVT = WS_MISC + 6 * MiB;
constexpr size_t MS_S5AB = WS_MISC + 10 * MiB;
constexpr size_t MS_S5ABL = MS_S5AB + 65536;
constexpr size_t MS_S5BM = MS_S5ABL + 65536;
constexpr size_t MS_S5CM = MS_S5BM + 524288;
constexpr size_t MS_S5E = MS_S5CM + 524288;
constexpr size_t MS_S5SIN = MS_S5E + 1048576;
constexpr int S5_NCH = 8, S5_LC = SEQ / S5_NCH;
constexpr size_t MS_STATS = WS_MISC + 14 * MiB;
constexpr size_t WS_MT = WS_MISC + 22 * MiB;
constexpr size_t WS_VWT = WS_MISC + 38 * MiB;
constexpr size_t MS_GATES = WS_MISC + 16 * MiB;
constexpr size_t MS_CB = WS_MISC + 20 * MiB;
constexpr size_t MS_PAB = OV_T1;
constexpr size_t MS_KCMP = WS_MISC + 54 * MiB;
constexpr size_t OV_KVH = WS_OVL + 64 * MiB;
constexpr size_t OV_QH = WS_OVL + 160 * MiB;
constexpr size_t KVH_SLOT = (size_t)2 * 4 * 8192 * 128;

__device__ __forceinline__ unsigned f2bf(float f) { unsigned u = __builtin_bit_cast(unsigned, f); return (u + 0x7fffu + ((u >> 16) & 1u)) >> 16; }
__device__ __forceinline__ unsigned pk2(float lo, float hi) { return f2bf(lo) | (f2bf(hi) << 16); }
__device__ __forceinline__ float bf2f(unsigned short h) { return __builtin_bit_cast(float, (unsigned)h << 16); }

__device__ __forceinline__ int lane_now() { int l_; asm volatile("v_mbcnt_lo_u32_b32 %0, -1, 0\n\tv_mbcnt_hi_u32_b32 %0, -1, %0" : "=v"(l_)); return l_; }
__device__ __forceinline__ float my_shfl_xor(float v, int o) { return __builtin_bit_cast(float, __builtin_amdgcn_ds_bpermute((lane_now() ^ o) << 2, __builtin_bit_cast(int, v))); }
__device__ __forceinline__ int my_shfl_xor(int v, int o) { return __builtin_amdgcn_ds_bpermute((lane_now() ^ o) << 2, v); }
__device__ __forceinline__ float my_shfl(float v, int src) { return __builtin_bit_cast(float, __builtin_amdgcn_ds_bpermute(src << 2, __builtin_bit_cast(int, v))); }
__device__ __forceinline__ float wave_sum(float v) {
#pragma unroll
    for (int o = 1; o < 64; o <<= 1) v += my_shfl_xor(v, o);
    return v;
}
#define LDS_WAIT() asm volatile("s_waitcnt lgkmcnt(0)" ::: "memory")

namespace pg8 {
constexpr int BM = 256, BK = 64, HALF = 128, HTB = HALF * BK * 2, STAGE_BYTES = 8 * HTB, NXCD = 8, WGM = 8;
__host__ __device__ __forceinline__ int lds_byte(int r, int c) { const int st = (r >> 4) * 2 + (c >> 5), rr = r & 15, cc = c & 31, ob = rr * 64 + cc * 2; return st * 1024 + (ob ^ (((ob >> 9) & 1) << 5)); }
__host__ __device__ __forceinline__ void stage_rc(int b, int& R, int& C) { const int st = b / 1024, sb = b % 1024, swz = sb ^ (((sb >> 9) & 1) << 5); R = (st >> 1) * 16 + swz / 64; C = (st & 1) * 32 + (swz % 64) / 2; }
__host__ __device__ __forceinline__ int perm32(int rho) { const int n = rho >> 4, i = rho & 15; return 8 * (i >> 2) + 4 * n + (i & 3); }

struct Unit { int pm, pn, z; unsigned ao, bo; };
struct Gemm { const bf16_t* A; const bf16_t* Bt; int lda, ldb, K; };

struct StaticOrder {
    int nM, nN, nwg, G, c; unsigned ta, tb;
    __device__ void init(int M, int N, int lda, int ldb, int G_, int c_) { nM = M / BM; nN = N / BM; nwg = nM * nN; G = G_; c = c_; ta = (unsigned)BM * lda * 2; tb = (unsigned)BM * ldb * 2; }
    __device__ bool next(int i, Unit& u) const {
        const long L = (long)i * G + c; if (L >= nwg) return false;
        int wgid = (int)L; { const int q = nwg / NXCD, r = nwg % NXCD, xcd = wgid % NXCD, off = wgid / NXCD; wgid = (xcd < r ? xcd * (q + 1) : r * (q + 1) + (xcd - r) * q) + off; }
        const int nig = WGM * nN, gid = wgid / nig, fm = gid * WGM, gsz = (nM - fm) < WGM ? (nM - fm) : WGM;
        u.pm = fm + ((wgid % nig) % gsz); u.pn = (wgid % nig) / gsz; u.z = 0; u.ao = (unsigned)u.pm * ta; u.bo = (unsigned)u.pn * tb; return true;
    }
};

__device__ __forceinline__ unsigned cvt_pk_bf16(float lo, float hi) { unsigned r; asm volatile("v_cvt_pk_bf16_f32 %0, %1, %2" : "=v"(r) : "v"(lo), "v"(hi)); return r; }


template <class Epi, class Sched>
__device__ __forceinline__ void gemm_phase(LAS unsigned char* lds, const Gemm g, const Sched& S, const Epi& E, int wv) {
    int tid; asm volatile("v_mbcnt_lo_u32_b32 %0, -1, 0\n\tv_mbcnt_hi_u32_b32 %0, -1, %0" : "=v"(tid)); tid += wv * 64;
    const int wid = __builtin_amdgcn_readfirstlane(tid >> 6), lane = tid & 63, wr = wid >> 2, wc = wid & 3, fr = lane & 15, fq = lane >> 4;
    int nt = g.K / BK; asm volatile("" : "+s"(nt));
    unsigned voffA[2], voffB[2];
#pragma unroll
    for (int i = 0; i < 2; ++i) { int R, C; stage_rc(tid * 16 + i * 8192, R, C); const int Rb = Epi::PERM ? ((R & ~31) + perm32(R & 31)) : R;
        voffA[i] = (unsigned)(R * g.lda + C) * 2u; voffB[i] = (unsigned)(Rb * g.ldb + C) * 2u; }
    const size_t kstep = (size_t)(BK * 2);
    const size_t hsA = (size_t)HALF * g.lda * 2, hsB = (size_t)HALF * g.ldb * 2;
    const unsigned ldsw = (unsigned)wid * 1024u;
    const int aoff = lds_byte(wr * 64 + fr, fq * 8), boff = lds_byte(wc * 32 + fr, fq * 8);
#define PG8_SA(b, h) (((b) * 2 + (h)) * HTB)
#define PG8_SB(b, h) ((4 + (b) * 2 + (h)) * HTB)
#define PG8_STAGE(bufoff, gbase, voff) do { _Pragma("unroll") for (int _i = 0; _i < 2; ++_i) \
        __builtin_amdgcn_global_load_lds((const unsigned*)((const char*)(gbase) + (voff)[_i]), (LAS unsigned*)(lds + (bufoff) + ldsw + _i * 8192), 16, 0, 0); } while (0)
#define PG8_LDA(dst, b, h) do { _Pragma("unroll") for (int m = 0; m < 4; ++m) _Pragma("unroll") for (int k = 0; k < 2; ++k) dst[m][k] = *(const LAS bf16x8*)(lds + PG8_SA(b, h) + aoff + m * 2048 + k * 1024); } while (0)
#define PG8_LDB(dst, b, h) do { _Pragma("unroll") for (int n = 0; n < 2; ++n) _Pragma("unroll") for (int k = 0; k < 2; ++k) dst[n][k] = *(const LAS bf16x8*)(lds + PG8_SB(b, h) + boff + n * 2048 + k * 1024); } while (0)
#define PG8_MMA(ai, bj, At, Bt) do { __builtin_amdgcn_s_setprio(1); _Pragma("unroll") for (int m = 0; m < 4; ++m) _Pragma("unroll") for (int n = 0; n < 2; ++n) _Pragma("unroll") for (int k = 0; k < 2; ++k) \
        acc[ai][bj][m][n] = __builtin_amdgcn_mfma_f32_16x16x32_bf16(Bt[n][k], At[m][k], acc[ai][bj][m][n], 0, 0, 0); __builtin_amdgcn_s_setprio(0); } while (0)
#define PG8_WAIT_V(n) asm volatile("s_waitcnt vmcnt(" #n ")" ::: "memory")
#define PG8_WAIT_L(n) asm volatile("s_waitcnt lgkmcnt(" #n ")" ::: "memory")
#define PG8_BAR __builtin_amdgcn_s_barrier()
#define PG8_SCHED __builtin_amdgcn_sched_barrier(0)
    Unit cur, nxt; int ui = 0;
    if (!S.next(0, cur)) return;
    f32x4 acc[2][2][4][2];
#pragma unroll
    for (int a = 0; a < 2; ++a)
#pragma unroll
        for (int b = 0; b < 2; ++b)
#pragma unroll
            for (int m = 0; m < 4; ++m)
#pragma unroll
                for (int n = 0; n < 2; ++n) acc[a][b][m][n] = (f32x4){0.f, 0.f, 0.f, 0.f};
    bf16x8 At[4][2], B0[2][2], B1[2][2];
    const char* cA = (const char*)g.A + cur.ao; const char* cB = (const char*)g.Bt + cur.bo;
    PG8_STAGE(PG8_SB(0, 0), cB, voffB); PG8_STAGE(PG8_SB(0, 1), cB + hsB, voffB); PG8_STAGE(PG8_SA(0, 0), cA, voffA); PG8_STAGE(PG8_SA(0, 1), cA + hsA, voffA);
    if (wr == 1) PG8_BAR;
    PG8_WAIT_V(2); PG8_BAR;
    PG8_STAGE(PG8_SB(1, 0), cB + kstep, voffB); PG8_STAGE(PG8_SA(1, 0), cA + kstep, voffA); PG8_STAGE(PG8_SB(1, 1), cB + hsB + kstep, voffB);
    PG8_WAIT_V(6); PG8_BAR;
    for (;;) {
        const bool has_next = S.next(ui + 1, nxt);
        const char* nA = has_next ? (const char*)g.A + nxt.ao : cA; const char* nB = has_next ? (const char*)g.Bt + nxt.bo : cB;
        for (int t = 0; t < nt; t += 2) {
            const bool last = (t == nt - 2);
            const char* a1 = cA + (size_t)(t + 1) * kstep;
            const char* a2 = last ? nA : cA + (size_t)(t + 2) * kstep; const char* b2 = last ? nB : cB + (size_t)(t + 2) * kstep;
            const char* a3 = a2 + kstep; const char* b3 = b2 + kstep;
            PG8_LDB(B0, 0, 0); PG8_LDB(B1, 0, 1); PG8_SCHED; PG8_LDA(At, 0, 0); PG8_STAGE(PG8_SA(1, 1), a1 + hsA, voffA);
            PG8_WAIT_V(8); PG8_WAIT_L(0); PG8_BAR; PG8_MMA(0, 0, At, B0); PG8_MMA(0, 1, At, B1); PG8_BAR; PG8_SCHED;
            PG8_LDA(At, 0, 1); PG8_STAGE(PG8_SB(0, 0), b2, voffB); PG8_STAGE(PG8_SB(0, 1), b2 + hsB, voffB); PG8_STAGE(PG8_SA(0, 0), a2, voffA);
            PG8_WAIT_V(8); PG8_WAIT_L(0); PG8_BAR; PG8_MMA(1, 0, At, B0); PG8_MMA(1, 1, At, B1); PG8_BAR; PG8_SCHED;
            PG8_LDB(B0, 1, 0); PG8_LDB(B1, 1, 1); PG8_SCHED; PG8_LDA(At, 1, 0); PG8_STAGE(PG8_SA(0, 1), a2 + hsA, voffA);
            PG8_WAIT_V(8); PG8_WAIT_L(0); PG8_BAR; PG8_MMA(0, 0, At, B0); PG8_MMA(0, 1, At, B1); PG8_BAR; PG8_SCHED;
            PG8_LDA(At, 1, 1); PG8_STAGE(PG8_SB(1, 0), b3, voffB); PG8_STAGE(PG8_SB(1, 1), b3 + hsB, voffB); PG8_STAGE(PG8_SA(1, 0), a3, voffA);
            PG8_WAIT_V(8); PG8_WAIT_L(0); PG8_BAR; PG8_MMA(1, 0, At, B0); PG8_MMA(1, 1, At, B1); PG8_BAR; PG8_SCHED;
        }
        if (wr == 0) PG8_BAR;
        if constexpr (!Epi::AFTER_DRAIN) { E(acc, cur, wr, wc, fr, fq); }
        if (!has_next) break;
#pragma unroll
        for (int a = 0; a < 2; ++a)
#pragma unroll
            for (int b = 0; b < 2; ++b)
#pragma unroll
                for (int m = 0; m < 4; ++m)
#pragma unroll
                    for (int n = 0; n < 2; ++n) acc[a][b][m][n] = (f32x4){0.f, 0.f, 0.f, 0.f};
        cur = nxt; cA = nA; cB = nB; ++ui;
        if (wr == 1) PG8_BAR;
    }
    PG8_WAIT_V(0);
    PG8_BAR;
    if constexpr (Epi::AFTER_DRAIN) { E.fused(acc, cur, wr, wc, fr, fq, lds, wid, lane); }
#undef PG8_SA
#undef PG8_SB
#undef PG8_STAGE
#undef PG8_LDA
#undef PG8_LDB
#undef PG8_MMA
#undef PG8_WAIT_V
#undef PG8_WAIT_L
#undef PG8_BAR
#undef PG8_SCHED
}

template <class F> struct EpiCols8 {
    static constexpr bool PERM = true, AFTER_DRAIN = false; F f;
    __device__ __forceinline__ void operator()(const f32x4 (&acc)[2][2][4][2], const Unit& u, int wr, int wc, int fr, int fq) const {
#pragma unroll
        for (int ai = 0; ai < 2; ++ai)
#pragma unroll
            for (int m = 0; m < 4; ++m) { const int row = u.pm * BM + ai * HALF + wr * 64 + m * 16 + fr;
#pragma unroll
                for (int bj = 0; bj < 2; ++bj) f(u, row, u.pn * BM + bj * HALF + wc * 32 + 8 * fq, acc[ai][bj][m][0], acc[ai][bj][m][1]); }
    }
};
template <int MODE> struct EpiRes {
    static constexpr bool PERM = false, AFTER_DRAIN = false; const float* res; float* out; const f32x2* st; const float* g; const float* b; int ldc; float alpha;
    __device__ __forceinline__ void operator()(const f32x4 (&acc)[2][2][4][2], const Unit& u, int wr, int wc, int fr, int fq) const {
        const unsigned row0 = (unsigned)(u.pm * BM + wr * 64 + fr), col0 = (unsigned)(u.pn * BM + wc * 32 + 4 * fq);
        const unsigned base = row0 * (unsigned)ldc + col0;
        f32x4 gv[2][2], bv[2][2];
        if (MODE == 1) {
#pragma unroll
            for (int bj = 0; bj < 2; ++bj)
#pragma unroll
                for (int n = 0; n < 2; ++n) { gv[bj][n] = *(const f32x4*)(g + col0 + bj * HALF + n * 16); bv[bj][n] = *(const f32x4*)(b + col0 + bj * HALF + n * 16); }
        }
#pragma unroll
        for (int ai = 0; ai < 2; ++ai)
#pragma unroll
            for (int mp = 0; mp < 2; ++mp) {
                f32x4 r[2][2][2]; f32x2 sv[2];
#pragma unroll
                for (int mm = 0; mm < 2; ++mm) { const int m = 2 * mp + mm; const unsigned off = base + (unsigned)(ai * HALF + m * 16) * (unsigned)ldc;
                    if (MODE == 1) sv[mm] = st[row0 + ai * HALF + m * 16];
#pragma unroll
                    for (int bj = 0; bj < 2; ++bj)
#pragma unroll
                        for (int n = 0; n < 2; ++n) r[mm][bj][n] = *(const f32x4*)(res + (off + bj * HALF + n * 16)); }
                asm volatile("" ::: "memory");
#pragma unroll
                for (int mm = 0; mm < 2; ++mm) { const int m = 2 * mp + mm; const unsigned off = base + (unsigned)(ai * HALF + m * 16) * (unsigned)ldc;
#pragma unroll
                    for (int bj = 0; bj < 2; ++bj)
#pragma unroll
                        for (int n = 0; n < 2; ++n) { f32x4 x = r[mm][bj][n];
                            if (MODE == 1) x = (x - sv[mm].x) * sv[mm].y * gv[bj][n] + bv[bj][n];
                            *(f32x4*)(out + (off + bj * HALF + n * 16)) = x * alpha + acc[ai][bj][m][n]; } }
                asm volatile("" ::: "memory");
            }
    }
};
}

struct Args { const float* in[29]; float* out; unsigned char* ws; int ph_lo, ph_hi; };
enum { I_X = 0, I_MEM, I_S5_WIN, I_S5_ARE, I_S5_AIM, I_S5_LOGDT, I_S5_BRE, I_S5_BIM, I_S5_CRE, I_S5_CIM, I_S5_D, I_S5_WGLU, I_S5_WOUT, I_KVW,
       I_CPK, I_CW1K, I_CW2K, I_CPV, I_CW1V, I_CW2V, I_WQG, I_WNO, I_MWQ, I_MWKV, I_MWO, I_WUP, I_WDN, I_LNG, I_LNB };

__device__ __forceinline__ const float* argp(int i) {
    const char* kp = (const char*)__builtin_amdgcn_kernarg_segment_ptr(); const float* p;
    asm volatile("s_load_dwordx2 %0, %1, %2\n\ts_waitcnt lgkmcnt(0)" : "=s"(p) : "s"(kp), "i"(i * 8)); return p; }
#define INP(i) argp(i)

__device__ __forceinline__ void conv_item(const float* W, int ldw, int ncols, bf16_t* WT, int ldt, int k0, int n0, int drow0, LAS float* scr, int lane) {
    const int r8 = lane >> 3, c4 = (lane & 7) * 4; const bool ok = (n0 + c4) < ncols;
    f32x4 v[8];
#pragma unroll
    for (int i = 0; i < 8; ++i) v[i] = ok ? *(const f32x4*)(W + (size_t)(k0 + 8 * i + r8) * ldw + n0 + c4) : (f32x4){0.f, 0.f, 0.f, 0.f};
#pragma unroll
    for (int i = 0; i < 8; ++i) { LAS float* d = scr + (8 * i + r8) * 33 + c4; d[0] = v[i].x; d[1] = v[i].y; d[2] = v[i].z; d[3] = v[i].w; }
    LDS_WAIT(); asm volatile("" ::: "memory");
    const int c = lane & 7;
#pragma unroll
    for (int j = 0; j < 4; ++j) { const int n = (lane >> 3) + 8 * j; const LAS float* s = scr + (8 * c) * 33 + n;
        u32x4 o; o.x = pk2(s[0 * 33], s[1 * 33]); o.y = pk2(s[2 * 33], s[3 * 33]); o.z = pk2(s[4 * 33], s[5 * 33]); o.w = pk2(s[6 * 33], s[7 * 33]);
        *(u32x4*)(WT + (size_t)(drow0 + n) * ldt + k0 + 8 * c) = o; }
    LDS_WAIT(); asm volatile("" ::: "memory");
}
template <int MODE>
__device__ __forceinline__ void conv_matrix(const float* W, int K, int ldw, int ncols, bf16_t* WT, int ldt, int row_off, LAS float* scr, int gw, int NGW, int lane) {
    const int nblk = (ncols + 31) / 32, nitems = (K / 64) * nblk;
    for (int it = gw; it < nitems; it += NGW) {
        const int kb = it / nblk, nb = it % nblk, n0 = 32 * nb;
        int drow0;
        if (MODE == 1) { const int bj = n0 >> 11, j = n0 & 2047; drow0 = 256 * (j >> 7) + 128 * bj + (j & 127); } else drow0 = row_off + n0;
        conv_item(W, ldw, ncols, WT, ldt, 64 * kb, n0, drow0, scr, lane);
    }
}
__device__ __forceinline__ void cvt_rows(const float* src, bf16_t* dst, size_t n, int gtid, int gthreads) {
    for (size_t i = (size_t)gtid * 8; i < n; i += (size_t)gthreads * 8) {
        const f32x4 a = *(const f32x4*)(src + i), b = *(const f32x4*)(src + i + 4);
        u32x4 o; o.x = pk2(a.x, a.y); o.y = pk2(a.z, a.w); o.z = pk2(b.x, b.y); o.w = pk2(b.z, b.w);
        *(u32x4*)(dst + i) = o;
    }
}
template <bool WF32>
__device__ __forceinline__ void ln_phase(const float* src, float prescale, float* XF, bf16_t* XB, f32x2* ST, const float* g, const float* b, int gw, int NGW, int lane) {
    asm volatile("" : "+v"(lane));
    for (int row = gw; row < MTOK; row += NGW) {
        const f32x4* xr = (const f32x4*)(src + (size_t)row * DM) + lane;
        f32x4 v[8]; float s = 0.f;
#pragma unroll
        for (int j = 0; j < 8; ++j) { v[j] = xr[64 * j] * prescale; s += (v[j].x + v[j].y) + (v[j].z + v[j].w); }
        const float mean = wave_sum(s) * (1.f / DM); float s2 = 0.f;
#pragma unroll
        for (int j = 0; j < 8; ++j) { v[j] = v[j] - mean; s2 += (v[j].x * v[j].x + v[j].y * v[j].y) + (v[j].z * v[j].z + v[j].w * v[j].w); }
        const float rstd = 1.f / sqrtf(wave_sum(s2) * (1.f / DM) + LN_EPS);
        if (!WF32 && lane == 0) ST[row] = (f32x2){mean, rstd};
        f32x4* xo = (f32x4*)(XF + (size_t)row * DM) + lane; u32x2* bo = (u32x2*)(XB + (size_t)row * DM) + lane;
#pragma unroll
        for (int j = 0; j < 8; ++j) { const f32x4 gv = ((const f32x4*)g)[lane + 64 * j], bv = ((const f32x4*)b)[lane + 64 * j];
            const f32x4 o = v[j] * rstd * gv + bv; if (WF32) xo[64 * j] = o; u32x2 w; w.x = pk2(o.x, o.y); w.y = pk2(o.z, o.w); bo[64 * j] = w; }
    }
}

struct StoreBf16 { bf16_t* O; int ldc; float scale;
    __device__ __forceinline__ void operator()(const pg8::Unit&, int row, int col, f32x4 v0, f32x4 v1) const {
        u32x4 w; w.x = pg8::cvt_pk_bf16(v0[0] * scale, v0[1] * scale); w.y = pg8::cvt_pk_bf16(v0[2] * scale, v0[3] * scale); w.z = pg8::cvt_pk_bf16(v1[0] * scale, v1[1] * scale); w.w = pg8::cvt_pk_bf16(v1[2] * scale, v1[3] * scale);
        *(u32x4*)(O + (size_t)row * ldc + col) = w; } };
struct StoreRelu2 { bf16_t* O; int ldc;
    __device__ __forceinline__ void operator()(const pg8::Unit&, int row, int col, f32x4 v0, f32x4 v1) const {
#pragma unroll
        for (int i = 0; i < 4; ++i) { const float a = v0[i] > 0.f ? v0[i] : 0.f, c = v1[i] > 0.f ? v1[i] : 0.f; v0[i] = a * a; v1[i] = c * c; }
        u32x4 w; w.x = pg8::cvt_pk_bf16(v0[0], v0[1]); w.y = pg8::cvt_pk_bf16(v0[2], v0[3]); w.z = pg8::cvt_pk_bf16(v1[0], v1[1]); w.w = pg8::cvt_pk_bf16(v1[2], v1[3]);
        *(u32x4*)(O + (size_t)row * ldc + col) = w; } };


__device__ __forceinline__ void s5_tables(const float* a_re, const float* a_im, const float* log_dt, const float* b_re, const float* b_im, const float* c_re, const float* c_im,
                                          unsigned char* ws, int gtid, int gthreads) {
    f32x2* AB = (f32x2*)(ws + MS_S5AB); f32x2* ABL = (f32x2*)(ws + MS_S5ABL); bf16_t* BM = (bf16_t*)(ws + MS_S5BM); bf16_t* CM = (bf16_t*)(ws + MS_S5CM);
    for (int i = gtid; i < 128 * 64 * 16; i += gthreads) {
        const int h = i & 15, p = (i >> 4) & 63, g = i >> 10;
        const float dt = expf(log_dt[g]), lr = a_re[g * 64 + p], li = a_im[g * 64 + p];
        const float mag = expf(lr * dt), abr = mag * cosf(li * dt), abi = mag * sinf(li * dt);
        const float den = lr * lr + li * li, nr = abr - 1.0f, ni = abi;
        const float fre = (nr * lr + ni * li) / den, fim = (ni * lr - nr * li) / den;
        const float br = b_re[(g * 64 + p) * 16 + h], bi = b_im[(g * 64 + p) * 16 + h];
        BM[(g * 128 + p) * 16 + h] = (bf16_t)f2bf(fre * br - fim * bi);
        BM[(g * 128 + 64 + p) * 16 + h] = (bf16_t)f2bf(fre * bi + fim * br);
        CM[(g * 16 + h) * 128 + p] = (bf16_t)f2bf(c_re[(g * 16 + h) * 64 + p]);
        CM[(g * 16 + h) * 128 + 64 + p] = (bf16_t)f2bf(-c_im[(g * 16 + h) * 64 + p]);
        if (h == 0) { AB[g * 64 + p] = (f32x2){abr, abi}; float xr = abr, xi = abi;
            for (int k = S5_LC; k > 1; k >>= 1) { const float t = xr * xr - xi * xi; xi = 2.f * xr * xi; xr = t; }
            ABL[g * 64 + p] = (f32x2){xr, xi}; }
    }
}
__device__ __forceinline__ float gelu_tanh(float y) { const float z = 0.7978845608028654f * (y + 0.044715f * y * y * y); const float e = __expf(2.f * z); return 0.5f * y * (2.f - 2.f / (1.f + e)); }
template <bool FINAL>
__device__ __forceinline__ void s5_pass(const bf16_t* U, bf16_t* Y, const float* dskip, unsigned char* ws, LAS unsigned char* lds, int gw, int NGW, int wave, int lane) {
    asm volatile("" : "+v"(lane));
    const int fr = lane & 15, fq = lane >> 4;
    LAS float* BU = (LAS float*)(lds + wave * 12800); LAS bf16_t* SB = (LAS bf16_t*)(lds + wave * 12800 + 8448);
    constexpr int LDB = 132, LDSB = 136;
    for (int item = gw; item < 2 * 128 * S5_NCH; item += NGW) {
        const int g = item & 127, b = (item >> 7) & 1, ch = item >> 8;
        const bf16_t* BMg = (const bf16_t*)(ws + MS_S5BM) + (size_t)g * 128 * 16; const bf16_t* CMg = (const bf16_t*)(ws + MS_S5CM) + (size_t)g * 16 * 128;
        bf16x8 bmf[8];
#pragma unroll
        for (int nt = 0; nt < 8; ++nt) { bmf[nt] = (bf16x8){0, 0, 0, 0, 0, 0, 0, 0}; if (fq < 2) bmf[nt] = *(const bf16x8*)(BMg + (16 * nt + fr) * 16 + 8 * fq); }
        bf16x8 cmf[4];
        if (FINAL) {
#pragma unroll
            for (int kk = 0; kk < 4; ++kk) cmf[kk] = *(const bf16x8*)(CMg + fr * 128 + 32 * kk + 8 * fq);
        }
        const f32x2 ab = ((const f32x2*)(ws + MS_S5AB))[g * 64 + lane];
        const float ar = ab.x, ai = ab.y;
        float sr = 0.f, si = 0.f;
        if (FINAL) { const f32x2 al = ((const f32x2*)(ws + MS_S5ABL))[g * 64 + lane]; const f32x2* E = (const f32x2*)(ws + MS_S5E) + (size_t)(b * 128 + g) * S5_NCH * 64 + lane;
            for (int c = 0; c < ch; ++c) { const f32x2 e = E[c * 64]; const float nr = al.x * sr - al.y * si + e.x, ni = al.x * si + al.y * sr + e.y; sr = nr; si = ni; } }
        const float dsk = FINAL ? dskip[g * 16 + fr] : 0.f;
        const size_t row0 = (size_t)b * SEQ + (size_t)ch * S5_LC;
        const bf16_t* Up = U + (row0 + fr) * DM + g * 16 + 8 * fq;
        bf16x8 uf = (bf16x8){0, 0, 0, 0, 0, 0, 0, 0}; if (fq < 2) uf = *(const bf16x8*)Up;
        for (int t0 = 0; t0 < S5_LC; t0 += 16) {
            bf16x8 un = (bf16x8){0, 0, 0, 0, 0, 0, 0, 0};
            if (fq < 2 && t0 + 16 < S5_LC) un = *(const bf16x8*)(Up + (size_t)(t0 + 16) * DM);
#pragma unroll
            for (int nt = 0; nt < 8; ++nt) { const f32x4 d = __builtin_amdgcn_mfma_f32_16x16x32_bf16(uf, bmf[nt], (f32x4){0.f, 0.f, 0.f, 0.f}, 0, 0, 0);
#pragma unroll
                for (int r = 0; r < 4; ++r) BU[(4 * fq + r) * LDB + 16 * nt + fr] = d[r]; }
#pragma unroll
            for (int t = 0; t < 16; ++t) { const float br = BU[t * LDB + lane], bi = BU[t * LDB + 64 + lane];
                const float nr = ar * sr - ai * si + br, ni = ar * si + ai * sr + bi; sr = nr; si = ni;
                if (FINAL) { SB[t * LDSB + lane] = (bf16_t)f2bf(sr); SB[t * LDSB + 64 + lane] = (bf16_t)f2bf(si); } }
            if (FINAL) {
                f32x4 y = (f32x4){0.f, 0.f, 0.f, 0.f};
#pragma unroll
                for (int kk = 0; kk < 4; ++kk) { const bf16x8 sf = *(const LAS bf16x8*)(SB + fr * LDSB + 32 * kk + 8 * fq); y = __builtin_amdgcn_mfma_f32_16x16x32_bf16(sf, cmf[kk], y, 0, 0, 0); }
#pragma unroll
                for (int r = 0; r < 4; ++r) { const size_t o = (row0 + t0 + 4 * fq + r) * DM + g * 16 + fr; const float uu = bf2f(U[o]); Y[o] = (bf16_t)f2bf(gelu_tanh(y[r] + dsk * uu)); }
            }
            uf = un;
        }
        if (!FINAL) ((f32x2*)(ws + MS_S5E))[((b * 128 + g) * S5_NCH + ch) * 64 + lane] = (f32x2){sr, si};
    }
}
__device__ __forceinline__ void s5_carry(unsigned char* ws, int gtid, int gthreads) {
    for (int i = gtid; i < 2 * 128 * 64; i += gthreads) {
        const int p = i & 63, bg = i >> 6, g = bg & 127;
        const f32x2 al = ((const f32x2*)(ws + MS_S5ABL))[g * 64 + p];
        const f32x2* E = (const f32x2*)(ws + MS_S5E) + (size_t)bg * S5_NCH * 64 + p; f32x2* SI = (f32x2*)(ws + MS_S5SIN) + (size_t)bg * S5_NCH * 64 + p;
        float sr = 0.f, si = 0.f;
        for (int c = 0; c < S5_NCH; ++c) { SI[c * 64] = (f32x2){sr, si}; const f32x2 e = E[c * 64]; const float nr = al.x * sr - al.y * si + e.x, ni = al.x * si + al.y * sr + e.y; sr = nr; si = ni; }
    }
}

struct EpiGlu {
    static constexpr bool PERM = true, AFTER_DRAIN = false; bf16_t* O; int ldc;
    __device__ __forceinline__ void operator()(const f32x4 (&acc)[2][2][4][2], const pg8::Unit& u, int wr, int wc, int fr, int fq) const {
        const int col = u.pn * 128 + wc * 32 + 8 * fq;
#pragma unroll
        for (int ai = 0; ai < 2; ++ai)
#pragma unroll
            for (int m = 0; m < 4; ++m) { const int row = u.pm * 256 + ai * 128 + wr * 64 + m * 16 + fr; float o[8];
#pragma unroll
                for (int n = 0; n < 2; ++n)
#pragma unroll
                    for (int i = 0; i < 4; ++i) { const float v = acc[ai][0][m][n][i], gt = acc[ai][1][m][n][i]; o[4 * n + i] = v / (1.f + __expf(-gt)); }
                u32x4 w; w.x = pg8::cvt_pk_bf16(o[0], o[1]); w.y = pg8::cvt_pk_bf16(o[2], o[3]); w.z = pg8::cvt_pk_bf16(o[4], o[5]); w.w = pg8::cvt_pk_bf16(o[6], o[7]);
                *(u32x4*)(O + (size_t)row * ldc + col) = w; }
    }
};
struct EpiSoftmax {
    static constexpr bool PERM = false, AFTER_DRAIN = true; bf16_t* P;
    __device__ __forceinline__ void fused(f32x4 (&acc)[2][2][4][2], const pg8::Unit& u, int wr, int wc, int fr, int fq, LAS unsigned char* lds, int wid, int lane) const {
        LAS f32x2* X = (LAS f32x2*)lds;
        float mw[2][4];
#pragma unroll
        for (int ai = 0; ai < 2; ++ai)
#pragma unroll
            for (int m = 0; m < 4; ++m) {
                float mx = -3.0e38f;
#pragma unroll
                for (int bj = 0; bj < 2; ++bj)
#pragma unroll
                    for (int n = 0; n < 2; ++n)
#pragma unroll
                        for (int i = 0; i < 4; ++i) mx = fmaxf(mx, acc[ai][bj][m][n][i]);
                mx = fmaxf(mx, my_shfl_xor(mx, 16)); mx = fmaxf(mx, my_shfl_xor(mx, 32));
                float sm = 0.f;
#pragma unroll
                for (int bj = 0; bj < 2; ++bj)
#pragma unroll
                    for (int n = 0; n < 2; ++n)
#pragma unroll
                        for (int i = 0; i < 4; ++i) { const float e = __builtin_amdgcn_exp2f(acc[ai][bj][m][n][i] - mx); acc[ai][bj][m][n][i] = e; sm += e; }
                sm += my_shfl_xor(sm, 16); sm += my_shfl_xor(sm, 32);
                mw[ai][m] = mx;
                if (fq == 0) X[(ai * 128 + wr * 64 + m * 16 + fr) * 4 + wc] = (f32x2){mx, sm};
            }
        LDS_WAIT(); __builtin_amdgcn_s_barrier(); asm volatile("" ::: "memory");
#pragma unroll
        for (int ai = 0; ai < 2; ++ai)
#pragma unroll
            for (int m = 0; m < 4; ++m) { const int r = ai * 128 + wr * 64 + m * 16 + fr;
                const f32x2 a = X[r * 4 + 0], b = X[r * 4 + 1], c = X[r * 4 + 2], d = X[r * 4 + 3];
                const float M = fmaxf(fmaxf(a.x, b.x), fmaxf(c.x, d.x));
                const float tot = a.y * __builtin_amdgcn_exp2f(a.x - M) + b.y * __builtin_amdgcn_exp2f(b.x - M) + c.y * __builtin_amdgcn_exp2f(c.x - M) + d.y * __builtin_amdgcn_exp2f(d.x - M);
                const float f = __builtin_amdgcn_exp2f(mw[ai][m] - M) / tot;
                bf16_t* rowp = P + (size_t)(u.pm * 256 + r) * 1024 + u.z * 256 + wc * 32 + 4 * fq;
#pragma unroll
                for (int bj = 0; bj < 2; ++bj)
#pragma unroll
                    for (int n = 0; n < 2; ++n) { const f32x4 v = acc[ai][bj][m][n] * f; u32x2 w; w.x = pg8::cvt_pk_bf16(v[0], v[1]); w.y = pg8::cvt_pk_bf16(v[2], v[3]); *(u32x2*)(rowp + bj * 128 + n * 16) = w; } }
        LDS_WAIT(); __builtin_amdgcn_s_barrier(); asm volatile("" ::: "memory");
    }
};
struct CmpSched {
    int G, c;
    __device__ bool next(int i, pg8::Unit& u) const {
        const int L = i * G + c; if (L >= 128) return false;
        const int which = L >> 6, ks = (L >> 4) & 3, pm = L & 15; u.pm = pm; u.pn = 0; u.z = which * 4 + ks;
        u.ao = (unsigned)(((size_t)which * KVH_SLOT + (size_t)pm * 256 * 2048 + ks * 512) * 2); u.bo = (unsigned)(((size_t)which * 256 * 2048 + ks * 512) * 2);
        return true;
    }
};
struct StoreBf16Z { bf16_t* O; int ldc; float scale; size_t zstride;
    __device__ __forceinline__ void operator()(const pg8::Unit& u, int row, int col, f32x4 v0, f32x4 v1) const {
        u32x4 w; w.x = pg8::cvt_pk_bf16(v0[0] * scale, v0[1] * scale); w.y = pg8::cvt_pk_bf16(v0[2] * scale, v0[3] * scale); w.z = pg8::cvt_pk_bf16(v1[0] * scale, v1[1] * scale); w.w = pg8::cvt_pk_bf16(v1[2] * scale, v1[3] * scale);
        *(u32x4*)(O + (size_t)u.z * zstride + (size_t)row * ldc + col) = w; } };
struct KvSched { int G, c;
    __device__ bool next(int i, pg8::Unit& u) const { const int L = i * G + c; if (L >= 64) return false;
        const int l = L >> 5, pm = (L >> 4) & 1, pn = L & 15; u.pm = pm; u.pn = pn; u.z = l;
        u.ao = (unsigned)((size_t)pm * 256 * 2048 * 2); u.bo = (unsigned)((size_t)l * 16 * MiB + (size_t)pn * 256 * 2048 * 2); return true; } };
struct MtSched { int G, c;
    __device__ bool next(int i, pg8::Unit& u) const { const int L = i * G + c; if (L >= 128 || L < 0) return false;
        const int l = L >> 6, b = (L >> 5) & 1, h = (L >> 3) & 3, pn = L & 7; u.pm = h; u.pn = pn; u.z = l * 2 + b;
        u.ao = (unsigned)((size_t)l * 4 * MiB + ((size_t)(b * 256) * 4096 + h * 512) * 2); u.bo = (unsigned)((size_t)l * 8 * MiB + ((size_t)(pn * 256) * 2048 + h * 512) * 2); return true; } };
struct VwSched { int G, c;
    __device__ bool next(int i, pg8::Unit& u) const { const int L = i * G + c; if (L >= 128 || L < 0) return false;
        const int l = L >> 6, b = (L >> 5) & 1, h = (L >> 3) & 3, pmn = L & 7; u.pm = pmn; u.pn = h; u.z = l * 2 + b;
        u.ao = (unsigned)((size_t)l * 8 * MiB + ((size_t)(pmn * 256) * 2048 + h * 512) * 2); u.bo = (unsigned)((size_t)l * 4 * MiB + ((size_t)(b * 256) * 4096 + 2048 + h * 512) * 2); return true; } };
struct ScoreSched { int G, c, base, lim, layer;
    __device__ bool next(int i, pg8::Unit& u) const { const int L = base + i * G + c; if (L >= lim) return false;
        const int b = L >> 7, pmp = (L >> 2) & 31, h = L & 3; u.pm = b * 32 + pmp; u.pn = 0; u.z = h;
        u.ao = (unsigned)((size_t)(b * SEQ + 256 * pmp) * 2048 * 2); u.bo = (unsigned)((size_t)(layer * 2 + b) * 4 * MiB + (size_t)(h * 256) * 2048 * 2); return true; } };
struct PvoSched { pg8::StaticOrder so; int layer;
    __device__ bool next(int i, pg8::Unit& u) const { if (!so.next(i, u)) return false; u.bo += (unsigned)((size_t)(layer * 2 + (u.pm >> 5)) * 4 * MiB); return true; } };
template <int MODE> struct MemSched {
    int G, c, base, lim;
    __device__ bool next(int i, pg8::Unit& u) const {
        const int L = base + i * G + c; if (L >= lim) return false;
        if (MODE == 0) { const int b = L >> 7, h = (L >> 5) & 3, pmp = L & 31; u.pm = b * 32 + pmp; u.pn = 0; u.z = h;
            u.ao = (unsigned)(((b * SEQ + 256 * pmp) * 2048 + h * 512) * 2); u.bo = (unsigned)(((b * 256) * 2048 + h * 512) * 2); }
        else { const int pn = L & 1, pmp = (L >> 1) & 31, h = (L >> 6) & 3, b = L >> 8; u.pm = b * 32 + pmp; u.pn = h * 2 + pn; u.z = 0;
            u.ao = (unsigned)(((b * SEQ + 256 * pmp) * 1024 + h * 256) * 2); u.bo = (unsigned)(((h * 512 + 256 * pn) * 512 + b * 256) * 2); }
        return true;
    }
};


struct StoreKVQ { bf16_t* KVH; bf16_t* QH; float* GATES; float qscale;
    __device__ __forceinline__ void operator()(const pg8::Unit&, int row, int col, f32x4 v0, f32x4 v1) const {
        const int b = row >> 13, t = row & 8191;
        if (col < 3072) { const int slot = col >> 9, g = (col >> 7) & 3, d = col & 127;
            u32x4 w; w.x = pg8::cvt_pk_bf16(v0[0], v0[1]); w.y = pg8::cvt_pk_bf16(v0[2], v0[3]); w.z = pg8::cvt_pk_bf16(v1[0], v1[1]); w.w = pg8::cvt_pk_bf16(v1[2], v1[3]);
            *(u32x4*)(KVH + ((((size_t)slot * 2 + b) * 4 + g) * 8192 + t) * 128 + d) = w; }
        else if (col < 5120) { const int c2 = col - 3072, head = c2 >> 7, d = c2 & 127, g = head >> 2, r = head & 3; v0 = v0 * qscale; v1 = v1 * qscale;
            u32x4 w; w.x = pg8::cvt_pk_bf16(v0[0], v0[1]); w.y = pg8::cvt_pk_bf16(v0[2], v0[3]); w.z = pg8::cvt_pk_bf16(v1[0], v1[1]); w.w = pg8::cvt_pk_bf16(v1[2], v1[3]);
            *(u32x4*)(QH + ((((size_t)b * 4 + g) * 8192 + t) * 4 + r) * 128 + d) = w; }
        else if (col < 5168) { float* gp = GATES + (size_t)row * 48 + (col - 5120);
#pragma unroll
            for (int i = 0; i < 4; ++i) { v0[i] = 1.f / (1.f + __expf(-v0[i])); v1[i] = 1.f / (1.f + __expf(-v1[i])); }
            *(f32x4*)gp = v0; *(f32x4*)(gp + 4) = v1; }
    } };
struct StoreF32 { float* O; int ldc; size_t zstride;
    __device__ __forceinline__ void operator()(const pg8::Unit& u, int row, int col, f32x4 v0, f32x4 v1) const { float* p = O + (size_t)u.z * zstride + (size_t)row * ldc + col; *(f32x4*)p = v0; *(f32x4*)(p + 4) = v1; } };
__device__ __forceinline__ void cmp_bias(const float* pos_k, const float* w1_k, const float* pos_v, const float* w1_v, float* CB, int tid) {
    if (tid < 256) { const int which = tid >> 7, n = tid & 127; const float* pos = which ? pos_v : pos_k; const float* w1 = which ? w1_v : w1_k; float a = 0.f;
        for (int k = 0; k < 4096; ++k) a += pos[k] * w1[(size_t)k * 128 + n];
        CB[tid] = a; }
}
__device__ __forceinline__ void cmp_combine(const float* PAB, const float* CB, const float* w2k, const float* w2v, bf16_t* KCMP, int gw, int NGW, int lane) {
    asm volatile("" : "+v"(lane));
    for (int it = gw; it < 2 * 4096; it += NGW) {
        const int which = it >> 12, row = it & 4095, c = row & 511;
        bf16_t* out = KCMP + ((size_t)which * 4096 + row) * 128;
        if (c == 511) { out[lane] = 0; out[lane + 64] = 0; continue; }
        const float* P = PAB + (size_t)which * 4 * 4096 * 256; const float* w2 = which ? w2v : w2k;
        float sa = CB[which * 128 + lane], sb = CB[which * 128 + 64 + lane];
#pragma unroll
        for (int ks = 0; ks < 4; ++ks) { const float* Pk = P + (size_t)ks * 4096 * 256;
            sa += Pk[(size_t)row * 256 + lane] + Pk[(size_t)(row + 1) * 256 + 128 + lane]; sb += Pk[(size_t)row * 256 + 64 + lane] + Pk[(size_t)(row + 1) * 256 + 192 + lane]; }
        const float va = gelu_tanh(sa), vb = gelu_tanh(sb);
        float o0 = 0.f, o1 = 0.f;
        for (int n = 0; n < 64; ++n) { const float x = my_shfl(va, n); o0 += x * w2[n * 128 + lane]; o1 += x * w2[n * 128 + 64 + lane]; }
        for (int n = 0; n < 64; ++n) { const float x = my_shfl(vb, n); o0 += x * w2[(64 + n) * 128 + lane]; o1 += x * w2[(64 + n) * 128 + 64 + lane]; }
        out[lane] = (bf16_t)f2bf(o0); out[lane + 64] = (bf16_t)f2bf(o1);
    }
}

namespace nsa {
constexpr int L_K0 = 0, L_V0 = 32768, L_IMP = 65536, IMP_LD = 132, IMP_WAVE = 8 * IMP_LD * 4, L_SELM = L_IMP + 8 * IMP_WAVE, L_UNI = L_SELM + 8 * 128, L_NTL = L_UNI + 16, L_TL = L_NTL + 16, L_WSF = L_TL + 512;
constexpr float NEGB = -1.0e30f;
typedef short v4i16_t __attribute__((ext_vector_type(4)));
__device__ __forceinline__ unsigned off_b(unsigned row, unsigned ch) { return 256u * row + 16u * (ch ^ (((row & 3) << 2) | ((row >> 2) & 3))); }
__device__ __forceinline__ int crow(int r, int hi) { return (r & 3) + 8 * (r >> 2) + 4 * hi; }
__device__ __forceinline__ float xhalf(float v) { return my_shfl_xor(v, 32); }

template <int BR, int MODE>
__device__ __forceinline__ void run_tiles(LAS unsigned char* lds, const bf16_t* Kb, const bf16_t* Vb, int ntiles, int first, int qt, const bf16x8 (&qf)[8], f32x16 (&o)[4], float& l_run,
                                          int t, unsigned selw0, unsigned selw1, unsigned selw2, unsigned selw3, float pscale, float gate, int tid, int wave, int lane) {
    const int l32 = lane & 31, hi = lane >> 5;
    LAS const int* TL = (LAS const int*)(lds + L_TL);
    LAS float* imp = (LAS float*)(lds + L_IMP + wave * IMP_WAVE) + ((l32 >> 2) * IMP_LD);
    const unsigned soff = (unsigned)((4 * wave + (lane >> 4)) * 128 + (((lane & 15) ^ (((lane >> 4) << 2) | (wave & 3))) * 8));
    auto tile_of = [&](int i) -> int { return (BR == 1) ? TL[i] : first + i; };
    auto stage = [&](int tile, int buf) { const bf16_t* ks = Kb + (size_t)tile * 8192 + soff; LAS unsigned char* kd = lds + L_K0 + buf * 16384 + wave * 1024;
        __builtin_amdgcn_global_load_lds((const unsigned*)ks, (LAS unsigned*)kd, 16, 0, 0); __builtin_amdgcn_global_load_lds((const unsigned*)(ks + 4096), (LAS unsigned*)(kd + 8192), 16, 0, 0);
        if (MODE != 0) { const bf16_t* vs = Vb + (size_t)tile * 8192 + soff; LAS unsigned char* vd = lds + L_V0 + buf * 16384 + wave * 1024;
            __builtin_amdgcn_global_load_lds((const unsigned*)vs, (LAS unsigned*)vd, 16, 0, 0); __builtin_amdgcn_global_load_lds((const unsigned*)(vs + 4096), (LAS unsigned*)(vd + 8192), 16, 0, 0); } };
    if (ntiles <= 0) return;
    stage(tile_of(0), 0);
    asm volatile("s_waitcnt vmcnt(0) lgkmcnt(0)" ::: "memory"); __builtin_amdgcn_s_barrier(); asm volatile("" ::: "memory");
    const unsigned kx = ((l32 & 3) << 2) | ((l32 >> 2) & 3);
    const int blk = (lane >> 4) & 1, tq = (lane & 15) >> 2, tp = lane & 3;
    for (int i = 0; i < ntiles; ++i) {
        const int tile = tile_of(i), buf = i & 1;
        if (i + 1 < ntiles) stage(tile_of(i + 1), buf ^ 1);
        bool selbit = true;
        if (BR == 1) { const unsigned w = (tile < 32) ? selw0 : (tile < 64) ? selw1 : (tile < 96) ? selw2 : selw3; selbit = (w >> (tile & 31)) & 1u; }
        const bool active = (BR == 1) ? (bool)__any((int)selbit) : true;
        if (active) {
            LAS const unsigned char* kb = lds + L_K0 + buf * 16384; LAS const unsigned char* vb = lds + L_V0 + buf * 16384;
            f32x16 p0, p1;
#pragma unroll
            for (int r = 0; r < 16; ++r) { p0[r] = 0.f; p1[r] = 0.f; }
            {
                bf16x8 kq0[3], kq1[3];
#define NSA_LDK(s_, slot_) do { const unsigned ko_ = 256u * l32 + 16u * ((unsigned)(2 * (s_) + hi) ^ kx); kq0[slot_] = *(LAS const bf16x8*)(kb + ko_); kq1[slot_] = *(LAS const bf16x8*)(kb + 8192 + ko_); } while (0)
                NSA_LDK(0, 0); NSA_LDK(1, 1);
                __builtin_amdgcn_sched_barrier(0);
#pragma unroll
                for (int s = 0; s < 8; ++s) {
                    if (s + 2 < 8) NSA_LDK(s + 2, (s + 2) % 3);
                    __builtin_amdgcn_sched_barrier(0);
                    p0 = __builtin_amdgcn_mfma_f32_32x32x16_bf16(kq0[s % 3], qf[s], p0, 0, 0, 0); p1 = __builtin_amdgcn_mfma_f32_32x32x16_bf16(kq1[s % 3], qf[s], p1, 0, 0, 0);
                    __builtin_amdgcn_sched_barrier(0);
                }
#undef NSA_LDK
            }
            const int kbase = tile * 64;
            const bool need_mask = (BR == 0) ? true : (BR == 1) ? (tile == qt) : ((tile == qt) || (tile == first && qt >= 8));
            const float ps = (BR == 1) ? (selbit ? pscale : 0.f) : pscale;
            if (need_mask) {
                const int cmax = (t - 31) >> 4;
#pragma unroll
                for (int r = 0; r < 16; ++r) { const int k0i = kbase + crow(r, hi), k1i = k0i + 32; bool v0, v1;
                    if (BR == 0) { v0 = k0i <= cmax; v1 = k1i <= cmax; }
                    else if (BR == 1) { v0 = (k0i <= t); v1 = (k1i <= t); }
                    else { v0 = (k0i <= t) && (k0i > t - 512); v1 = (k1i <= t) && (k1i > t - 512); }
                    p0[r] = v0 ? __builtin_amdgcn_exp2f(p0[r]) * ps : 0.f; p1[r] = v1 ? __builtin_amdgcn_exp2f(p1[r]) * ps : 0.f; }
            } else {
#pragma unroll
                for (int r = 0; r < 16; ++r) { p0[r] = __builtin_amdgcn_exp2f(p0[r]) * ps; p1[r] = __builtin_amdgcn_exp2f(p1[r]) * ps; }
            }
            if (MODE != 1) { float sum = 0.f;
#pragma unroll
                for (int r = 0; r < 16; ++r) sum += p0[r] + p1[r];
                l_run += sum; }
            if (MODE == 1) {
#pragma unroll
                for (int h2 = 0; h2 < 2; ++h2)
#pragma unroll
                    for (int a = 0; a < 4; ++a) { const f32x16& pp = h2 ? p1 : p0; float gs = (pp[4 * a] + pp[4 * a + 1]) + (pp[4 * a + 2] + pp[4 * a + 3]), ls = pp[4 * a + 3];
                        gs += my_shfl_xor(gs, 1); gs += my_shfl_xor(gs, 2); ls += my_shfl_xor(ls, 1); ls += my_shfl_xor(ls, 2);
                        if ((lane & 3) == 0) { const int sidx = 16 * tile + 2 * a + hi + 8 * h2; atomicAdd((float*)(imp + sidx), gs); atomicAdd((float*)(imp + sidx + 1), ls); } }
#pragma unroll
                for (int r = 0; r < 16; ++r) { p0[r] *= gate; p1[r] *= gate; }
            }
            if (MODE != 0) {
                bf16x8 pa[4];
#pragma unroll
                for (int ks = 0; ks < 4; ++ks) { const f32x16& pp = (ks < 2) ? p0 : p1; const int b0 = 8 * (ks & 1); u32x4 w;
                    w.x = pg8::cvt_pk_bf16(pp[b0], pp[b0 + 1]); w.y = pg8::cvt_pk_bf16(pp[b0 + 2], pp[b0 + 3]); w.z = pg8::cvt_pk_bf16(pp[b0 + 4], pp[b0 + 5]); w.w = pg8::cvt_pk_bf16(pp[b0 + 6], pp[b0 + 7]);
                    pa[ks] = __builtin_bit_cast(bf16x8, w); }
                bf16x8 vfr[2][4];
#define NSA_LDV(d_, slot_) do { _Pragma("unroll") for (int ks_ = 0; ks_ < 4; ++ks_) { \
                        const unsigned a0_ = off_b(16 * ks_ + 4 * hi + tq, 4 * (d_) + 2 * blk + (tp >> 1)) + 8 * (tp & 1); \
                        const unsigned a1_ = off_b(16 * ks_ + 8 + 4 * hi + tq, 4 * (d_) + 2 * blk + (tp >> 1)) + 8 * (tp & 1); \
                        const v4i16_t lo_ = __builtin_amdgcn_ds_read_tr16_b64_v4i16((LAS v4i16_t*)(vb + a0_)); \
                        const v4i16_t hv_ = __builtin_amdgcn_ds_read_tr16_b64_v4i16((LAS v4i16_t*)(vb + a1_)); \
                        vfr[slot_][ks_] = (bf16x8){lo_[0], lo_[1], lo_[2], lo_[3], hv_[0], hv_[1], hv_[2], hv_[3]}; } } while (0)
                NSA_LDV(0, 0);
                __builtin_amdgcn_sched_barrier(0);
#pragma unroll
                for (int d = 0; d < 4; ++d) {
                    if (d + 1 < 4) NSA_LDV(d + 1, (d + 1) & 1);
                    __builtin_amdgcn_sched_barrier(0);
#pragma unroll
                    for (int ks = 0; ks < 4; ++ks) o[d] = __builtin_amdgcn_mfma_f32_32x32x16_bf16(pa[ks], vfr[d & 1][ks], o[d], 0, 0, 0);
                    __builtin_amdgcn_sched_barrier(0);
                }
#undef NSA_LDV
            }
        }
        asm volatile("s_waitcnt vmcnt(0) lgkmcnt(0)" ::: "memory"); __builtin_amdgcn_s_barrier(); asm volatile("" ::: "memory");
    }
}

template <int BR>
__device__ __forceinline__ void run_tiles_stag(LAS unsigned char* lds, const bf16_t* Kb, const bf16_t* Vb, int ntiles, int first, int qt, const bf16x8 (&qf)[8], f32x16 (&o)[4], float& l_run,
                                               int t, unsigned selw0, unsigned selw1, unsigned selw2, unsigned selw3, int tid, int wave, int lane) {
    int wv_ = wave; asm volatile("" : "+s"(wv_)); const bool halfB = wv_ >= 4;
    LAS const int* TL = (LAS const int*)(lds + L_TL);
    const unsigned soff = (unsigned)((4 * wave + (lane >> 4)) * 128 + (((lane & 15) ^ (((lane >> 4) << 2) | (wave & 3))) * 8));
    auto tile_of = [&](int i) -> int { return (BR == 1) ? TL[i] : first + i; };
    auto stageK = [&](int tile, int buf) { const bf16_t* ks = Kb + (size_t)tile * 8192 + soff; LAS unsigned char* kd = lds + L_K0 + buf * 16384 + wave * 1024;
        __builtin_amdgcn_global_load_lds((const unsigned*)ks, (LAS unsigned*)kd, 16, 0, 0); __builtin_amdgcn_global_load_lds((const unsigned*)(ks + 4096), (LAS unsigned*)(kd + 8192), 16, 0, 0); };
    auto stageV = [&](int tile, int buf) { const bf16_t* vs = Vb + (size_t)tile * 8192 + soff; LAS unsigned char* vd = lds + L_V0 + buf * 16384 + wave * 1024;
        __builtin_amdgcn_global_load_lds((const unsigned*)vs, (LAS unsigned*)vd, 16, 0, 0); __builtin_amdgcn_global_load_lds((const unsigned*)(vs + 4096), (LAS unsigned*)(vd + 8192), 16, 0, 0); };
    if (ntiles <= 0) return;
    { const int t0_ = tile_of(0); stageK(t0_, 0); stageV(t0_, 0); }
    asm volatile("s_waitcnt vmcnt(0) lgkmcnt(0)" ::: "memory"); __builtin_amdgcn_s_barrier(); asm volatile("" ::: "memory");
    bf16x8 pa[4]; bool act = false;
#pragma unroll
    for (int ks = 0; ks < 4; ++ks) pa[ks] = (bf16x8){0, 0, 0, 0, 0, 0, 0, 0};
    auto qk_sm = [&](int tile, int buf) {
        bool selbit = true;
        if (BR == 1) { const unsigned w = (tile < 32) ? selw0 : (tile < 64) ? selw1 : (tile < 96) ? selw2 : selw3; selbit = (w >> (tile & 31)) & 1u; }
        act = (BR == 1) ? (bool)__any((int)selbit) : true;
        if (!act) return;
        int lv = lane; asm volatile("" : "+v"(lv));
        const int l32 = lv & 31, hi = lv >> 5; const unsigned kx = ((l32 & 3) << 2) | ((l32 >> 2) & 3);
        LAS const unsigned char* kb = lds + L_K0 + buf * 16384;
        const int kbase = tile * 64;
        const bool need_mask = (BR == 1) ? (tile == qt) : ((tile == qt) || (tile == first && qt >= 8));
        const float ps = (BR == 1) ? (selbit ? 1.f : 0.f) : 1.f;
        float sum = 0.f;
#pragma unroll
        for (int h2 = 0; h2 < 2; ++h2) {
            f32x16 pp;
#pragma unroll
            for (int r = 0; r < 16; ++r) pp[r] = 0.f;
            {
                bf16x8 kq[2];
#define NSA_LDK(s_, slot_) do { const unsigned ko_ = 256u * l32 + 16u * ((unsigned)(2 * (s_) + hi) ^ kx); kq[slot_] = *(LAS const bf16x8*)(kb + h2 * 8192 + ko_); } while (0)
                NSA_LDK(0, 0); NSA_LDK(1, 1);
                __builtin_amdgcn_sched_barrier(0);
#pragma unroll
                for (int s = 0; s < 8; s += 2) {
                    pp = __builtin_amdgcn_mfma_f32_32x32x16_bf16(kq[0], qf[s], pp, 0, 0, 0);
                    if (s + 2 < 8) NSA_LDK(s + 2, 0);
                    pp = __builtin_amdgcn_mfma_f32_32x32x16_bf16(kq[1], qf[s + 1], pp, 0, 0, 0);
                    if (s + 3 < 8) NSA_LDK(s + 3, 1);
                    __builtin_amdgcn_sched_barrier(0);
                }
#undef NSA_LDK
            }
            if (need_mask) {
#pragma unroll
                for (int r = 0; r < 16; ++r) { const int ki = kbase + 32 * h2 + crow(r, hi); bool v0;
                    if (BR == 1) v0 = (ki <= t); else v0 = (ki <= t) && (ki > t - 512);
                    pp[r] = v0 ? __builtin_amdgcn_exp2f(pp[r]) * ps : 0.f; }
            } else {
#pragma unroll
                for (int r = 0; r < 16; ++r) pp[r] = __builtin_amdgcn_exp2f(pp[r]) * ps;
            }
#pragma unroll
            for (int r = 0; r < 16; ++r) sum += pp[r];
#pragma unroll
            for (int kk = 0; kk < 2; ++kk) { const int b0 = 8 * kk; u32x4 w;
                w.x = pg8::cvt_pk_bf16(pp[b0], pp[b0 + 1]); w.y = pg8::cvt_pk_bf16(pp[b0 + 2], pp[b0 + 3]); w.z = pg8::cvt_pk_bf16(pp[b0 + 4], pp[b0 + 5]); w.w = pg8::cvt_pk_bf16(pp[b0 + 6], pp[b0 + 7]);
                pa[2 * h2 + kk] = __builtin_bit_cast(bf16x8, w); }
        }
        l_run += sum;
    };
    auto pv = [&](int buf) {
        int lv = lane; asm volatile("" : "+v"(lv));
        const int hi = lv >> 5, blk = (lv >> 4) & 1, tq = (lv & 15) >> 2, tp = lv & 3;
        LAS const unsigned char* vb = lds + L_V0 + buf * 16384;
        bf16x8 vfr[3];
#define NSA_LDV(j_, slot_) do { const int d_ = (j_) >> 2, ks_ = (j_) & 3; \
                const unsigned a0_ = off_b(16 * ks_ + 4 * hi + tq, 4 * d_ + 2 * blk + (tp >> 1)) + 8 * (tp & 1); \
                const unsigned a1_ = off_b(16 * ks_ + 8 + 4 * hi + tq, 4 * d_ + 2 * blk + (tp >> 1)) + 8 * (tp & 1); \
                const v4i16_t lo_ = __builtin_amdgcn_ds_read_tr16_b64_v4i16((LAS v4i16_t*)(vb + a0_)); \
                const v4i16_t hv_ = __builtin_amdgcn_ds_read_tr16_b64_v4i16((LAS v4i16_t*)(vb + a1_)); \
                vfr[slot_] = (bf16x8){lo_[0], lo_[1], lo_[2], lo_[3], hv_[0], hv_[1], hv_[2], hv_[3]}; } while (0)
        NSA_LDV(0, 0); NSA_LDV(1, 1);
        __builtin_amdgcn_sched_barrier(0);
#pragma unroll
        for (int j = 0; j < 16; ++j) {
            if (j + 2 < 16) NSA_LDV(j + 2, (j + 2) % 3);
            __builtin_amdgcn_sched_barrier(0);
            o[j >> 2] = __builtin_amdgcn_mfma_f32_32x32x16_bf16(pa[j & 3], vfr[j % 3], o[j >> 2], 0, 0, 0);
            __builtin_amdgcn_sched_barrier(0);
        }
#undef NSA_LDV
    };
#define NSA_SLOT_END() do { asm volatile("s_waitcnt vmcnt(0) lgkmcnt(0)" ::: "memory"); __builtin_amdgcn_s_barrier(); asm volatile("" ::: "memory"); } while (0)
    const int hsel = halfB ? 1 : 0;
    for (int sl = 0; sl <= 2 * ntiles; ++sl) {
        const int inext = (sl >> 1) + 1;
        const bool staged = inext < ntiles;
        if (staged) { const int tn = tile_of(inext); if (sl & 1) stageV(tn, inext & 1); else stageK(tn, inext & 1); }
        if ((sl & 1) == hsel) { const int i = (sl - hsel) >> 1; if (i < ntiles) qk_sm(tile_of(i), i & 1); }
        else { const int i = (sl - 1 - hsel) >> 1; if (sl - 1 - hsel >= 0 && i < ntiles && act) pv(i & 1); }
        if (staged) asm volatile("s_waitcnt vmcnt(2) lgkmcnt(0)" ::: "memory"); else asm volatile("s_waitcnt vmcnt(0) lgkmcnt(0)" ::: "memory");
        __builtin_amdgcn_s_barrier(); asm volatile("" ::: "memory");
    }
#undef NSA_SLOT_END
}

template <bool FIRST>
__device__ __forceinline__ void flush(f32x16 (&o)[4], float fac, bf16_t* Obase, LAS float* wsf, int l32, int hi) {
    if (hi == 0) wsf[l32] = fac;
    LDS_WAIT(); asm volatile("" ::: "memory");
    bf16_t* pa = Obase + (size_t)hi * DM + l32;
#pragma unroll
    for (int a = 0; a < 4; ++a) { const f32x4 f = *(LAS const f32x4*)(wsf + 8 * a + 4 * hi);
        asm volatile("" : "+v"(pa));
#pragma unroll
        for (int i2 = 0; i2 < 4; ++i2)
#pragma unroll
            for (int d = 0; d < 4; ++d) { bf16_t* op = pa + i2 * 128 + 32 * d; float v = o[d][4 * a + i2] * f[i2]; if (!FIRST) v += bf2f(*op); *op = (bf16_t)f2bf(v); o[d][4 * a + i2] = 0.f; }
        pa += 2 * DM; }
    LDS_WAIT(); asm volatile("" ::: "memory");
}

__device__ __forceinline__ void unit(LAS unsigned char* lds, const bf16_t* KVH, const bf16_t* QH, const bf16_t* KCMP, const float* GATES, bf16_t* O, int b, int g, int qt, int tid, int wave, int lane) {
    asm volatile("" : "+v"(tid)); lane = tid & 63; wave = __builtin_amdgcn_readfirstlane(tid >> 6);
    const int l32 = lane & 31, hi = lane >> 5, tokl = l32 >> 2, rr = l32 & 3;
    const int t0 = qt * 64, t = t0 + wave * 8 + tokl;
    const size_t bg = (size_t)b * 4 + g;
    LAS float* impw = (LAS float*)(lds + L_IMP + wave * IMP_WAVE);
    LAS unsigned* selm = (LAS unsigned*)(lds + L_SELM + wave * 128);
    LAS unsigned* uni = (LAS unsigned*)(lds + L_UNI);
    LAS int* NTL = (LAS int*)(lds + L_NTL); LAS int* TL = (LAS int*)(lds + L_TL);
    LAS float* wsf = (LAS float*)(lds + L_WSF + wave * 128);
    for (int i = lane; i < 8 * IMP_LD; i += 64) impw[i] = 0.f;
    if (tid < 4) uni[tid] = 0u;
    bf16x8 qf[8];
    { const bf16_t* qp = QH + ((bg * 8192 + t0 + wave * 8) * 4 + l32) * 128 + 8 * hi;
#pragma unroll
      for (int s = 0; s < 8; ++s) qf[s] = *(const bf16x8*)(qp + 16 * s); }
    const float* gp = GATES + ((size_t)b * 8192 + t) * 48 + (g * 4 + rr) * 3;
    const float g_cmp = gp[0], g_slc = gp[1], g_win = gp[2];
    bf16_t* Obase = O + ((size_t)b * 8192 + t0 + wave * 8) * DM + g * 512;
    f32x16 o[4];
#pragma unroll
    for (int d = 0; d < 4; ++d)
#pragma unroll
        for (int r = 0; r < 16; ++r) o[d][r] = 0.f;
    LDS_WAIT(); __builtin_amdgcn_s_barrier(); asm volatile("" ::: "memory");
    const bf16_t* Kc = KCMP + bg * 512 * 128; const bf16_t* Vc = KCMP + (size_t)4096 * 128 + bg * 512 * 128;
    const int ntc = ((4 * qt + 2) >> 6) + 1;
    { float l = 0.f;
      run_tiles<0, 0>(lds, Kc, Vc, ntc, 0, qt, qf, o, l, t, 0u, 0u, 0u, 0u, 1.f, 1.f, tid, wave, lane);
      const float ltot = l + xhalf(l); const float inv = ltot > 0.f ? 1.f / ltot : 0.f;
      run_tiles<0, 1>(lds, Kc, Vc, ntc, 0, qt, qf, o, l, t, 0u, 0u, 0u, 0u, inv, g_cmp, tid, wave, lane); }
    flush<true>(o, 1.f, Obase, wsf, l32, hi);
    {
        const int tk = lane >> 3, j = lane & 7; const int nvalid = qt + 1;
        unsigned m0 = 0u, m1 = 0u, m2 = 0u, m3 = 0u;
        auto setbit = [&](int s) { const unsigned bit = 1u << (s & 31); const int w = s >> 5; m0 |= (w == 0) ? bit : 0u; m1 |= (w == 1) ? bit : 0u; m2 |= (w == 2) ? bit : 0u; m3 |= (w == 3) ? bit : 0u; };
        if (nvalid <= 16) { for (int s2 = 0; s2 < nvalid; ++s2) setbit(s2); }
        else {
            setbit(0); setbit(qt); setbit(qt - 1);
            unsigned key[16];
#pragma unroll
            for (int i = 0; i < 16; ++i) { const int s2 = 16 * j + i; const float v = impw[tk * IMP_LD + s2];
                const bool cand = (s2 < nvalid) && (s2 != 0) && (s2 != qt) && (s2 != qt - 1);
                key[i] = cand ? ((__float_as_uint(fmaxf(v, 0.f)) & ~0x7Fu) + (unsigned)(128 - s2)) : 0u; }
            for (int round = 0; round < 13; ++round) {
                unsigned mx = key[0];
#pragma unroll
                for (int i = 1; i < 16; ++i) mx = mx > key[i] ? mx : key[i];
                unsigned o1 = (unsigned)my_shfl_xor((int)mx, 1); mx = mx > o1 ? mx : o1;
                o1 = (unsigned)my_shfl_xor((int)mx, 2); mx = mx > o1 ? mx : o1;
                o1 = (unsigned)my_shfl_xor((int)mx, 4); mx = mx > o1 ? mx : o1;
                if (mx != 0u) { const int sw = (128 - (int)(mx & 0x7Fu)) & 127; setbit(sw); }
#pragma unroll
                for (int i = 0; i < 16; ++i) key[i] = (key[i] == mx) ? 0u : key[i];
            }
        }
        if (j == 0) { selm[tk * 4 + 0] = m0; selm[tk * 4 + 1] = m1; selm[tk * 4 + 2] = m2; selm[tk * 4 + 3] = m3;
            atomicOr((unsigned*)(uni + 0), m0); atomicOr((unsigned*)(uni + 1), m1); atomicOr((unsigned*)(uni + 2), m2); atomicOr((unsigned*)(uni + 3), m3); }
    }
    LDS_WAIT(); __builtin_amdgcn_s_barrier(); asm volatile("" ::: "memory");
    if (tid == 0) { int n = 0; for (int w = 0; w < 4; ++w) { unsigned u = uni[w]; while (u) { const int bpos = __builtin_ctz(u); u &= u - 1; TL[n++] = 32 * w + bpos; } } NTL[0] = n; }
    LDS_WAIT(); __builtin_amdgcn_s_barrier(); asm volatile("" ::: "memory");
    const unsigned sw0 = selm[tokl * 4 + 0], sw1 = selm[tokl * 4 + 1], sw2 = selm[tokl * 4 + 2], sw3 = selm[tokl * 4 + 3];
    const int nsel = __builtin_amdgcn_readfirstlane(NTL[0]);
    { const bf16_t* Ks = KVH + 2 * KVH_SLOT + bg * 8192 * 128; const bf16_t* Vs = KVH + 3 * KVH_SLOT + bg * 8192 * 128;
      float l = 0.f;
      run_tiles<1, 2>(lds, Ks, Vs, nsel, 0, qt, qf, o, l, t, sw0, sw1, sw2, sw3, 1.f, 1.f, tid, wave, lane);
      const float ltot = l + xhalf(l);
      flush<false>(o, ltot > 0.f ? g_slc / ltot : 0.f, Obase, wsf, l32, hi); }
    { const bf16_t* Kw = KVH + 4 * KVH_SLOT + bg * 8192 * 128; const bf16_t* Vw = KVH + 5 * KVH_SLOT + bg * 8192 * 128;
      const int first = qt >= 8 ? qt - 8 : 0; float l = 0.f;
      run_tiles<2, 2>(lds, Kw, Vw, qt - first + 1, first, qt, qf, o, l, t, 0u, 0u, 0u, 0u, 1.f, 1.f, tid, wave, lane);
      const float ltot = l + xhalf(l);
      flush<false>(o, ltot > 0.f ? g_win / ltot : 0.f, Obase, wsf, l32, hi); }
    LDS_WAIT(); __builtin_amdgcn_s_barrier(); asm volatile("" ::: "memory");
}
}


constexpr size_t WS_CTL = WS_MISC + 63 * MiB; constexpr size_t CTL_ZERO_BYTES = 16384;
#define XB_TMO      128
#define XB_XCNT(j)  (256  + 64 * (j))
#define XB_XSUB(j)  (1280 + 64 * (j))
#define XB_XGEN(j)  (2304 + 64 * (j))
#define XB_TOP      3328
#define XB_TOPGEN   3392
#define XB_SPIN_CAP (1u << 18)
__device__ __forceinline__ unsigned xb_ld(unsigned* p)              { return __hip_atomic_load(p, __ATOMIC_RELAXED, __HIP_MEMORY_SCOPE_AGENT); }
__device__ __forceinline__ unsigned xb_add(unsigned* p, unsigned v) { return __hip_atomic_fetch_add(p, v, __ATOMIC_RELAXED, __HIP_MEMORY_SCOPE_AGENT); }
__device__ __forceinline__ unsigned xb_xcc_id() { return (unsigned)__builtin_amdgcn_s_getreg((3 << 11) | 20) & 0xFu; }
#define XB_SPIN(cond, bar) do { unsigned _sp = 0; while (cond) { __builtin_amdgcn_s_sleep(1); \
    if ((++_sp & 255u) == 0u) { if (xb_ld(&(bar)[XB_TMO])) break; if (_sp > XB_SPIN_CAP) { atomicAdd(&(bar)[XB_TMO], 1u); break; } } } } while (0)
struct XcdBarrier { unsigned* bar; unsigned x; volatile LAS unsigned* st; };
__device__ __forceinline__ XcdBarrier xcd_barrier_post(unsigned* bar, volatile LAS unsigned* st, bool t0) {
    XcdBarrier b; b.bar = bar; b.x = xb_xcc_id(); b.st = st;
    if (t0) (void)xb_add(&bar[XB_XCNT(b.x)], 1u);
    return b;
}
__device__ __forceinline__ void xcd_barrier_complete(unsigned* bar, unsigned x, unsigned& nloc, unsigned& nx) {
    const unsigned G = gridDim.x * gridDim.y * gridDim.z;
    unsigned sum, cnt, mine, sp = 0u;
    for (;;) {
        sum = 0u; cnt = 0u; mine = 0u;
#pragma unroll
        for (unsigned j = 0; j < 16; ++j) { const unsigned c = xb_ld(&bar[XB_XCNT(j)]); sum += c; cnt += (c > 0u) ? 1u : 0u; mine = (j == x) ? c : mine; }
        if (sum == G) break;
        __builtin_amdgcn_s_sleep(1);
        if ((++sp & 255u) == 0u) { if (xb_ld(&bar[XB_TMO])) break; if (sp > XB_SPIN_CAP) { atomicAdd(&bar[XB_TMO], 1u); break; } }
    }
    nloc = mine > 0u ? mine : 1u; nx = cnt > 0u ? cnt : 1u;
}
__device__ __forceinline__ void xcd_barrier(const XcdBarrier& b, bool t0) {
    asm volatile("s_waitcnt vmcnt(0)" ::: "memory");
    __syncthreads();
    if (t0) {
        unsigned* bar = b.bar;
        __builtin_amdgcn_s_waitcnt(0);
        unsigned nloc = b.st[0], nx = b.st[1];
        if (nloc == 0u) { xcd_barrier_complete(bar, b.x, nloc, nx); b.st[0] = nloc; b.st[1] = nx; }
        const unsigned old = xb_add(&bar[XB_XSUB(b.x)], 1u);
        const unsigned gen = old / nloc;
        if (old + 1u == (gen + 1u) * nloc) {
            __builtin_amdgcn_fence(__ATOMIC_RELEASE, "agent");
            asm volatile("s_waitcnt vmcnt(0)" ::: "memory");
            const unsigned og = xb_add(&bar[XB_TOP], 1u);
            const unsigned tg = og / nx;
            if (og + 1u == (tg + 1u) * nx) xb_add(&bar[XB_TOPGEN], 1u);
            else XB_SPIN(xb_ld(&bar[XB_TOPGEN]) == tg, bar);
            __builtin_amdgcn_fence(__ATOMIC_ACQUIRE, "agent");
            xb_add(&bar[XB_XGEN(b.x)], 1u);
            asm volatile("s_waitcnt vmcnt(0)" ::: "memory");
        } else {
            XB_SPIN(xb_ld(&bar[XB_XGEN(b.x)]) == gen, bar);
            __builtin_amdgcn_fence(__ATOMIC_ACQUIRE, "agent");
            asm volatile("s_waitcnt vmcnt(0)" ::: "memory");
        }
    }
    __syncthreads();
}

__global__ void __launch_bounds__(NTHREADS, 2) fwd_kernel(Args args) {
    extern __shared__ __attribute__((aligned(16))) unsigned char lds_raw[];
    LAS unsigned char* lds = (LAS unsigned char*)lds_raw;
    cg::grid_group grid = cg::this_grid();
    const int G = gridDim.x;
    const int NGW = G * NWAVES, gthreads = G * NTHREADS;
#define bid ({ int b_ = (int)blockIdx.x; asm volatile("" : "+s"(b_)); b_; })
    const int wave0 = __builtin_amdgcn_readfirstlane((int)threadIdx.x >> 6);
#define lane ({ int l_; asm volatile("v_mbcnt_lo_u32_b32 %0, -1, 0\n\tv_mbcnt_hi_u32_b32 %0, -1, %0" : "=v"(l_)); l_; })
#define wave wave0
#define tid (wave0 * 64 + lane)
#define gw (bid * NWAVES + wave)
#define gtid (bid * NTHREADS + tid)
#define ws ((unsigned char*)argp(30))
#define XF ((float*)argp(29))
#define XB ((bf16_t*)(ws + WS_XB))
#define HID ((bf16_t*)(ws + OV_HID))
#define ln_g INP(I_LNG)
#define ln_b INP(I_LNB)
#define T1 ((bf16_t*)(ws + OV_T1))
#define T2 ((bf16_t*)(ws + OV_T2))
#define T3 ((bf16_t*)(ws + OV_T3))
#define STP ((f32x2*)(ws + MS_STATS))
#define GSYNC_CG() do { asm volatile("s_waitcnt vmcnt(0) lgkmcnt(0)" ::: "memory"); grid.sync(); asm volatile("s_waitcnt vmcnt(0) lgkmcnt(0)" ::: "memory"); __builtin_amdgcn_s_barrier(); asm volatile("" ::: "memory"); } while (0)
#define GSYNC() do { asm volatile("s_waitcnt vmcnt(0) lgkmcnt(0)" ::: "memory"); XcdBarrier xb_; xb_.bar = (unsigned*)(ws + WS_CTL); xb_.x = xb_xcc_id(); xb_.st = (volatile LAS unsigned*)(lds + LDS_BYTES - 64); xcd_barrier(xb_, tid == 0); asm volatile("" ::: "memory"); } while (0)
    volatile LAS unsigned* xst = (volatile LAS unsigned*)(lds + LDS_BYTES - 64);
    if (tid == 0) { xst[0] = 0u; xst[1] = 0u; }
    __syncthreads();
    (void)xcd_barrier_post((unsigned*)(ws + WS_CTL), xst, tid == 0);

    {
        LAS float* scr = (LAS float*)(lds + wave * 16384);
        conv_matrix<0>(INP(I_S5_WIN), 2048, 2048, 2048, (bf16_t*)(ws + WS_WIN), 2048, 0, scr, gw, NGW, lane);
        conv_matrix<1>(INP(I_S5_WGLU), 2048, 4096, 4096, (bf16_t*)(ws + WS_WGLU), 2048, 0, scr, gw, NGW, lane);
        conv_matrix<0>(INP(I_S5_WOUT), 2048, 2048, 2048, (bf16_t*)(ws + WS_WOUT), 2048, 0, scr, gw, NGW, lane);
        conv_matrix<0>(INP(I_KVW), 2048, 3072, 3072, (bf16_t*)(ws + WS_WKVQ), 2048, 0, scr, gw, NGW, lane);
        conv_matrix<0>(INP(I_WQG), 2048, 2096, 2048, (bf16_t*)(ws + WS_WKVQ), 2048, 3072, scr, gw, NGW, lane);
        conv_matrix<0>(INP(I_WQG) + 2048, 2048, 2096, 48, (bf16_t*)(ws + WS_WKVQ), 2048, 5120, scr, gw, NGW, lane);
        conv_matrix<0>(INP(I_WNO), 2048, 2048, 2048, (bf16_t*)(ws + WS_WNO), 2048, 0, scr, gw, NGW, lane);
        for (int l = 0; l < 2; ++l) {
            cvt_rows(INP(I_MWQ) + (size_t)l * 2048 * 2048, (bf16_t*)(ws + WS_WMQ + l * 8 * MiB), (size_t)2048 * 2048, gtid, gthreads);
            conv_matrix<0>(INP(I_MWKV) + (size_t)l * 2048 * 4096, 2048, 4096, 4096, (bf16_t*)(ws + WS_WMKV + l * 16 * MiB), 2048, 0, scr, gw, NGW, lane);
            conv_matrix<0>(INP(I_MWO) + (size_t)l * 2048 * 2048, 2048, 2048, 2048, (bf16_t*)(ws + WS_WMO + l * 8 * MiB), 2048, 0, scr, gw, NGW, lane);
            conv_matrix<0>(INP(I_WUP) + (size_t)l * 2048 * 8192, 2048, 8192, 8192, (bf16_t*)(ws + WS_WUP + l * 32 * MiB), 2048, 0, scr, gw, NGW, lane);
            conv_matrix<0>(INP(I_WDN) + (size_t)l * 8192 * 2048, 8192, 2048, 2048, (bf16_t*)(ws + WS_WDN + l * 32 * MiB), 8192, 0, scr, gw, NGW, lane);
        }
        cvt_rows(INP(I_X), XB, (size_t)MTOK * DM, gtid, gthreads);
        cvt_rows(INP(I_MEM), (bf16_t*)(ws + MS_MEMB), (size_t)512 * DM, gtid, gthreads);
        for (int q = 0; q < 4; ++q) { const int which = q >> 1, half = q & 1;
            conv_matrix<0>((which ? INP(I_CW1V) : INP(I_CW1K)) + (size_t)half * 2048 * 128, 2048, 128, 128, (bf16_t*)(ws + WS_WC1 + which * MiB), 2048, 128 * half, scr, gw, NGW, lane); }
        if (bid == G - 1) cmp_bias(INP(I_CPK), INP(I_CW1K), INP(I_CPV), INP(I_CW1V), (float*)(ws + MS_CB), tid);
        s5_tables(INP(I_S5_ARE), INP(I_S5_AIM), INP(I_S5_LOGDT), INP(I_S5_BRE), INP(I_S5_BIM), INP(I_S5_CRE), INP(I_S5_CIM), ws, gtid, gthreads);
    }
    GSYNC_CG();
    for (int layer = 0; layer < 2; ++layer) {

        if (layer == 0) {
            { pg8::Gemm g{XB, (const bf16_t*)(ws + WS_WIN), DM, DM, DM}; pg8::StaticOrder S; S.init(MTOK, DM, DM, DM, G, bid);
              pg8::EpiCols8<StoreBf16> E{StoreBf16{T1, DM, 1.f}}; pg8::gemm_phase(lds, g, S, E, wave0); }
            { pg8::Gemm g{(const bf16_t*)(ws + MS_MEMB), (const bf16_t*)(ws + WS_WMKV), DM, DM, DM}; KvSched S{G, bid};
              pg8::EpiCols8<StoreBf16Z> E{StoreBf16Z{(bf16_t*)(ws + MS_MKV), 4096, 1.f, (size_t)512 * 4096}}; pg8::gemm_phase(lds, g, S, E, wave0); }
            GSYNC();
            s5_pass<false>(T1, T2, INP(I_S5_D), ws, lds, gw, NGW, wave, lane);
            GSYNC();
            s5_pass<true>(T1, T2, INP(I_S5_D), ws, lds, gw, NGW, wave, lane);
            GSYNC();
            { pg8::Gemm g{T2, (const bf16_t*)(ws + WS_WGLU), DM, DM, DM}; pg8::StaticOrder S; S.init(MTOK, 2 * DM, DM, DM, G, bid);
              EpiGlu E{T1, DM}; pg8::gemm_phase(lds, g, S, E, wave0); }
            { pg8::Gemm g{(const bf16_t*)(ws + MS_MKV), (const bf16_t*)(ws + WS_WMQ), 4096, 2048, 512}; MtSched S{G, bid};
              pg8::EpiCols8<StoreBf16Z> E{StoreBf16Z{(bf16_t*)(ws + WS_MT), 2048, 0.044194173824159216f * 1.4426950408889634f, (size_t)1024 * 2048}}; pg8::gemm_phase(lds, g, S, E, wave0); }
            { pg8::Gemm g{(const bf16_t*)(ws + WS_WMO), (const bf16_t*)(ws + MS_MKV), 2048, 4096, 512}; VwSched S{G, (G == 256) ? ((bid + 128) & 255) : bid};
              pg8::EpiCols8<StoreBf16Z> E{StoreBf16Z{(bf16_t*)(ws + WS_VWT), 1024, 1.f, (size_t)2048 * 1024}}; pg8::gemm_phase(lds, g, S, E, wave0); }
            GSYNC();
            { pg8::Gemm g{T1, (const bf16_t*)(ws + WS_WOUT), DM, DM, DM}; pg8::StaticOrder S; S.init(MTOK, DM, DM, DM, G, bid);
              pg8::EpiRes<0> E{INP(I_X), XF, nullptr, nullptr, nullptr, DM, DN_ALPHA}; pg8::gemm_phase(lds, g, S, E, wave0); }
            GSYNC();
            ln_phase<false>(XF, 1.f, XF, XB, STP, ln_g + (layer * 3 + 0) * DM, ln_b + (layer * 3 + 0) * DM, gw, NGW, lane);
        } else {
            { pg8::Gemm g{XB, (const bf16_t*)(ws + WS_WKVQ), DM, DM, DM}; pg8::StaticOrder S; S.init(MTOK, 5376, DM, DM, G, bid);
              pg8::EpiCols8<StoreKVQ> E{StoreKVQ{(bf16_t*)(ws + OV_KVH), (bf16_t*)(ws + OV_QH), (float*)(ws + MS_GATES), 0.08838834764831845f * 1.4426950408889634f}}; pg8::gemm_phase(lds, g, S, E, wave0); }
            GSYNC();
            { pg8::Gemm g{(const bf16_t*)(ws + OV_KVH), (const bf16_t*)(ws + WS_WC1), 2048, 2048, 512}; CmpSched S{G, bid};
              pg8::EpiCols8<StoreF32> E{StoreF32{(float*)(ws + MS_PAB), 256, (size_t)4096 * 256}}; pg8::gemm_phase(lds, g, S, E, wave0); }
            GSYNC();
            cmp_combine((const float*)(ws + MS_PAB), (const float*)(ws + MS_CB), INP(I_CW2K), INP(I_CW2V), (bf16_t*)(ws + MS_KCMP), gw, NGW, lane);
            GSYNC();
            for (int vb = bid; vb < 256; vb += G) {
                const int bgi = vb >> 5, sidx = vb & 31;
                for (int i = 0; i < 4; ++i) { const int qt = (i == 0) ? sidx : (i == 1) ? 63 - sidx : (i == 2) ? 64 + sidx : 127 - sidx;
                    nsa::unit(lds, (const bf16_t*)(ws + OV_KVH), (const bf16_t*)(ws + OV_QH), (const bf16_t*)(ws + MS_KCMP), (const float*)(ws + MS_GATES), T1, bgi >> 2, bgi & 3, qt, tid, wave, lane); }
            }
            GSYNC();
            { pg8::Gemm g{T1, (const bf16_t*)(ws + WS_WNO), DM, DM, DM}; pg8::StaticOrder S; S.init(MTOK, DM, DM, DM, G, bid);
              pg8::EpiRes<1> E{XF, XF, STP, ln_g + 2 * DM, ln_b + 2 * DM, DM, DN_ALPHA}; pg8::gemm_phase(lds, g, S, E, wave0); }
            GSYNC();
            ln_phase<false>(XF, 1.f, XF, XB, STP, ln_g + (layer * 3 + 0) * DM, ln_b + (layer * 3 + 0) * DM, gw, NGW, lane);
        }
        GSYNC();
        for (int base = 0; base < 256; base += G) {
            pg8::Gemm g{XB, (const bf16_t*)(ws + WS_MT), DM, DM, DM}; ScoreSched S{G, bid, base, (base + G < 256) ? base + G : 256, layer};
            EpiSoftmax E{T2}; pg8::gemm_phase(lds, g, S, E, wave0);
        }
        GSYNC();
        { pg8::Gemm g{T2, (const bf16_t*)(ws + WS_VWT), 1024, 1024, 1024}; PvoSched S; S.so.init(MTOK, DM, 1024, 1024, G, bid); S.layer = layer;
          pg8::EpiRes<1> E{XF, XF, STP, ln_g + (layer * 3 + 0) * DM, ln_b + (layer * 3 + 0) * DM, DM, DN_ALPHA}; pg8::gemm_phase(lds, g, S, E, wave0); }
        GSYNC();
        ln_phase<false>(XF, 1.f, XF, XB, STP, ln_g + (layer * 3 + 1) * DM, ln_b + (layer * 3 + 1) * DM, gw, NGW, lane);
        GSYNC();
        {
            pg8::Gemm g{XB, (const bf16_t*)(ws + WS_WUP + layer * 32 * MiB), DM, DM, DM};
            pg8::StaticOrder S; S.init(MTOK, DFF, DM, DM, G, bid);
            pg8::EpiCols8<StoreRelu2> E{StoreRelu2{HID, DFF}};
            pg8::gemm_phase(lds, g, S, E, wave0);
        }
        GSYNC();
        {
            pg8::Gemm g{HID, (const bf16_t*)(ws + WS_WDN + layer * 32 * MiB), DFF, DFF, DFF};
            pg8::StaticOrder S; S.init(MTOK, DM, DFF, DFF, G, bid);
            pg8::EpiRes<1> E{XF, XF, STP, ln_g + (layer * 3 + 1) * DM, ln_b + (layer * 3 + 1) * DM, DM, DN_ALPHA};
            pg8::gemm_phase(lds, g, S, E, wave0);
        }
        GSYNC();
        if (layer == 1) ln_phase<true>(XF, 1.f, XF, XB, STP, ln_g + (layer * 3 + 2) * DM, ln_b + (layer * 3 + 2) * DM, gw, NGW, lane);
        else ln_phase<false>(XF, 1.f, XF, XB, STP, ln_g + (layer * 3 + 2) * DM, ln_b + (layer * 3 + 2) * DM, gw, NGW, lane);
        GSYNC();
    }
}

#undef ws
#undef XF
#undef XB
#undef HID
#undef ln_g
#undef ln_b
#undef T1
#undef T2
#undef T3
#undef STP
#undef bid
#undef tid
#undef lane
#undef wave
#undef gw
#undef gtid
extern "C" void kernel_launch(void* const* d_in, const int* in_sizes, int n_in, void* d_out, int out_size, void* d_ws, size_t ws_size, hipStream_t stream) {
    static int grid = 0;
    if (grid == 0) {
        if (n_in != 29 || ws_size < WS_END) { fprintf(stderr, "kernel_launch: unexpected n_in %d or ws %zu (< %zu)\n", n_in, ws_size, (size_t)WS_END); grid = -1; return; }
        int dev = 0, cus = 0, per_cu = 0;
        hipGetDevice(&dev); hipDeviceGetAttribute(&cus, hipDeviceAttributeMultiprocessorCount, dev);
        hipFuncSetAttribute((const void*)fwd_kernel, hipFuncAttributeMaxDynamicSharedMemorySize, LDS_BYTES);
        hipOccupancyMaxActiveBlocksPerMultiprocessor(&per_cu, (const void*)fwd_kernel, NTHREADS, LDS_BYTES);
        if (per_cu < 1) { fprintf(stderr, "kernel_launch: occupancy query says %d blocks/CU\n", per_cu); per_cu = 1; }
        (void)hipGetLastError();
        grid = cus;
    }
    if (grid < 0) return;
    if (hipMemsetAsync((char*)d_ws + WS_CTL, 0, CTL_ZERO_BYTES, stream) != hipSuccess) { fprintf(stderr, "kernel_launch: memset of the barrier words failed\n"); return; }
    Args a{};
    for (int i = 0; i < 29; ++i) a.in[i] = (const float*)d_in[i];
    a.out = (float*)d_out; a.ws = (unsigned char*)d_ws; a.ph_lo = 0; a.ph_hi = 100;
    void* kargs[] = {&a};
    hipError_t e = hipLaunchCooperativeKernel((const void*)fwd_kernel, dim3(grid), dim3(NTHREADS), kargs, LDS_BYTES, stream);
    if (e != hipSuccess) fprintf(stderr, "cooperative launch failed: %s (grid %d)\n", hipGetErrorString(e), grid);
}
```

```cpp
#include <hip/hip_runtime.h>
#include <hip/hip_cooperative_groups.h>
#include <cstdio>
#include <cstdint>
namespace cg = cooperative_groups;

#define LAS __attribute__((address_space(3)))
typedef unsigned short bf16_t;
typedef short bf16x8 __attribute__((ext_vector_type(8)));
typedef float f32x4 __attribute__((ext_vector_type(4)));
typedef float f32x2 __attribute__((ext_vector_type(2)));
typedef float f32x16 __attribute__((ext_vector_type(16)));
typedef unsigned u32x4 __attribute__((ext_vector_type(4)));
typedef unsigned u32x2 __attribute__((ext_vector_type(2)));

constexpr int SEQ = 8192, BATCH = 2, DM = 2048, MTOK = BATCH * SEQ, DFF = 8192;
constexpr float LN_EPS = 1e-5f;
constexpr float DN_ALPHA = 1.4142135623730951f;
constexpr int NWAVES = 8, NTHREADS = 512;
constexpr int LDS_BYTES = 147456;

constexpr size_t MiB = 1u << 20;
constexpr size_t WS_WIN = 0;
constexpr size_t WS_WGLU = WS_WIN + 8 * MiB;
constexpr size_t WS_WOUT = WS_WGLU + 16 * MiB;
constexpr size_t WS_WKVQ = WS_WOUT + 8 * MiB;
constexpr size_t WS_WNO = WS_WKVQ + 22 * MiB;
constexpr size_t WS_WMQ = WS_WNO + 8 * MiB;
constexpr size_t WS_WMKV = WS_WMQ + 16 * MiB;
constexpr size_t WS_WMO = WS_WMKV + 32 * MiB;
constexpr size_t WS_WUP = WS_WMO + 16 * MiB;
constexpr size_t WS_WDN = WS_WUP + 64 * MiB;
constexpr size_t WS_WC1 = WS_WDN + 64 * MiB;
constexpr size_t WS_XB = WS_WC1 + 2 * MiB;
constexpr size_t WS_OVL = WS_XB + 64 * MiB;
constexpr size_t WS_MISC = WS_OVL + 256 * MiB;
constexpr size_t WS_END = WS_MISC + 64 * MiB;
constexpr size_t OV_T1 = WS_OVL;
constexpr size_t OV_T2 = WS_OVL + 64 * MiB;
constexpr size_t OV_T3 = WS_OVL + 128 * MiB;
constexpr size_t OV_KV = WS_OVL + 128 * MiB;
constexpr size_t OV_HID = WS_OVL;
constexpr size_t MS_MEMB = WS_MISC;
constexpr size_t MS_MKV = WS_MISC + 2 * MiB;
constexpr size_t MS_MK = WS_MISC + 2 * MiB;
constexpr size_t MS_MVT = WS_MISC + 6 * MiB;
constexpr size_t MS_S5AB = WS_MISC + 10 * MiB;
constexpr size_t MS_S5ABL = MS_S5AB + 65536;
constexpr size_t MS_S5BM = MS_S5ABL + 65536;
constexpr size_t MS_S5CM = MS_S5BM + 524288;
constexpr size_t MS_S5E = MS_S5CM + 524288;
constexpr size_t MS_S5SIN = MS_S5E + 1048576;
constexpr int S5_NCH = 8, S5_LC = SEQ / S5_NCH;
constexpr size_t MS_STATS = WS_MISC + 14 * MiB;
constexpr size_t WS_MT = WS_MISC + 22 * MiB;
constexpr size_t WS_VWT = WS_MISC + 38 * MiB;
constexpr size_t MS_GATES = WS_MISC + 16 * MiB;
constexpr size_t MS_CB = WS_MISC + 20 * MiB;
constexpr size_t MS_PAB = OV_T1;
constexpr size_t MS_KCMP = WS_MISC + 54 * MiB;
constexpr size_t OV_KVH = WS_OVL + 64 * MiB;
constexpr size_t OV_QH = WS_OVL + 160 * MiB;
constexpr size_t KVH_SLOT = (size_t)2 * 4 * 8192 * 128;

__device__ __forceinline__ unsigned f2bf(float f) { unsigned u = __builtin_bit_cast(unsigned, f); return (u + 0x7fffu + ((u >> 16) & 1u)) >> 16; }
__device__ __forceinline__ unsigned pk2(float lo, float hi) { unsigned r; asm volatile("v_cvt_pk_bf16_f32 %0, %1, %2" : "=v"(r) : "v"(lo), "v"(hi)); return r; }
__device__ __forceinline__ float bf2f(unsigned short h) { return __builtin_bit_cast(float, (unsigned)h << 16); }

__device__ __forceinline__ int lane_now() { int l_; asm volatile("v_mbcnt_lo_u32_b32 %0, -1, 0\n\tv_mbcnt_hi_u32_b32 %0, -1, %0" : "=v"(l_)); return l_; }
__device__ __forceinline__ float my_shfl_xor(float v, int o) { return __builtin_bit_cast(float, __builtin_amdgcn_ds_bpermute((lane_now() ^ o) << 2, __builtin_bit_cast(int, v))); }
__device__ __forceinline__ int my_shfl_xor(int v, int o) { return __builtin_amdgcn_ds_bpermute((lane_now() ^ o) << 2, v); }
__device__ __forceinline__ float my_shfl(float v, int src) { return __builtin_bit_cast(float, __builtin_amdgcn_ds_bpermute(src << 2, __builtin_bit_cast(int, v))); }
__device__ __forceinline__ float wave_sum(float v) {
#pragma unroll
    for (int o = 1; o < 64; o <<= 1) v += my_shfl_xor(v, o);
    return v;
}
#define LDS_WAIT() asm volatile("s_waitcnt lgkmcnt(0)" ::: "memory")

namespace pg8 {
constexpr int BM = 256, BK = 64, HALF = 128, HTB = HALF * BK * 2, STAGE_BYTES = 8 * HTB, NXCD = 8, WGM = 8;
__host__ __device__ __forceinline__ int lds_byte(int r, int c) { const int st = (r >> 4) * 2 + (c >> 5), rr = r & 15, cc = c & 31, ob = rr * 64 + cc * 2; return st * 1024 + (ob ^ (((ob >> 9) & 1) << 5)); }
__host__ __device__ __forceinline__ void stage_rc(int b, int& R, int& C) { const int st = b / 1024, sb = b % 1024, swz = sb ^ (((sb >> 9) & 1) << 5); R = (st >> 1) * 16 + swz / 64; C = (st & 1) * 32 + (swz % 64) / 2; }
__host__ __device__ __forceinline__ int perm32(int rho) { const int n = rho >> 4, i = rho & 15; return 8 * (i >> 2) + 4 * n + (i & 3); }

struct Unit { int pm, pn, z; unsigned ao, bo; };
struct Gemm { const bf16_t* A; const bf16_t* Bt; int lda, ldb, K; };

struct StaticOrder {
    int nM, nN, nwg, G, c; unsigned ta, tb;
    __device__ void init(int M, int N, int lda, int ldb, int G_, int c_) { nM = M / BM; nN = N / BM; nwg = nM * nN; G = G_; c = c_; ta = (unsigned)BM * lda * 2; tb = (unsigned)BM * ldb * 2; }
    __device__ bool next(int i, Unit& u) const {
        const long L = (long)i * G + c; if (L >= nwg) return false;
        int wgid = (int)L; { const int q = nwg / NXCD, r = nwg % NXCD, xcd = wgid % NXCD, off = wgid / NXCD; wgid = (xcd < r ? xcd * (q + 1) : r * (q + 1) + (xcd - r) * q) + off; }
        const int nig = WGM * nN, gid = wgid / nig, fm = gid * WGM, gsz = (nM - fm) < WGM ? (nM - fm) : WGM;
        u.pm = fm + ((wgid % nig) % gsz); u.pn = (wgid % nig) / gsz; u.z = 0; u.ao = (unsigned)u.pm * ta; u.bo = (unsigned)u.pn * tb; return true;
    }
};

__device__ __forceinline__ unsigned cvt_pk_bf16(float lo, float hi) { unsigned r; asm volatile("v_cvt_pk_bf16_f32 %0, %1, %2" : "=v"(r) : "v"(lo), "v"(hi)); return r; }


template <class Epi, class Sched>
__device__ __forceinline__ void gemm_phase(LAS unsigned char* lds, const Gemm g, const Sched& S, const Epi& E, int wv) {
    int tid; asm volatile("v_mbcnt_lo_u32_b32 %0, -1, 0\n\tv_mbcnt_hi_u32_b32 %0, -1, %0" : "=v"(tid)); tid += wv * 64;
    const int wid = __builtin_amdgcn_readfirstlane(tid >> 6), lane = tid & 63, wr = wid >> 2, wc = wid & 3, fr = lane & 15, fq = lane >> 4;
    int nt = g.K / BK; asm volatile("" : "+s"(nt));
    unsigned voffA[2], voffB[2];
#pragma unroll
    for (int i = 0; i < 2; ++i) { int R, C; stage_rc(tid * 16 + i * 8192, R, C); const int Rb = Epi::PERM ? ((R & ~31) + perm32(R & 31)) : R;
        voffA[i] = (unsigned)(R * g.lda + C) * 2u; voffB[i] = (unsigned)(Rb * g.ldb + C) * 2u; }
    const size_t kstep = (size_t)(BK * 2);
    const size_t hsA = (size_t)HALF * g.lda * 2, hsB = (size_t)HALF * g.ldb * 2;
    const unsigned ldsw = (unsigned)wid * 1024u;
    const int aoff = lds_byte(wr * 64 + fr, fq * 8), boff = lds_byte(wc * 32 + fr, fq * 8);
#define PG8_SA(b, h) (((b) * 2 + (h)) * HTB)
#define PG8_SB(b, h) ((4 + (b) * 2 + (h)) * HTB)
#define PG8_STAGE(bufoff, gbase, voff) do { _Pragma("unroll") for (int _i = 0; _i < 2; ++_i) \
        __builtin_amdgcn_global_load_lds((const unsigned*)((const char*)(gbase) + (voff)[_i]), (LAS unsigned*)(lds + (bufoff) + ldsw + _i * 8192), 16, 0, 0); } while (0)
#define PG8_LDA(dst, b, h) do { _Pragma("unroll") for (int m = 0; m < 4; ++m) _Pragma("unroll") for (int k = 0; k < 2; ++k) dst[m][k] = *(const LAS bf16x8*)(lds + PG8_SA(b, h) + aoff + m * 2048 + k * 1024); } while (0)
#define PG8_LDB(dst, b, h) do { _Pragma("unroll") for (int n = 0; n < 2; ++n) _Pragma("unroll") for (int k = 0; k < 2; ++k) dst[n][k] = *(const LAS bf16x8*)(lds + PG8_SB(b, h) + boff + n * 2048 + k * 1024); } while (0)
#define PG8_MMA(ai, bj, At, Bt) do { __builtin_amdgcn_s_setprio(1); _Pragma("unroll") for (int m = 0; m < 4; ++m) _Pragma("unroll") for (int n = 0; n < 2; ++n) _Pragma("unroll") for (int k = 0; k < 2; ++k) \
        acc[ai][bj][m][n] = __builtin_amdgcn_mfma_f32_16x16x32_bf16(Bt[n][k], At[m][k], acc[ai][bj][m][n], 0, 0, 0); __builtin_amdgcn_s_setprio(0); } while (0)
#define PG8_WAIT_V(n) asm volatile("s_waitcnt vmcnt(" #n ")" ::: "memory")
#define PG8_WAIT_L(n) asm volatile("s_waitcnt lgkmcnt(" #n ")" ::: "memory")
#define PG8_BAR __builtin_amdgcn_s_barrier()
#define PG8_SCHED __builtin_amdgcn_sched_barrier(0)
    Unit cur, nxt; int ui = 0;
    if (!S.next(0, cur)) return;
    f32x4 acc[2][2][4][2];
#pragma unroll
    for (int a = 0; a < 2; ++a)
#pragma unroll
        for (int b = 0; b < 2; ++b)
#pragma unroll
            for (int m = 0; m < 4; ++m)
#pragma unroll
                for (int n = 0; n < 2; ++n) acc[a][b][m][n] = (f32x4){0.f, 0.f, 0.f, 0.f};
    bf16x8 At[4][2], B0[2][2], B1[2][2];
    const char* cA = (const char*)g.A + cur.ao; const char* cB = (const char*)g.Bt + cur.bo;
    PG8_STAGE(PG8_SB(0, 0), cB, voffB); PG8_STAGE(PG8_SB(0, 1), cB + hsB, voffB); PG8_STAGE(PG8_SA(0, 0), cA, voffA); PG8_STAGE(PG8_SA(0, 1), cA + hsA, voffA);
    if (wr == 1) PG8_BAR;
    PG8_WAIT_V(2); PG8_BAR;
    PG8_STAGE(PG8_SB(1, 0), cB + kstep, voffB); PG8_STAGE(PG8_SA(1, 0), cA + kstep, voffA); PG8_STAGE(PG8_SB(1, 1), cB + hsB + kstep, voffB);
    PG8_WAIT_V(6); PG8_BAR;
    for (;;) {
        const bool has_next = S.next(ui + 1, nxt);
        const char* nA = has_next ? (const char*)g.A + nxt.ao : cA; const char* nB = has_next ? (const char*)g.Bt + nxt.bo : cB;
        for (int t = 0; t < nt; t += 2) {
            const bool last = (t == nt - 2);
            const char* a1 = cA + (size_t)(t + 1) * kstep;
            const char* a2 = last ? nA : cA + (size_t)(t + 2) * kstep; const char* b2 = last ? nB : cB + (size_t)(t + 2) * kstep;
            const char* a3 = a2 + kstep; const char* b3 = b2 + kstep;
            PG8_LDB(B0, 0, 0); PG8_LDB(B1, 0, 1); PG8_SCHED; PG8_LDA(At, 0, 0); PG8_STAGE(PG8_SA(1, 1), a1 + hsA, voffA);
            PG8_WAIT_V(8); PG8_WAIT_L(0); PG8_BAR; PG8_MMA(0, 0, At, B0); PG8_MMA(0, 1, At, B1); PG8_BAR; PG8_SCHED;
            PG8_LDA(At, 0, 1); PG8_STAGE(PG8_SB(0, 0), b2, voffB); PG8_STAGE(PG8_SB(0, 1), b2 + hsB, voffB); PG8_STAGE(PG8_SA(0, 0), a2, voffA);
            PG8_WAIT_V(8); PG8_WAIT_L(0); PG8_BAR; PG8_MMA(1, 0, At, B0); PG8_MMA(1, 1, At, B1); PG8_BAR; PG8_SCHED;
            PG8_LDB(B0, 1, 0); PG8_LDB(B1, 1, 1); PG8_SCHED; PG8_LDA(At, 1, 0); PG8_STAGE(PG8_SA(0, 1), a2 + hsA, voffA);
            PG8_WAIT_V(8); PG8_WAIT_L(0); PG8_BAR; PG8_MMA(0, 0, At, B0); PG8_MMA(0, 1, At, B1); PG8_BAR; PG8_SCHED;
            PG8_LDA(At, 1, 1); PG8_STAGE(PG8_SB(1, 0), b3, voffB); PG8_STAGE(PG8_SB(1, 1), b3 + hsB, voffB); PG8_STAGE(PG8_SA(1, 0), a3, voffA);
            PG8_WAIT_V(8); PG8_WAIT_L(0); PG8_BAR; PG8_MMA(1, 0, At, B0); PG8_MMA(1, 1, At, B1); PG8_BAR; PG8_SCHED;
        }
        if (wr == 0) PG8_BAR;
        if constexpr (!Epi::AFTER_DRAIN) { E(acc, cur, wr, wc, fr, fq); }
        if (!has_next) break;
#pragma unroll
        for (int a = 0; a < 2; ++a)
#pragma unroll
            for (int b = 0; b < 2; ++b)
#pragma unroll
                for (int m = 0; m < 4; ++m)
#pragma unroll
                    for (int n = 0; n < 2; ++n) acc[a][b][m][n] = (f32x4){0.f, 0.f, 0.f, 0.f};
        cur = nxt; cA = nA; cB = nB; ++ui;
        if (wr == 1) PG8_BAR;
    }
    PG8_WAIT_V(0);
    PG8_BAR;
    if constexpr (Epi::AFTER_DRAIN) { E.fused(acc, cur, wr, wc, fr, fq, lds, wid, lane); }
#undef PG8_SA
#undef PG8_SB
#undef PG8_STAGE
#undef PG8_LDA
#undef PG8_LDB
#undef PG8_MMA
#undef PG8_WAIT_V
#undef PG8_WAIT_L
#undef PG8_BAR
#undef PG8_SCHED
}

template <class F> struct EpiCols8 {
    static constexpr bool PERM = true, AFTER_DRAIN = false; F f;
    __device__ __forceinline__ void operator()(const f32x4 (&acc)[2][2][4][2], const Unit& u, int wr, int wc, int fr, int fq) const {
#pragma unroll
        for (int ai = 0; ai < 2; ++ai)
#pragma unroll
            for (int m = 0; m < 4; ++m) { const int row = u.pm * BM + ai * HALF + wr * 64 + m * 16 + fr;
#pragma unroll
                for (int bj = 0; bj < 2; ++bj) f(u, row, u.pn * BM + bj * HALF + wc * 32 + 8 * fq, acc[ai][bj][m][0], acc[ai][bj][m][1]); }
    }
};
template <int MODE> struct EpiRes {
    static constexpr bool PERM = false, AFTER_DRAIN = false; const float* res; float* out; const f32x2* st; const float* g; const float* b; int ldc; float alpha;
    __device__ __forceinline__ void operator()(const f32x4 (&acc)[2][2][4][2], const Unit& u, int wr, int wc, int fr, int fq) const {
        const unsigned row0 = (unsigned)(u.pm * BM + wr * 64 + fr), col0 = (unsigned)(u.pn * BM + wc * 32 + 4 * fq);
        const unsigned base = row0 * (unsigned)ldc + col0;
        f32x4 gv[2][2], bv[2][2];
        if (MODE == 1) {
#pragma unroll
            for (int bj = 0; bj < 2; ++bj)
#pragma unroll
                for (int n = 0; n < 2; ++n) { gv[bj][n] = *(const f32x4*)(g + col0 + bj * HALF + n * 16); bv[bj][n] = *(const f32x4*)(b + col0 + bj * HALF + n * 16); }
        }
#pragma unroll
        for (int ai = 0; ai < 2; ++ai)
#pragma unroll
            for (int mp = 0; mp < 2; ++mp) {
                f32x4 r[2][2][2]; f32x2 sv[2];
#pragma unroll
                for (int mm = 0; mm < 2; ++mm) { const int m = 2 * mp + mm; const unsigned off = base + (unsigned)(ai * HALF + m * 16) * (unsigned)ldc;
                    if (MODE == 1) sv[mm] = st[row0 + ai * HALF + m * 16];
#pragma unroll
                    for (int bj = 0; bj < 2; ++bj)
#pragma unroll
                        for (int n = 0; n < 2; ++n) r[mm][bj][n] = *(const f32x4*)(res + (off + bj * HALF + n * 16)); }
                asm volatile("" ::: "memory");
#pragma unroll
                for (int mm = 0; mm < 2; ++mm) { const int m = 2 * mp + mm; const unsigned off = base + (unsigned)(ai * HALF + m * 16) * (unsigned)ldc;
#pragma unroll
                    for (int bj = 0; bj < 2; ++bj)
#pragma unroll
                        for (int n = 0; n < 2; ++n) { f32x4 x = r[mm][bj][n];
                            if (MODE == 1) x = (x - sv[mm].x) * sv[mm].y * gv[bj][n] + bv[bj][n];
                            *(f32x4*)(out + (off + bj * HALF + n * 16)) = x * alpha + acc[ai][bj][m][n]; } }
                asm volatile("" ::: "memory");
            }
    }
};
}

struct Args { const float* in[29]; float* out; unsigned char* ws; int ph_lo, ph_hi; };
enum { I_X = 0, I_MEM, I_S5_WIN, I_S5_ARE, I_S5_AIM, I_S5_LOGDT, I_S5_BRE, I_S5_BIM, I_S5_CRE, I_S5_CIM, I_S5_D, I_S5_WGLU, I_S5_WOUT, I_KVW,
       I_CPK, I_CW1K, I_CW2K, I_CPV, I_CW1V, I_CW2V, I_WQG, I_WNO, I_MWQ, I_MWKV, I_MWO, I_WUP, I_WDN, I_LNG, I_LNB };

__device__ __forceinline__ const float* argp(int i) {
    const char* kp = (const char*)__builtin_amdgcn_kernarg_segment_ptr(); const float* p;
    asm volatile("s_load_dwordx2 %0, %1, %2\n\ts_waitcnt lgkmcnt(0)" : "=s"(p) : "s"(kp), "i"(i * 8)); return p; }
#define INP(i) argp(i)

__device__ __forceinline__ void conv_item(const float* W, int ldw, int ncols, bf16_t* WT, int ldt, int k0, int n0, int drow0, LAS float* scr, int lane) {
    const int r8 = lane >> 3, c4 = (lane & 7) * 4; const bool ok = (n0 + c4) < ncols;
    f32x4 v[8];
#pragma unroll
    for (int i = 0; i < 8; ++i) v[i] = ok ? *(const f32x4*)(W + (size_t)(k0 + 8 * i + r8) * ldw + n0 + c4) : (f32x4){0.f, 0.f, 0.f, 0.f};
#pragma unroll
    for (int i = 0; i < 8; ++i) { LAS float* d = scr + (8 * i + r8) * 33 + c4; d[0] = v[i].x; d[1] = v[i].y; d[2] = v[i].z; d[3] = v[i].w; }
    LDS_WAIT(); asm volatile("" ::: "memory");
    const int c = lane & 7;
#pragma unroll
    for (int j = 0; j < 4; ++j) { const int n = (lane >> 3) + 8 * j; const LAS float* s = scr + (8 * c) * 33 + n;
        u32x4 o; o.x = pk2(s[0 * 33], s[1 * 33]); o.y = pk2(s[2 * 33], s[3 * 33]); o.z = pk2(s[4 * 33], s[5 * 33]); o.w = pk2(s[6 * 33], s[7 * 33]);
        *(u32x4*)(WT + (size_t)(drow0 + n) * ldt + k0 + 8 * c) = o; }
    LDS_WAIT(); asm volatile("" ::: "memory");
}
template <int MODE>
__device__ __forceinline__ void conv_matrix(const float* W, int K, int ldw, int ncols, bf16_t* WT, int ldt, int row_off, LAS float* scr, int gw, int NGW, int lane) {
    const int nblk = (ncols + 31) / 32, nitems = (K / 64) * nblk;
    for (int it = gw; it < nitems; it += NGW) {
        const int kb = it / nblk, nb = it % nblk, n0 = 32 * nb;
        int drow0;
        if (MODE == 1) { const int bj = n0 >> 11, j = n0 & 2047; drow0 = 256 * (j >> 7) + 128 * bj + (j & 127); } else drow0 = row_off + n0;
        conv_item(W, ldw, ncols, WT, ldt, 64 * kb, n0, drow0, scr, lane);
    }
}
__device__ __forceinline__ void cvt_rows(const float* src, bf16_t* dst, size_t n, int gtid, int gthreads) {
    for (size_t i = (size_t)gtid * 8; i < n; i += (size_t)gthreads * 8) {
        const f32x4 a = *(const f32x4*)(src + i), b = *(const f32x4*)(src + i + 4);
        u32x4 o; o.x = pk2(a.x, a.y); o.y = pk2(a.z, a.w); o.z = pk2(b.x, b.y); o.w = pk2(b.z, b.w);
        *(u32x4*)(dst + i) = o;
    }
}
template <bool WF32>
__device__ __forceinline__ void ln_phase(const float* src, float prescale, float* XF, bf16_t* XB, f32x2* ST, const float* g, const float* b, int gw, int NGW, int lane) {
    asm volatile("" : "+v"(lane));
    for (int row = gw; row < MTOK; row += NGW) {
        const f32x4* xr = (const f32x4*)(src + (size_t)row * DM) + lane;
        f32x4 v[8]; float s = 0.f;
#pragma unroll
        for (int j = 0; j < 8; ++j) { v[j] = xr[64 * j] * prescale; s += (v[j].x + v[j].y) + (v[j].z + v[j].w); }
        const float mean = wave_sum(s) * (1.f / DM); float s2 = 0.f;
#pragma unroll
        for (int j = 0; j < 8; ++j) { v[j] = v[j] - mean; s2 += (v[j].x * v[j].x + v[j].y * v[j].y) + (v[j].z * v[j].z + v[j].w * v[j].w); }
        const float rstd = 1.f / sqrtf(wave_sum(s2) * (1.f / DM) + LN_EPS);
        if (!WF32 && lane == 0) ST[row] = (f32x2){mean, rstd};
        f32x4* xo = (f32x4*)(XF + (size_t)row * DM) + lane; u32x2* bo = (u32x2*)(XB + (size_t)row * DM) + lane;
#pragma unroll
        for (int j = 0; j < 8; ++j) { const f32x4 gv = ((const f32x4*)g)[lane + 64 * j], bv = ((const f32x4*)b)[lane + 64 * j];
            const f32x4 o = v[j] * rstd * gv + bv; if (WF32) xo[64 * j] = o; u32x2 w; w.x = pk2(o.x, o.y); w.y = pk2(o.z, o.w); bo[64 * j] = w; }
    }
}

struct StoreBf16 { bf16_t* O; int ldc; float scale;
    __device__ __forceinline__ void operator()(const pg8::Unit&, int row, int col, f32x4 v0, f32x4 v1) const {
        u32x4 w; w.x = pg8::cvt_pk_bf16(v0[0] * scale, v0[1] * scale); w.y = pg8::cvt_pk_bf16(v0[2] * scale, v0[3] * scale); w.z = pg8::cvt_pk_bf16(v1[0] * scale, v1[1] * scale); w.w = pg8::cvt_pk_bf16(v1[2] * scale, v1[3] * scale);
        *(u32x4*)(O + (size_t)row * ldc + col) = w; } };
struct StoreRelu2 { bf16_t* O; int ldc;
    __device__ __forceinline__ void operator()(const pg8::Unit&, int row, int col, f32x4 v0, f32x4 v1) const {
#pragma unroll
        for (int i = 0; i < 4; ++i) { const float a = v0[i] > 0.f ? v0[i] : 0.f, c = v1[i] > 0.f ? v1[i] : 0.f; v0[i] = a * a; v1[i] = c * c; }
        u32x4 w; w.x = pg8::cvt_pk_bf16(v0[0], v0[1]); w.y = pg8::cvt_pk_bf16(v0[2], v0[3]); w.z = pg8::cvt_pk_bf16(v1[0], v1[1]); w.w = pg8::cvt_pk_bf16(v1[2], v1[3]);
        *(u32x4*)(O + (size_t)row * ldc + col) = w; } };


__device__ __forceinline__ void s5_tables(const float* a_re, const float* a_im, const float* log_dt, const float* b_re, const float* b_im, const float* c_re, const float* c_im,
                                          unsigned char* ws, int gtid, int gthreads) {
    f32x2* AB = (f32x2*)(ws + MS_S5AB); f32x2* ABL = (f32x2*)(ws + MS_S5ABL); bf16_t* BM = (bf16_t*)(ws + MS_S5BM); bf16_t* CM = (bf16_t*)(ws + MS_S5CM);
    for (int i = gtid; i < 128 * 64 * 16; i += gthreads) {
        const int h = i & 15, p = (i >> 4) & 63, g = i >> 10;
        const float dt = expf(log_dt[g]), lr = a_re[g * 64 + p], li = a_im[g * 64 + p];
        const float mag = expf(lr * dt), abr = mag * cosf(li * dt), abi = mag * sinf(li * dt);
        const float den = lr * lr + li * li, nr = abr - 1.0f, ni = abi;
        const float fre = (nr * lr + ni * li) / den, fim = (ni * lr - nr * li) / den;
        const float br = b_re[(g * 64 + p) * 16 + h], bi = b_im[(g * 64 + p) * 16 + h];
        BM[(g * 128 + p) * 16 + h] = (bf16_t)f2bf(fre * br - fim * bi);
        BM[(g * 128 + 64 + p) * 16 + h] = (bf16_t)f2bf(fre * bi + fim * br);
        CM[(g * 16 + h) * 128 + p] = (bf16_t)f2bf(c_re[(g * 16 + h) * 64 + p]);
        CM[(g * 16 + h) * 128 + 64 + p] = (bf16_t)f2bf(-c_im[(g * 16 + h) * 64 + p]);
        if (h == 0) { AB[g * 64 + p] = (f32x2){abr, abi}; float xr = abr, xi = abi;
            for (int k = S5_LC; k > 1; k >>= 1) { const float t = xr * xr - xi * xi; xi = 2.f * xr * xi; xr = t; }
            ABL[g * 64 + p] = (f32x2){xr, xi}; }
    }
}
__device__ __forceinline__ float gelu_tanh(float y) { const float z = 0.7978845608028654f * (y + 0.044715f * y * y * y); const float e = __expf(2.f * z); return y * (1.f - __builtin_amdgcn_rcpf(1.f + e)); }
template <bool FINAL>
__device__ __forceinline__ void s5_pass(const bf16_t* U, bf16_t* Y, const float* dskip, unsigned char* ws, LAS unsigned char* lds, int gw, int NGW, int wave, int lane) {
    asm volatile("" : "+v"(lane));
    const int fr = lane & 15, fq = lane >> 4;
    LAS float* BU = (LAS float*)(lds + wave * 12800); LAS bf16_t* SB = (LAS bf16_t*)(lds + wave * 12800 + 8448);
    constexpr int LDB = 132, LDSB = 136;
    for (int item = gw; item < 2 * 128 * S5_NCH; item += NGW) {
        const int g = item & 127, b = (item >> 7) & 1, ch = item >> 8;
        const bf16_t* BMg = (const bf16_t*)(ws + MS_S5BM) + (size_t)g * 128 * 16; const bf16_t* CMg = (const bf16_t*)(ws + MS_S5CM) + (size_t)g * 16 * 128;
        bf16x8 bmf[8];
#pragma unroll
        for (int nt = 0; nt < 8; ++nt) { bmf[nt] = (bf16x8){0, 0, 0, 0, 0, 0, 0, 0}; if (fq < 2) bmf[nt] = *(const bf16x8*)(BMg + (16 * nt + fr) * 16 + 8 * fq); }
        bf16x8 cmf[4];
        if (FINAL) {
#pragma unroll
            for (int kk = 0; kk < 4; ++kk) cmf[kk] = *(const bf16x8*)(CMg + fr * 128 + 32 * kk + 8 * fq);
        }
        const f32x2 ab = ((const f32x2*)(ws + MS_S5AB))[g * 64 + lane];
        const float ar = ab.x, ai = ab.y;
        float sr = 0.f, si = 0.f;
        if (FINAL) { const f32x2 al = ((const f32x2*)(ws + MS_S5ABL))[g * 64 + lane]; const f32x2* E = (const f32x2*)(ws + MS_S5E) + (size_t)(b * 128 + g) * S5_NCH * 64 + lane;
            for (int c = 0; c < ch; ++c) { const f32x2 e = E[c * 64]; const float nr = al.x * sr - al.y * si + e.x, ni = al.x * si + al.y * sr + e.y; sr = nr; si = ni; } }
        const float dsk = FINAL ? dskip[g * 16 + fr] : 0.f;
        const size_t row0 = (size_t)b * SEQ + (size_t)ch * S5_LC;
        const bf16_t* Up = U + (row0 + fr) * DM + g * 16 + 8 * fq;
        bf16x8 uf = (bf16x8){0, 0, 0, 0, 0, 0, 0, 0}; if (fq < 2) uf = *(const bf16x8*)Up;
        for (int t0 = 0; t0 < S5_LC; t0 += 16) {
            bf16x8 un = (bf16x8){0, 0, 0, 0, 0, 0, 0, 0};
            if (fq < 2 && t0 + 16 < S5_LC) un = *(const bf16x8*)(Up + (size_t)(t0 + 16) * DM);
#pragma unroll
            for (int nt = 0; nt < 8; ++nt) { const f32x4 d = __builtin_amdgcn_mfma_f32_16x16x32_bf16(uf, bmf[nt], (f32x4){0.f, 0.f, 0.f, 0.f}, 0, 0, 0);
#pragma unroll
                for (int r = 0; r < 4; ++r) BU[(4 * fq + r) * LDB + 16 * nt + fr] = d[r]; }
#pragma unroll
            for (int t = 0; t < 16; ++t) { const float br = BU[t * LDB + lane], bi = BU[t * LDB + 64 + lane];
                const float nr = ar * sr - ai * si + br, ni = ar * si + ai * sr + bi; sr = nr; si = ni;
                if (FINAL) { SB[t * LDSB + lane] = (bf16_t)f2bf(sr); SB[t * LDSB + 64 + lane] = (bf16_t)f2bf(si); } }
            if (FINAL) {
                f32x4 y = (f32x4){0.f, 0.f, 0.f, 0.f};
#pragma unroll
                for (int kk = 0; kk < 4; ++kk) { const bf16x8 sf = *(const LAS bf16x8*)(SB + fr * LDSB + 32 * kk + 8 * fq); y = __builtin_amdgcn_mfma_f32_16x16x32_bf16(sf, cmf[kk], y, 0, 0, 0); }
#pragma unroll
                for (int r = 0; r < 4; ++r) { const size_t o = (row0 + t0 + 4 * fq + r) * DM + g * 16 + fr; const float uu = bf2f(U[o]); Y[o] = (bf16_t)f2bf(gelu_tanh(y[r] + dsk * uu)); }
            }
            uf = un;
        }
        if (!FINAL) ((f32x2*)(ws + MS_S5E))[((b * 128 + g) * S5_NCH + ch) * 64 + lane] = (f32x2){sr, si};
    }
}
__device__ __forceinline__ void s5_carry(unsigned char* ws, int gtid, int gthreads) {
    for (int i = gtid; i < 2 * 128 * 64; i += gthreads) {
        const int p = i & 63, bg = i >> 6, g = bg & 127;
        const f32x2 al = ((const f32x2*)(ws + MS_S5ABL))[g * 64 + p];
        const f32x2* E = (const f32x2*)(ws + MS_S5E) + (size_t)bg * S5_NCH * 64 + p; f32x2* SI = (f32x2*)(ws + MS_S5SIN) + (size_t)bg * S5_NCH * 64 + p;
        float sr = 0.f, si = 0.f;
        for (int c = 0; c < S5_NCH; ++c) { SI[c * 64] = (f32x2){sr, si}; const f32x2 e = E[c * 64]; const float nr = al.x * sr - al.y * si + e.x, ni = al.x * si + al.y * sr + e.y; sr = nr; si = ni; }
    }
}

struct EpiGlu {
    static constexpr bool PERM = true, AFTER_DRAIN = false; bf16_t* O; int ldc;
    __device__ __forceinline__ void operator()(const f32x4 (&acc)[2][2][4][2], const pg8::Unit& u, int wr, int wc, int fr, int fq) const {
        const int col = u.pn * 128 + wc * 32 + 8 * fq;
#pragma unroll
        for (int ai = 0; ai < 2; ++ai)
#pragma unroll
            for (int m = 0; m < 4; ++m) { const int row = u.pm * 256 + ai * 128 + wr * 64 + m * 16 + fr; float o[8];
#pragma unroll
                for (int n = 0; n < 2; ++n)
#pragma unroll
                    for (int i = 0; i < 4; ++i) { const float v = acc[ai][0][m][n][i], gt = acc[ai][1][m][n][i]; o[4 * n + i] = v * __builtin_amdgcn_rcpf(1.f + __expf(-gt)); }
                u32x4 w; w.x = pg8::cvt_pk_bf16(o[0], o[1]); w.y = pg8::cvt_pk_bf16(o[2], o[3]); w.z = pg8::cvt_pk_bf16(o[4], o[5]); w.w = pg8::cvt_pk_bf16(o[6], o[7]);
                *(u32x4*)(O + (size_t)row * ldc + col) = w; }
    }
};
struct EpiSoftmax {
    static constexpr bool PERM = false, AFTER_DRAIN = true; bf16_t* P;
    __device__ __forceinline__ void fused(f32x4 (&acc)[2][2][4][2], const pg8::Unit& u, int wr, int wc, int fr, int fq, LAS unsigned char* lds, int wid, int lane) const {
        LAS f32x2* X = (LAS f32x2*)lds;
        float mw[2][4];
#pragma unroll
        for (int ai = 0; ai < 2; ++ai)
#pragma unroll
            for (int m = 0; m < 4; ++m) {
                float mx = -3.0e38f;
#pragma unroll
                for (int bj = 0; bj < 2; ++bj)
#pragma unroll
                    for (int n = 0; n < 2; ++n)
#pragma unroll
                        for (int i = 0; i < 4; ++i) mx = fmaxf(mx, acc[ai][bj][m][n][i]);
                mx = fmaxf(mx, my_shfl_xor(mx, 16)); mx = fmaxf(mx, my_shfl_xor(mx, 32));
                float sm = 0.f;
#pragma unroll
                for (int bj = 0; bj < 2; ++bj)
#pragma unroll
                    for (int n = 0; n < 2; ++n)
#pragma unroll
                        for (int i = 0; i < 4; ++i) { const float e = __builtin_amdgcn_exp2f(acc[ai][bj][m][n][i] - mx); acc[ai][bj][m][n][i] = e; sm += e; }
                sm += my_shfl_xor(sm, 16); sm += my_shfl_xor(sm, 32);
                mw[ai][m] = mx;
                if (fq == 0) X[(ai * 128 + wr * 64 + m * 16 + fr) * 4 + wc] = (f32x2){mx, sm};
            }
        LDS_WAIT(); __builtin_amdgcn_s_barrier(); asm volatile("" ::: "memory");
#pragma unroll
        for (int ai = 0; ai < 2; ++ai)
#pragma unroll
            for (int m = 0; m < 4; ++m) { const int r = ai * 128 + wr * 64 + m * 16 + fr;
                const f32x2 a = X[r * 4 + 0], b = X[r * 4 + 1], c = X[r * 4 + 2], d = X[r * 4 + 3];
                const float M = fmaxf(fmaxf(a.x, b.x), fmaxf(c.x, d.x));
                const float tot = a.y * __builtin_amdgcn_exp2f(a.x - M) + b.y * __builtin_amdgcn_exp2f(b.x - M) + c.y * __builtin_amdgcn_exp2f(c.x - M) + d.y * __builtin_amdgcn_exp2f(d.x - M);
                const float f = __builtin_amdgcn_exp2f(mw[ai][m] - M) / tot;
                bf16_t* rowp = P + (size_t)(u.pm * 256 + r) * 1024 + u.z * 256 + wc * 32 + 4 * fq;
#pragma unroll
                for (int bj = 0; bj < 2; ++bj)
#pragma unroll
                    for (int n = 0; n < 2; ++n) { const f32x4 v = acc[ai][bj][m][n] * f; u32x2 w; w.x = pg8::cvt_pk_bf16(v[0], v[1]); w.y = pg8::cvt_pk_bf16(v[2], v[3]); *(u32x2*)(rowp + bj * 128 + n * 16) = w; } }
        LDS_WAIT(); __builtin_amdgcn_s_barrier(); asm volatile("" ::: "memory");
    }
};
struct CmpSched {
    int G, c;
    __device__ bool next(int i, pg8::Unit& u) const {
        const int L = i * G + c; if (L >= 128) return false;
        const int which = L >> 6, ks = (L >> 4) & 3, pm = L & 15; u.pm = pm; u.pn = 0; u.z = which * 4 + ks;
        u.ao = (unsigned)(((size_t)which * KVH_SLOT + (size_t)pm * 256 * 2048 + ks * 512) * 2); u.bo = (unsigned)(((size_t)which * 256 * 2048 + ks * 512) * 2);
        return true;
    }
};
struct StoreBf16Z { bf16_t* O; int ldc; float scale; size_t zstride;
    __device__ __forceinline__ void operator()(const pg8::Unit& u, int row, int col, f32x4 v0, f32x4 v1) const {
        u32x4 w; w.x = pg8::cvt_pk_bf16(v0[0] * scale, v0[1] * scale); w.y = pg8::cvt_pk_bf16(v0[2] * scale, v0[3] * scale); w.z = pg8::cvt_pk_bf16(v1[0] * scale, v1[1] * scale); w.w = pg8::cvt_pk_bf16(v1[2] * scale, v1[3] * scale);
        *(u32x4*)(O + (size_t)u.z * zstride + (size_t)row * ldc + col) = w; } };
struct KvSched { int G, c;
    __device__ bool next(int i, pg8::Unit& u) const { const int L = i * G + c; if (L >= 64) return false;
        const int l = L >> 5, pm = (L >> 4) & 1, pn = L & 15; u.pm = pm; u.pn = pn; u.z = l;
        u.ao = (unsigned)((size_t)pm * 256 * 2048 * 2); u.bo = (unsigned)((size_t)l * 16 * MiB + (size_t)pn * 256 * 2048 * 2); return true; } };
struct MtSched { int G, c;
    __device__ bool next(int i, pg8::Unit& u) const { const int L = i * G + c; if (L >= 128 || L < 0) return false;
        const int l = L >> 6, b = (L >> 5) & 1, h = (L >> 3) & 3, pn = L & 7; u.pm = h; u.pn = pn; u.z = l * 2 + b;
        u.ao = (unsigned)((size_t)l * 4 * MiB + ((size_t)(b * 256) * 4096 + h * 512) * 2); u.bo = (unsigned)((size_t)l * 8 * MiB + ((size_t)(pn * 256) * 2048 + h * 512) * 2); return true; } };
struct VwSched { int G, c;
    __device__ bool next(int i, pg8::Unit& u) const { const int L = i * G + c; if (L >= 128 || L < 0) return false;
        const int l = L >> 6, b = (L >> 5) & 1, h = (L >> 3) & 3, pmn = L & 7; u.pm = pmn; u.pn = h; u.z = l * 2 + b;
        u.ao = (unsigned)((size_t)l * 8 * MiB + ((size_t)(pmn * 256) * 2048 + h * 512) * 2); u.bo = (unsigned)((size_t)l * 4 * MiB + ((size_t)(b * 256) * 4096 + 2048 + h * 512) * 2); return true; } };
struct ScoreSched { int G, c, base, lim, layer;
    __device__ bool next(int i, pg8::Unit& u) const { const int L0 = base + i * G + c; if (L0 >= lim) return false;
        const int L = (G == 256) ? ((L0 & 7) * 32 + (L0 >> 3)) : L0;
        const int b = L >> 7, pmp = (L >> 2) & 31, h = L & 3; u.pm = b * 32 + pmp; u.pn = 0; u.z = h;
        u.ao = (unsigned)((size_t)(b * SEQ + 256 * pmp) * 2048 * 2); u.bo = (unsigned)((size_t)(layer * 2 + b) * 4 * MiB + (size_t)(h * 256) * 2048 * 2); return true; } };
struct PvoSched { pg8::StaticOrder so; int layer;
    __device__ bool next(int i, pg8::Unit& u) const { if (!so.next(i, u)) return false; u.bo += (unsigned)((size_t)(layer * 2 + (u.pm >> 5)) * 4 * MiB); return true; } };
template <int MODE> struct MemSched {
    int G, c, base, lim;
    __device__ bool next(int i, pg8::Unit& u) const {
        const int L = base + i * G + c; if (L >= lim) return false;
        if (MODE == 0) { const int b = L >> 7, h = (L >> 5) & 3, pmp = L & 31; u.pm = b * 32 + pmp; u.pn = 0; u.z = h;
            u.ao = (unsigned)(((b * SEQ + 256 * pmp) * 2048 + h * 512) * 2); u.bo = (unsigned)(((b * 256) * 2048 + h * 512) * 2); }
        else { const int pn = L & 1, pmp = (L >> 1) & 31, h = (L >> 6) & 3, b = L >> 8; u.pm = b * 32 + pmp; u.pn = h * 2 + pn; u.z = 0;
            u.ao = (unsigned)(((b * SEQ + 256 * pmp) * 1024 + h * 256) * 2); u.bo = (unsigned)(((h * 512 + 256 * pn) * 512 + b * 256) * 2); }
        return true;
    }
};


struct StoreKVQ { bf16_t* KVH; bf16_t* QH; float* GATES; float qscale;
    __device__ __forceinline__ void operator()(const pg8::Unit&, int row, int col, f32x4 v0, f32x4 v1) const {
        const int b = row >> 13, t = row & 8191;
        if (col < 3072) { const int slot = col >> 9, g = (col >> 7) & 3, d = col & 127;
            u32x4 w; w.x = pg8::cvt_pk_bf16(v0[0], v0[1]); w.y = pg8::cvt_pk_bf16(v0[2], v0[3]); w.z = pg8::cvt_pk_bf16(v1[0], v1[1]); w.w = pg8::cvt_pk_bf16(v1[2], v1[3]);
            *(u32x4*)(KVH + ((((size_t)slot * 2 + b) * 4 + g) * 8192 + t) * 128 + d) = w; }
        else if (col < 5120) { const int c2 = col - 3072, head = c2 >> 7, d = c2 & 127, g = head >> 2, r = head & 3; v0 = v0 * qscale; v1 = v1 * qscale;
            u32x4 w; w.x = pg8::cvt_pk_bf16(v0[0], v0[1]); w.y = pg8::cvt_pk_bf16(v0[2], v0[3]); w.z = pg8::cvt_pk_bf16(v1[0], v1[1]); w.w = pg8::cvt_pk_bf16(v1[2], v1[3]);
            *(u32x4*)(QH + ((((size_t)b * 4 + g) * 8192 + t) * 4 + r) * 128 + d) = w; }
        else if (col < 5168) { float* gp = GATES + (size_t)row * 48 + (col - 5120);
#pragma unroll
            for (int i = 0; i < 4; ++i) { v0[i] = __builtin_amdgcn_rcpf(1.f + __expf(-v0[i])); v1[i] = __builtin_amdgcn_rcpf(1.f + __expf(-v1[i])); }
            *(f32x4*)gp = v0; *(f32x4*)(gp + 4) = v1; }
    } };
struct StoreF32 { float* O; int ldc; size_t zstride;
    __device__ __forceinline__ void operator()(const pg8::Unit& u, int row, int col, f32x4 v0, f32x4 v1) const { float* p = O + (size_t)u.z * zstride + (size_t)row * ldc + col; *(f32x4*)p = v0; *(f32x4*)(p + 4) = v1; } };
__device__ __forceinline__ void cmp_bias(const float* pos_k, const float* w1_k, const float* pos_v, const float* w1_v, float* CB, int tid) {
    if (tid < 256) { const int which = tid >> 7, n = tid & 127; const float* pos = which ? pos_v : pos_k; const float* w1 = which ? w1_v : w1_k; float a = 0.f;
        for (int k = 0; k < 4096; ++k) a += pos[k] * w1[(size_t)k * 128 + n];
        CB[tid] = a; }
}
__device__ __forceinline__ void cmp_combine(const float* PAB, const float* CB, const float* w2k, const float* w2v, bf16_t* KCMP, int gw, int NGW, int lane) {
    asm volatile("" : "+v"(lane));
    for (int it = gw; it < 2 * 4096; it += NGW) {
        const int which = it >> 12, row = it & 4095, c = row & 511;
        bf16_t* out = KCMP + ((size_t)which * 4096 + row) * 128;
        if (c == 511) { out[lane] = 0; out[lane + 64] = 0; continue; }
        const float* P = PAB + (size_t)which * 4 * 4096 * 256; const float* w2 = which ? w2v : w2k;
        float sa = CB[which * 128 + lane], sb = CB[which * 128 + 64 + lane];
#pragma unroll
        for (int ks = 0; ks < 4; ++ks) { const float* Pk = P + (size_t)ks * 4096 * 256;
            sa += Pk[(size_t)row * 256 + lane] + Pk[(size_t)(row + 1) * 256 + 128 + lane]; sb += Pk[(size_t)row * 256 + 64 + lane] + Pk[(size_t)(row + 1) * 256 + 192 + lane]; }
        const float va = gelu_tanh(sa), vb = gelu_tanh(sb);
        float o0 = 0.f, o1 = 0.f;
        for (int n = 0; n < 64; ++n) { const float x = my_shfl(va, n); o0 += x * w2[n * 128 + lane]; o1 += x * w2[n * 128 + 64 + lane]; }
        for (int n = 0; n < 64; ++n) { const float x = my_shfl(vb, n); o0 += x * w2[(64 + n) * 128 + lane]; o1 += x * w2[(64 + n) * 128 + 64 + lane]; }
        out[lane] = (bf16_t)f2bf(o0); out[lane + 64] = (bf16_t)f2bf(o1);
    }
}

namespace nsa {
constexpr int L_K0 = 0, L_V0 = 32768, L_IMP = 65536, IMP_LD = 132, IMP_WAVE = 8 * IMP_LD * 4, L_SELM = L_IMP + 8 * IMP_WAVE, L_UNI = L_SELM + 8 * 128, L_NTL = L_UNI + 16, L_TL = L_NTL + 16, L_WSF = L_TL + 512;
constexpr float NEGB = -1.0e30f;
typedef short v4i16_t __attribute__((ext_vector_type(4)));
__device__ __forceinline__ unsigned off_b(unsigned row, unsigned ch) { return 256u * row + 16u * (ch ^ (((row & 3) << 2) | ((row >> 2) & 3))); }
__device__ __forceinline__ int crow(int r, int hi) { return (r & 3) + 8 * (r >> 2) + 4 * hi; }
__device__ __forceinline__ float xhalf(float v) { return my_shfl_xor(v, 32); }

template <int BR, int MODE>
__device__ __forceinline__ void run_tiles(LAS unsigned char* lds, const bf16_t* Kb, const bf16_t* Vb, int ntiles, int first, int qt, const bf16x8 (&qf)[8], f32x16 (&o)[4], float& l_run,
                                          int t, unsigned selw0, unsigned selw1, unsigned selw2, unsigned selw3, float pscale, float gate, int tid, int wave, int lane) {
    const int l32 = lane & 31, hi = lane >> 5;
    LAS const int* TL = (LAS const int*)(lds + L_TL);
    LAS float* imp = (LAS float*)(lds + L_IMP + wave * IMP_WAVE) + ((l32 >> 2) * IMP_LD);
    const unsigned soff = (unsigned)((4 * wave + (lane >> 4)) * 128 + (((lane & 15) ^ (((lane >> 4) << 2) | (wave & 3))) * 8));
    auto tile_of = [&](int i) -> int { return (BR == 1) ? TL[i] : first + i; };
    auto stage = [&](int tile, int buf) { const bf16_t* ks = Kb + (size_t)tile * 8192 + soff; LAS unsigned char* kd = lds + L_K0 + buf * 16384 + wave * 1024;
        __builtin_amdgcn_global_load_lds((const unsigned*)ks, (LAS unsigned*)kd, 16, 0, 0); __builtin_amdgcn_global_load_lds((const unsigned*)(ks + 4096), (LAS unsigned*)(kd + 8192), 16, 0, 0);
        if (MODE != 0) { const bf16_t* vs = Vb + (size_t)tile * 8192 + soff; LAS unsigned char* vd = lds + L_V0 + buf * 16384 + wave * 1024;
            __builtin_amdgcn_global_load_lds((const unsigned*)vs, (LAS unsigned*)vd, 16, 0, 0); __builtin_amdgcn_global_load_lds((const unsigned*)(vs + 4096), (LAS unsigned*)(vd + 8192), 16, 0, 0); } };
    if (ntiles <= 0) return;
    stage(tile_of(0), 0);
    asm volatile("s_waitcnt vmcnt(0) lgkmcnt(0)" ::: "memory"); __builtin_amdgcn_s_barrier(); asm volatile("" ::: "memory");
    const unsigned kx = ((l32 & 3) << 2) | ((l32 >> 2) & 3);
    const int blk = (lane >> 4) & 1, tq = (lane & 15) >> 2, tp = lane & 3;
    for (int i = 0; i < ntiles; ++i) {
        const int tile = tile_of(i), buf = i & 1;
        if (i + 1 < ntiles) stage(tile_of(i + 1), buf ^ 1);
        bool selbit = true;
        if (BR == 1) { const unsigned w = (tile < 32) ? selw0 : (tile < 64) ? selw1 : (tile < 96) ? selw2 : selw3; selbit = (w >> (tile & 31)) & 1u; }
        const bool active = (BR == 1) ? (bool)__any((int)selbit) : true;
        if (active) {
            LAS const unsigned char* kb = lds + L_K0 + buf * 16384; LAS const unsigned char* vb = lds + L_V0 + buf * 16384;
            f32x16 p0, p1;
#pragma unroll
            for (int r = 0; r < 16; ++r) { p0[r] = 0.f; p1[r] = 0.f; }
            {
                bf16x8 kq0[3], kq1[3];
#define NSA_LDK(s_, slot_) do { const unsigned ko_ = 256u * l32 + 16u * ((unsigned)(2 * (s_) + hi) ^ kx); kq0[slot_] = *(LAS const bf16x8*)(kb + ko_); kq1[slot_] = *(LAS const bf16x8*)(kb + 8192 + ko_); } while (0)
                NSA_LDK(0, 0); NSA_LDK(1, 1);
                __builtin_amdgcn_sched_barrier(0);
#pragma unroll
                for (int s = 0; s < 8; ++s) {
                    if (s + 2 < 8) NSA_LDK(s + 2, (s + 2) % 3);
                    __builtin_amdgcn_sched_barrier(0);
                    p0 = __builtin_amdgcn_mfma_f32_32x32x16_bf16(kq0[s % 3], qf[s], p0, 0, 0, 0); p1 = __builtin_amdgcn_mfma_f32_32x32x16_bf16(kq1[s % 3], qf[s], p1, 0, 0, 0);
                    __builtin_amdgcn_sched_barrier(0);
                }
#undef NSA_LDK
            }
            const int kbase = tile * 64;
            const bool need_mask = (BR == 0) ? true : (BR == 1) ? (tile == qt) : ((tile == qt) || (tile == first && qt >= 8));
            const float ps = (BR == 1) ? 1.f : pscale;
            if (need_mask) {
                const int cmax = (t - 31) >> 4;
#pragma unroll
                for (int r = 0; r < 16; ++r) { const int k0i = kbase + crow(r, hi), k1i = k0i + 32; bool v0, v1;
                    if (BR == 0) { v0 = k0i <= cmax; v1 = k1i <= cmax; }
                    else if (BR == 1) { v0 = (k0i <= t); v1 = (k1i <= t); }
                    else { v0 = (k0i <= t) && (k0i > t - 512); v1 = (k1i <= t) && (k1i > t - 512); }
                    p0[r] = v0 ? __builtin_amdgcn_exp2f(p0[r]) * ps : 0.f; p1[r] = v1 ? __builtin_amdgcn_exp2f(p1[r]) * ps : 0.f; }
            } else {
#pragma unroll
                for (int r = 0; r < 16; ++r) { p0[r] = __builtin_amdgcn_exp2f(p0[r]) * ps; p1[r] = __builtin_amdgcn_exp2f(p1[r]) * ps; }
            }
            if (MODE != 1) { float sum = 0.f;
#pragma unroll
                for (int r = 0; r < 16; ++r) sum += p0[r] + p1[r];
                l_run += (BR == 1) ? (selbit ? sum : 0.f) : sum; }
            if (MODE == 1) {
#pragma unroll
                for (int h2 = 0; h2 < 2; ++h2)
#pragma unroll
                    for (int a = 0; a < 4; ++a) { const f32x16& pp = h2 ? p1 : p0; float gs = (pp[4 * a] + pp[4 * a + 1]) + (pp[4 * a + 2] + pp[4 * a + 3]), ls = pp[4 * a + 3];
                        gs += my_shfl_xor(gs, 1); gs += my_shfl_xor(gs, 2); ls += my_shfl_xor(ls, 1); ls += my_shfl_xor(ls, 2);
                        if ((lane & 3) == 0) { const int sidx = 16 * tile + 2 * a + hi + 8 * h2; atomicAdd((float*)(imp + sidx), gs); atomicAdd((float*)(imp + sidx + 1), ls); } }
#pragma unroll
                for (int r = 0; r < 16; ++r) { p0[r] *= gate; p1[r] *= gate; }
            }
            if (MODE != 0) {
                bf16x8 pa[4];
#pragma unroll
                for (int ks = 0; ks < 4; ++ks) { const f32x16& pp = (ks < 2) ? p0 : p1; const int b0 = 8 * (ks & 1); u32x4 w;
                    w.x = pg8::cvt_pk_bf16(pp[b0], pp[b0 + 1]); w.y = pg8::cvt_pk_bf16(pp[b0 + 2], pp[b0 + 3]); w.z = pg8::cvt_pk_bf16(pp[b0 + 4], pp[b0 + 5]); w.w = pg8::cvt_pk_bf16(pp[b0 + 6], pp[b0 + 7]);
                    if (BR == 1) { const unsigned msk = selbit ? 0xffffffffu : 0u; w.x &= msk; w.y &= msk; w.z &= msk; w.w &= msk; }
                    pa[ks] = __builtin_bit_cast(bf16x8, w); }
                bf16x8 vfr[2][4];
#define NSA_LDV(d_, slot_) do { _Pragma("unroll") for (int ks_ = 0; ks_ < 4; ++ks_) { \
                        const unsigned a0_ = off_b(16 * ks_ + 4 * hi + tq, 4 * (d_) + 2 * blk + (tp >> 1)) + 8 * (tp & 1); \
                        const unsigned a1_ = off_b(16 * ks_ + 8 + 4 * hi + tq, 4 * (d_) + 2 * blk + (tp >> 1)) + 8 * (tp & 1); \
                        const v4i16_t lo_ = __builtin_amdgcn_ds_read_tr16_b64_v4i16((LAS v4i16_t*)(vb + a0_)); \
                        const v4i16_t hv_ = __builtin_amdgcn_ds_read_tr16_b64_v4i16((LAS v4i16_t*)(vb + a1_)); \
                        vfr[slot_][ks_] = (bf16x8){lo_[0], lo_[1], lo_[2], lo_[3], hv_[0], hv_[1], hv_[2], hv_[3]}; } } while (0)
                NSA_LDV(0, 0);
                __builtin_amdgcn_sched_barrier(0);
#pragma unroll
                for (int d = 0; d < 4; ++d) {
                    if (d + 1 < 4) NSA_LDV(d + 1, (d + 1) & 1);
                    __builtin_amdgcn_sched_barrier(0);
#pragma unroll
                    for (int ks = 0; ks < 4; ++ks) o[d] = __builtin_amdgcn_mfma_f32_32x32x16_bf16(pa[ks], vfr[d & 1][ks], o[d], 0, 0, 0);
                    __builtin_amdgcn_sched_barrier(0);
                }
#undef NSA_LDV
            }
        }
        asm volatile("s_waitcnt vmcnt(0) lgkmcnt(0)" ::: "memory"); __builtin_amdgcn_s_barrier(); asm volatile("" ::: "memory");
    }
}

template <int BR>
__device__ __forceinline__ void run_tiles_stag(LAS unsigned char* lds, const bf16_t* Kb, const bf16_t* Vb, int ntiles, int first, int qt, const bf16x8 (&qf)[8], f32x16 (&o)[4], float& l_run,
                                               int t, unsigned selw0, unsigned selw1, unsigned selw2, unsigned selw3, int tid, int wave, int lane) {
    int wv_ = wave; asm volatile("" : "+s"(wv_)); const bool halfB = wv_ >= 4;
    LAS const int* TL = (LAS const int*)(lds + L_TL);
    const unsigned soff = (unsigned)((4 * wave + (lane >> 4)) * 128 + (((lane & 15) ^ (((lane >> 4) << 2) | (wave & 3))) * 8));
    auto tile_of = [&](int i) -> int { return (BR == 1) ? TL[i] : first + i; };
    auto stageK = [&](int tile, int buf) { const bf16_t* ks = Kb + (size_t)tile * 8192 + soff; LAS unsigned char* kd = lds + L_K0 + buf * 16384 + wave * 1024;
        __builtin_amdgcn_global_load_lds((const unsigned*)ks, (LAS unsigned*)kd, 16, 0, 0); __builtin_amdgcn_global_load_lds((const unsigned*)(ks + 4096), (LAS unsigned*)(kd + 8192), 16, 0, 0); };
    auto stageV = [&](int tile, int buf) { const bf16_t* vs = Vb + (size_t)tile * 8192 + soff; LAS unsigned char* vd = lds + L_V0 + buf * 16384 + wave * 1024;
        __builtin_amdgcn_global_load_lds((const unsigned*)vs, (LAS unsigned*)vd, 16, 0, 0); __builtin_amdgcn_global_load_lds((const unsigned*)(vs + 4096), (LAS unsigned*)(vd + 8192), 16, 0, 0); };
    if (ntiles <= 0) return;
    { const int t0_ = tile_of(0); stageK(t0_, 0); stageV(t0_, 0); }
    asm volatile("s_waitcnt vmcnt(0) lgkmcnt(0)" ::: "memory"); __builtin_amdgcn_s_barrier(); asm volatile("" ::: "memory");
    bf16x8 pa[4]; bool act = false;
#pragma unroll
    for (int ks = 0; ks < 4; ++ks) pa[ks] = (bf16x8){0, 0, 0, 0, 0, 0, 0, 0};
    auto qk_sm = [&](int tile, int buf) {
        bool selbit = true;
        if (BR == 1) { const unsigned w = (tile < 32) ? selw0 : (tile < 64) ? selw1 : (tile < 96) ? selw2 : selw3; selbit = (w >> (tile & 31)) & 1u; }
        act = (BR == 1) ? (bool)__any((int)selbit) : true;
        if (!act) return;
        int lv = lane; asm volatile("" : "+v"(lv));
        const int l32 = lv & 31, hi = lv >> 5; const unsigned kx = ((l32 & 3) << 2) | ((l32 >> 2) & 3);
        LAS const unsigned char* kb = lds + L_K0 + buf * 16384;
        const int kbase = tile * 64;
        const bool need_mask = (BR == 1) ? (tile == qt) : ((tile == qt) || (tile == first && qt >= 8));
        const float ps = (BR == 1) ? (selbit ? 1.f : 0.f) : 1.f;
        float sum = 0.f;
#pragma unroll
        for (int h2 = 0; h2 < 2; ++h2) {
            f32x16 pp;
#pragma unroll
            for (int r = 0; r < 16; ++r) pp[r] = 0.f;
            {
                bf16x8 kq[2];
#define NSA_LDK(s_, slot_) do { const unsigned ko_ = 256u * l32 + 16u * ((unsigned)(2 * (s_) + hi) ^ kx); kq[slot_] = *(LAS const bf16x8*)(kb + h2 * 8192 + ko_); } while (0)
                NSA_LDK(0, 0); NSA_LDK(1, 1);
                __builtin_amdgcn_sched_barrier(0);
#pragma unroll
                for (int s = 0; s < 8; s += 2) {
                    pp = __builtin_amdgcn_mfma_f32_32x32x16_bf16(kq[0], qf[s], pp, 0, 0, 0);
                    if (s + 2 < 8) NSA_LDK(s + 2, 0);
                    pp = __builtin_amdgcn_mfma_f32_32x32x16_bf16(kq[1], qf[s + 1], pp, 0, 0, 0);
                    if (s + 3 < 8) NSA_LDK(s + 3, 1);
                    __builtin_amdgcn_sched_barrier(0);
                }
#undef NSA_LDK
            }
            if (need_mask) {
#pragma unroll
                for (int r = 0; r < 16; ++r) { const int ki = kbase + 32 * h2 + crow(r, hi); bool v0;
                    if (BR == 1) v0 = (ki <= t); else v0 = (ki <= t) && (ki > t - 512);
                    pp[r] = v0 ? __builtin_amdgcn_exp2f(pp[r]) * ps : 0.f; }
            } else {
#pragma unroll
                for (int r = 0; r < 16; ++r) pp[r] = __builtin_amdgcn_exp2f(pp[r]) * ps;
            }
#pragma unroll
            for (int r = 0; r < 16; ++r) sum += pp[r];
#pragma unroll
            for (int kk = 0; kk < 2; ++kk) { const int b0 = 8 * kk; u32x4 w;
                w.x = pg8::cvt_pk_bf16(pp[b0], pp[b0 + 1]); w.y = pg8::cvt_pk_bf16(pp[b0 + 2], pp[b0 + 3]); w.z = pg8::cvt_pk_bf16(pp[b0 + 4], pp[b0 + 5]); w.w = pg8::cvt_pk_bf16(pp[b0 + 6], pp[b0 + 7]);
                pa[2 * h2 + kk] = __builtin_bit_cast(bf16x8, w); }
        }
        l_run += sum;
    };
    auto pv = [&](int buf) {
        int lv = lane; asm volatile("" : "+v"(lv));
        const int hi = lv >> 5, blk = (lv >> 4) & 1, tq = (lv & 15) >> 2, tp = lv & 3;
        LAS const unsigned char* vb = lds + L_V0 + buf * 16384;
        bf16x8 vfr[3];
#define NSA_LDV(j_, slot_) do { const int d_ = (j_) >> 2, ks_ = (j_) & 3; \
                const unsigned a0_ = off_b(16 * ks_ + 4 * hi + tq, 4 * d_ + 2 * blk + (tp >> 1)) + 8 * (tp & 1); \
                const unsigned a1_ = off_b(16 * ks_ + 8 + 4 * hi + tq, 4 * d_ + 2 * blk + (tp >> 1)) + 8 * (tp & 1); \
                const v4i16_t lo_ = __builtin_amdgcn_ds_read_tr16_b64_v4i16((LAS v4i16_t*)(vb + a0_)); \
                const v4i16_t hv_ = __builtin_amdgcn_ds_read_tr16_b64_v4i16((LAS v4i16_t*)(vb + a1_)); \
                vfr[slot_] = (bf16x8){lo_[0], lo_[1], lo_[2], lo_[3], hv_[0], hv_[1], hv_[2], hv_[3]}; } while (0)
        NSA_LDV(0, 0); NSA_LDV(1, 1);
        __builtin_amdgcn_sched_barrier(0);
#pragma unroll
        for (int j = 0; j < 16; ++j) {
            if (j + 2 < 16) NSA_LDV(j + 2, (j + 2) % 3);
            __builtin_amdgcn_sched_barrier(0);
            o[j >> 2] = __builtin_amdgcn_mfma_f32_32x32x16_bf16(pa[j & 3], vfr[j % 3], o[j >> 2], 0, 0, 0);
            __builtin_amdgcn_sched_barrier(0);
        }
#undef NSA_LDV
    };
#define NSA_SLOT_END() do { asm volatile("s_waitcnt vmcnt(0) lgkmcnt(0)" ::: "memory"); __builtin_amdgcn_s_barrier(); asm volatile("" ::: "memory"); } while (0)
    const int hsel = halfB ? 1 : 0;
    for (int sl = 0; sl <= 2 * ntiles; ++sl) {
        const int inext = (sl >> 1) + 1;
        const bool staged = inext < ntiles;
        if (staged) { const int tn = tile_of(inext); if (sl & 1) stageV(tn, inext & 1); else stageK(tn, inext & 1); }
        if ((sl & 1) == hsel) { const int i = (sl - hsel) >> 1; if (i < ntiles) qk_sm(tile_of(i), i & 1); }
        else { const int i = (sl - 1 - hsel) >> 1; if (sl - 1 - hsel >= 0 && i < ntiles && act) pv(i & 1); }
        if (staged) asm volatile("s_waitcnt vmcnt(2) lgkmcnt(0)" ::: "memory"); else asm volatile("s_waitcnt vmcnt(0) lgkmcnt(0)" ::: "memory");
        __builtin_amdgcn_s_barrier(); asm volatile("" ::: "memory");
    }
#undef NSA_SLOT_END
}

template <bool FIRST>
__device__ __forceinline__ void flush(f32x16 (&o)[4], float fac, bf16_t* Obase, LAS float* wsf, int l32, int hi) {
    if (hi == 0) wsf[l32] = fac;
    LDS_WAIT(); asm volatile("" ::: "memory");
    bf16_t* pa = Obase + (size_t)hi * DM + l32;
#pragma unroll
    for (int a = 0; a < 4; ++a) { const f32x4 f = *(LAS const f32x4*)(wsf + 8 * a + 4 * hi);
        asm volatile("" : "+v"(pa));
#pragma unroll
        for (int i2 = 0; i2 < 4; ++i2)
#pragma unroll
            for (int d = 0; d < 4; ++d) { bf16_t* op = pa + i2 * 128 + 32 * d; float v = o[d][4 * a + i2] * f[i2]; if (!FIRST) v += bf2f(*op); *op = (bf16_t)f2bf(v); o[d][4 * a + i2] = 0.f; }
        pa += 2 * DM; }
    LDS_WAIT(); asm volatile("" ::: "memory");
}

__device__ __forceinline__ void unit(LAS unsigned char* lds, const bf16_t* KVH, const bf16_t* QH, const bf16_t* KCMP, const float* GATES, bf16_t* O, int b, int g, int qt, int tid, int wave, int lane) {
    asm volatile("" : "+v"(tid)); lane = tid & 63; wave = __builtin_amdgcn_readfirstlane(tid >> 6);
    const int l32 = lane & 31, hi = lane >> 5, tokl = l32 >> 2, rr = l32 & 3;
    const int t0 = qt * 64, t = t0 + wave * 8 + tokl;
    const size_t bg = (size_t)b * 4 + g;
    LAS float* impw = (LAS float*)(lds + L_IMP + wave * IMP_WAVE);
    LAS unsigned* selm = (LAS unsigned*)(lds + L_SELM + wave * 128);
    LAS unsigned* uni = (LAS unsigned*)(lds + L_UNI);
    LAS int* NTL = (LAS int*)(lds + L_NTL); LAS int* TL = (LAS int*)(lds + L_TL);
    LAS float* wsf = (LAS float*)(lds + L_WSF + wave * 128);
    for (int i = lane; i < 8 * IMP_LD; i += 64) impw[i] = 0.f;
    if (tid < 4) uni[tid] = 0u;
    bf16x8 qf[8];
    { const bf16_t* qp = QH + ((bg * 8192 + t0 + wave * 8) * 4 + l32) * 128 + 8 * hi;
#pragma unroll
      for (int s = 0; s < 8; ++s) qf[s] = *(const bf16x8*)(qp + 16 * s); }
    const float* gp = GATES + ((size_t)b * 8192 + t) * 48 + (g * 4 + rr) * 3;
    const float g_cmp = gp[0], g_slc = gp[1], g_win = gp[2];
    bf16_t* Obase = O + ((size_t)b * 8192 + t0 + wave * 8) * DM + g * 512;
    f32x16 o[4];
#pragma unroll
    for (int d = 0; d < 4; ++d)
#pragma unroll
        for (int r = 0; r < 16; ++r) o[d][r] = 0.f;
    LDS_WAIT(); __builtin_amdgcn_s_barrier(); asm volatile("" ::: "memory");
    const bf16_t* Kc = KCMP + bg * 512 * 128; const bf16_t* Vc = KCMP + (size_t)4096 * 128 + bg * 512 * 128;
    const int ntc = ((4 * qt + 2) >> 6) + 1;
    { float l = 0.f;
      run_tiles<0, 0>(lds, Kc, Vc, ntc, 0, qt, qf, o, l, t, 0u, 0u, 0u, 0u, 1.f, 1.f, tid, wave, lane);
      const float ltot = l + xhalf(l); const float inv = ltot > 0.f ? 1.f / ltot : 0.f;
      run_tiles<0, 1>(lds, Kc, Vc, ntc, 0, qt, qf, o, l, t, 0u, 0u, 0u, 0u, inv, g_cmp, tid, wave, lane); }
    flush<true>(o, 1.f, Obase, wsf, l32, hi);
    {
        const int tk = lane >> 3, j = lane & 7; const int nvalid = qt + 1;
        unsigned m0 = 0u, m1 = 0u, m2 = 0u, m3 = 0u;
        auto setbit = [&](int s) { const unsigned bit = 1u << (s & 31); const int w = s >> 5; m0 |= (w == 0) ? bit : 0u; m1 |= (w == 1) ? bit : 0u; m2 |= (w == 2) ? bit : 0u; m3 |= (w == 3) ? bit : 0u; };
        if (nvalid <= 16) { for (int s2 = 0; s2 < nvalid; ++s2) setbit(s2); }
        else {
            setbit(0); setbit(qt); setbit(qt - 1);
            unsigned key[16];
#pragma unroll
            for (int i = 0; i < 16; ++i) { const int s2 = 16 * j + i; const float v = impw[tk * IMP_LD + s2];
                const bool cand = (s2 < nvalid) && (s2 != 0) && (s2 != qt) && (s2 != qt - 1);
                key[i] = cand ? ((__float_as_uint(fmaxf(v, 0.f)) & ~0x7Fu) + (unsigned)(128 - s2)) : 0u; }
            for (int round = 0; round < 13; ++round) {
                unsigned mx = key[0];
#pragma unroll
                for (int i = 1; i < 16; ++i) mx = mx > key[i] ? mx : key[i];
                unsigned o1 = (unsigned)my_shfl_xor((int)mx, 1); mx = mx > o1 ? mx : o1;
                o1 = (unsigned)my_shfl_xor((int)mx, 2); mx = mx > o1 ? mx : o1;
                o1 = (unsigned)my_shfl_xor((int)mx, 4); mx = mx > o1 ? mx : o1;
                if (mx != 0u) { const int sw = (128 - (int)(mx & 0x7Fu)) & 127; setbit(sw); }
#pragma unroll
                for (int i = 0; i < 16; ++i) key[i] = (key[i] == mx) ? 0u : key[i];
            }
        }
        if (j == 0) { selm[tk * 4 + 0] = m0; selm[tk * 4 + 1] = m1; selm[tk * 4 + 2] = m2; selm[tk * 4 + 3] = m3;
            atomicOr((unsigned*)(uni + 0), m0); atomicOr((unsigned*)(uni + 1), m1); atomicOr((unsigned*)(uni + 2), m2); atomicOr((unsigned*)(uni + 3), m3); }
    }
    LDS_WAIT(); __builtin_amdgcn_s_barrier(); asm volatile("" ::: "memory");
    if (tid == 0) { int n = 0; for (int w = 0; w < 4; ++w) { unsigned u = uni[w]; while (u) { const int bpos = __builtin_ctz(u); u &= u - 1; TL[n++] = 32 * w + bpos; } } NTL[0] = n; }
    LDS_WAIT(); __builtin_amdgcn_s_barrier(); asm volatile("" ::: "memory");
    const unsigned sw0 = selm[tokl * 4 + 0], sw1 = selm[tokl * 4 + 1], sw2 = selm[tokl * 4 + 2], sw3 = selm[tokl * 4 + 3];
    const int nsel = __builtin_amdgcn_readfirstlane(NTL[0]);
    { const bf16_t* Ks = KVH + 2 * KVH_SLOT + bg * 8192 * 128; const bf16_t* Vs = KVH + 3 * KVH_SLOT + bg * 8192 * 128;
      float l = 0.f;
      run_tiles<1, 2>(lds, Ks, Vs, nsel, 0, qt, qf, o, l, t, sw0, sw1, sw2, sw3, 1.f, 1.f, tid, wave, lane);
      const float ltot = l + xhalf(l);
      flush<false>(o, ltot > 0.f ? g_slc / ltot : 0.f, Obase, wsf, l32, hi); }
    { const bf16_t* Kw = KVH + 4 * KVH_SLOT + bg * 8192 * 128; const bf16_t* Vw = KVH + 5 * KVH_SLOT + bg * 8192 * 128;
      const int first = qt >= 8 ? qt - 8 : 0; float l = 0.f;
      run_tiles<2, 2>(lds, Kw, Vw, qt - first + 1, first, qt, qf, o, l, t, 0u, 0u, 0u, 0u, 1.f, 1.f, tid, wave, lane);
      const float ltot = l + xhalf(l);
      flush<false>(o, ltot > 0.f ? g_win / ltot : 0.f, Obase, wsf, l32, hi); }
    LDS_WAIT(); __builtin_amdgcn_s_barrier(); asm volatile("" ::: "memory");
}
}


constexpr size_t WS_CTL = WS_MISC + 63 * MiB; constexpr size_t CTL_ZERO_BYTES = 16384;
#define XB_TMO      128
#define XB_XCNT(j)  (256  + 64 * (j))
#define XB_XSUB(j)  (1280 + 64 * (j))
#define XB_XGEN(j)  (2304 + 64 * (j))
#define XB_TOP      3328
#define XB_TOPGEN   3392
#define XB_SPIN_CAP (1u << 18)
__device__ __forceinline__ unsigned xb_ld(unsigned* p)              { return __hip_atomic_load(p, __ATOMIC_RELAXED, __HIP_MEMORY_SCOPE_AGENT); }
__device__ __forceinline__ unsigned xb_add(unsigned* p, unsigned v) { return __hip_atomic_fetch_add(p, v, __ATOMIC_RELAXED, __HIP_MEMORY_SCOPE_AGENT); }
__device__ __forceinline__ unsigned xb_xcc_id() { return (unsigned)__builtin_amdgcn_s_getreg((3 << 11) | 20) & 0xFu; }
#define XB_SPIN(cond, bar) do { unsigned _sp = 0; while (cond) { __builtin_amdgcn_s_sleep(1); \
    if ((++_sp & 255u) == 0u) { if (xb_ld(&(bar)[XB_TMO])) break; if (_sp > XB_SPIN_CAP) { atomicAdd(&(bar)[XB_TMO], 1u); break; } } } } while (0)
struct XcdBarrier { unsigned* bar; unsigned x; volatile LAS unsigned* st; };
__device__ __forceinline__ XcdBarrier xcd_barrier_post(unsigned* bar, volatile LAS unsigned* st, bool t0) {
    XcdBarrier b; b.bar = bar; b.x = xb_xcc_id(); b.st = st;
    if (t0) (void)xb_add(&bar[XB_XCNT(b.x)], 1u);
    return b;
}
__device__ __forceinline__ void xcd_barrier_complete(unsigned* bar, unsigned x, unsigned& nloc, unsigned& nx) {
    const unsigned G = gridDim.x * gridDim.y * gridDim.z;
    unsigned sum, cnt, mine, sp = 0u;
    for (;;) {
        sum = 0u; cnt = 0u; mine = 0u;
#pragma unroll
        for (unsigned j = 0; j < 16; ++j) { const unsigned c = xb_ld(&bar[XB_XCNT(j)]); sum += c; cnt += (c > 0u) ? 1u : 0u; mine = (j == x) ? c : mine; }
        if (sum == G) break;
        __builtin_amdgcn_s_sleep(1);
        if ((++sp & 255u) == 0u) { if (xb_ld(&bar[XB_TMO])) break; if (sp > XB_SPIN_CAP) { atomicAdd(&bar[XB_TMO], 1u); break; } }
    }
    nloc = mine > 0u ? mine : 1u; nx = cnt > 0u ? cnt : 1u;
}
__device__ __forceinline__ void xcd_barrier(const XcdBarrier& b, bool t0) {
    asm volatile("s_waitcnt vmcnt(0)" ::: "memory");
    __syncthreads();
    if (t0) {
        unsigned* bar = b.bar;
        __builtin_amdgcn_s_waitcnt(0);
        unsigned nloc = b.st[0], nx = b.st[1];
        if (nloc == 0u) { xcd_barrier_complete(bar, b.x, nloc, nx); b.st[0] = nloc; b.st[1] = nx; }
        const unsigned old = xb_add(&bar[XB_XSUB(b.x)], 1u);
        const unsigned gen = old / nloc;
        if (old + 1u == (gen + 1u) * nloc) {
            __builtin_amdgcn_fence(__ATOMIC_RELEASE, "agent");
            asm volatile("s_waitcnt vmcnt(0)" ::: "memory");
            const unsigned og = xb_add(&bar[XB_TOP], 1u);
            const unsigned tg = og / nx;
            if (og + 1u == (tg + 1u) * nx) xb_add(&bar[XB_TOPGEN], 1u);
            else XB_SPIN(xb_ld(&bar[XB_TOPGEN]) == tg, bar);
            __builtin_amdgcn_fence(__ATOMIC_ACQUIRE, "agent");
            xb_add(&bar[XB_XGEN(b.x)], 1u);
            asm volatile("s_waitcnt vmcnt(0)" ::: "memory");
        } else {
            XB_SPIN(xb_ld(&bar[XB_XGEN(b.x)]) == gen, bar);
            __builtin_amdgcn_fence(__ATOMIC_ACQUIRE, "agent");
            asm volatile("s_waitcnt vmcnt(0)" ::: "memory");
        }
    }
    __syncthreads();
}

__global__ void __launch_bounds__(NTHREADS, 2) fwd_kernel(Args args) {
    extern __shared__ __attribute__((aligned(16))) unsigned char lds_raw[];
    LAS unsigned char* lds = (LAS unsigned char*)lds_raw;
    cg::grid_group grid = cg::this_grid();
    const int G = gridDim.x;
    const int NGW = G * NWAVES, gthreads = G * NTHREADS;
#define bid ({ int b_ = (int)blockIdx.x; asm volatile("" : "+s"(b_)); b_; })
    const int wave0 = __builtin_amdgcn_readfirstlane((int)threadIdx.x >> 6);
#define lane ({ int l_; asm volatile("v_mbcnt_lo_u32_b32 %0, -1, 0\n\tv_mbcnt_hi_u32_b32 %0, -1, %0" : "=v"(l_)); l_; })
#define wave wave0
#define tid (wave0 * 64 + lane)
#define gw (bid * NWAVES + wave)
#define gtid (bid * NTHREADS + tid)
#define ws ((unsigned char*)argp(30))
#define XF ((float*)argp(29))
#define XB ((bf16_t*)(ws + WS_XB))
#define HID ((bf16_t*)(ws + OV_HID))
#define ln_g INP(I_LNG)
#define ln_b INP(I_LNB)
#define T1 ((bf16_t*)(ws + OV_T1))
#define T2 ((bf16_t*)(ws + OV_T2))
#define T3 ((bf16_t*)(ws + OV_T3))
#define STP ((f32x2*)(ws + MS_STATS))
#define GSYNC_CG() do { asm volatile("s_waitcnt vmcnt(0) lgkmcnt(0)" ::: "memory"); grid.sync(); asm volatile("s_waitcnt vmcnt(0) lgkmcnt(0)" ::: "memory"); __builtin_amdgcn_s_barrier(); asm volatile("" ::: "memory"); } while (0)
#define GSYNC() do { asm volatile("s_waitcnt vmcnt(0) lgkmcnt(0)" ::: "memory"); XcdBarrier xb_; xb_.bar = (unsigned*)(ws + WS_CTL); xb_.x = xb_xcc_id(); xb_.st = (volatile LAS unsigned*)(lds + LDS_BYTES - 64); xcd_barrier(xb_, tid == 0); asm volatile("" ::: "memory"); } while (0)
    volatile LAS unsigned* xst = (volatile LAS unsigned*)(lds + LDS_BYTES - 64);
    if (tid == 0) { xst[0] = 0u; xst[1] = 0u; }
    __syncthreads();
    (void)xcd_barrier_post((unsigned*)(ws + WS_CTL), xst, tid == 0);

    {
        LAS float* scr = (LAS float*)(lds + wave * 16384);
        conv_matrix<0>(INP(I_S5_WIN), 2048, 2048, 2048, (bf16_t*)(ws + WS_WIN), 2048, 0, scr, gw, NGW, lane);
        conv_matrix<1>(INP(I_S5_WGLU), 2048, 4096, 4096, (bf16_t*)(ws + WS_WGLU), 2048, 0, scr, gw, NGW, lane);
        conv_matrix<0>(INP(I_S5_WOUT), 2048, 2048, 2048, (bf16_t*)(ws + WS_WOUT), 2048, 0, scr, gw, NGW, lane);
        conv_matrix<0>(INP(I_KVW), 2048, 3072, 3072, (bf16_t*)(ws + WS_WKVQ), 2048, 0, scr, gw, NGW, lane);
        conv_matrix<0>(INP(I_WQG), 2048, 2096, 2048, (bf16_t*)(ws + WS_WKVQ), 2048, 3072, scr, gw, NGW, lane);
        conv_matrix<0>(INP(I_WQG) + 2048, 2048, 2096, 48, (bf16_t*)(ws + WS_WKVQ), 2048, 5120, scr, gw, NGW, lane);
        conv_matrix<0>(INP(I_WNO), 2048, 2048, 2048, (bf16_t*)(ws + WS_WNO), 2048, 0, scr, gw, NGW, lane);
        for (int l = 0; l < 2; ++l) {
            cvt_rows(INP(I_MWQ) + (size_t)l * 2048 * 2048, (bf16_t*)(ws + WS_WMQ + l * 8 * MiB), (size_t)2048 * 2048, gtid, gthreads);
            conv_matrix<0>(INP(I_MWKV) + (size_t)l * 2048 * 4096, 2048, 4096, 4096, (bf16_t*)(ws + WS_WMKV + l * 16 * MiB), 2048, 0, scr, gw, NGW, lane);
            conv_matrix<0>(INP(I_MWO) + (size_t)l * 2048 * 2048, 2048, 2048, 2048, (bf16_t*)(ws + WS_WMO + l * 8 * MiB), 2048, 0, scr, gw, NGW, lane);
            conv_matrix<0>(INP(I_WUP) + (size_t)l * 2048 * 8192, 2048, 8192, 8192, (bf16_t*)(ws + WS_WUP + l * 32 * MiB), 2048, 0, scr, gw, NGW, lane);
            conv_matrix<0>(INP(I_WDN) + (size_t)l * 8192 * 2048, 8192, 2048, 2048, (bf16_t*)(ws + WS_WDN + l * 32 * MiB), 8192, 0, scr, gw, NGW, lane);
        }
        cvt_rows(INP(I_X), XB, (size_t)MTOK * DM, gtid, gthreads);
        cvt_rows(INP(I_MEM), (bf16_t*)(ws + MS_MEMB), (size_t)512 * DM, gtid, gthreads);
        for (int q = 0; q < 4; ++q) { const int which = q >> 1, half = q & 1;
            conv_matrix<0>((which ? INP(I_CW1V) : INP(I_CW1K)) + (size_t)half * 2048 * 128, 2048, 128, 128, (bf16_t*)(ws + WS_WC1 + which * MiB), 2048, 128 * half, scr, gw, NGW, lane); }
        if (bid == G - 1) cmp_bias(INP(I_CPK), INP(I_CW1K), INP(I_CPV), INP(I_CW1V), (float*)(ws + MS_CB), tid);
        s5_tables(INP(I_S5_ARE), INP(I_S5_AIM), INP(I_S5_LOGDT), INP(I_S5_BRE), INP(I_S5_BIM), INP(I_S5_CRE), INP(I_S5_CIM), ws, gtid, gthreads);
    }
    GSYNC_CG();
    for (int layer = 0; layer < 2; ++layer) {

        if (layer == 0) {
            { pg8::Gemm g{XB, (const bf16_t*)(ws + WS_WIN), DM, DM, DM}; pg8::StaticOrder S; S.init(MTOK, DM, DM, DM, G, bid);
              pg8::EpiCols8<StoreBf16> E{StoreBf16{T1, DM, 1.f}}; pg8::gemm_phase(lds, g, S, E, wave0); }
            { pg8::Gemm g{(const bf16_t*)(ws + MS_MEMB), (const bf16_t*)(ws + WS_WMKV), DM, DM, DM}; KvSched S{G, bid};
              pg8::EpiCols8<StoreBf16Z> E{StoreBf16Z{(bf16_t*)(ws + MS_MKV), 4096, 1.f, (size_t)512 * 4096}}; pg8::gemm_phase(lds, g, S, E, wave0); }
            GSYNC();
            s5_pass<false>(T1, T2, INP(I_S5_D), ws, lds, gw, NGW, wave, lane);
            GSYNC();
            s5_pass<true>(T1, T2, INP(I_S5_D), ws, lds, gw, NGW, wave, lane);
            GSYNC();
            { pg8::Gemm g{T2, (const bf16_t*)(ws + WS_WGLU), DM, DM, DM}; pg8::StaticOrder S; S.init(MTOK, 2 * DM, DM, DM, G, bid);
              EpiGlu E{T1, DM}; pg8::gemm_phase(lds, g, S, E, wave0); }
            { pg8::Gemm g{(const bf16_t*)(ws + MS_MKV), (const bf16_t*)(ws + WS_WMQ), 4096, 2048, 512}; MtSched S{G, bid};
              pg8::EpiCols8<StoreBf16Z> E{StoreBf16Z{(bf16_t*)(ws + WS_MT), 2048, 0.044194173824159216f * 1.4426950408889634f, (size_t)1024 * 2048}}; pg8::gemm_phase(lds, g, S, E, wave0); }
            { pg8::Gemm g{(const bf16_t*)(ws + WS_WMO), (const bf16_t*)(ws + MS_MKV), 2048, 4096, 512}; VwSched S{G, (G == 256) ? ((bid + 128) & 255) : bid};
              pg8::EpiCols8<StoreBf16Z> E{StoreBf16Z{(bf16_t*)(ws + WS_VWT), 1024, 1.f, (size_t)2048 * 1024}}; pg8::gemm_phase(lds, g, S, E, wave0); }
            GSYNC();
            { pg8::Gemm g{T1, (const bf16_t*)(ws + WS_WOUT), DM, DM, DM}; pg8::StaticOrder S; S.init(MTOK, DM, DM, DM, G, bid);
              pg8::EpiRes<0> E{INP(I_X), XF, nullptr, nullptr, nullptr, DM, DN_ALPHA}; pg8::gemm_phase(lds, g, S, E, wave0); }
            GSYNC();
            ln_phase<false>(XF, 1.f, XF, XB, STP, ln_g + (layer * 3 + 0) * DM, ln_b + (layer * 3 + 0) * DM, gw, NGW, lane);
        } else {
            { pg8::Gemm g{XB, (const bf16_t*)(ws + WS_WKVQ), DM, DM, DM}; pg8::StaticOrder S; S.init(MTOK, 5376, DM, DM, G, bid);
              pg8::EpiCols8<StoreKVQ> E{StoreKVQ{(bf16_t*)(ws + OV_KVH), (bf16_t*)(ws + OV_QH), (float*)(ws + MS_GATES), 0.08838834764831845f * 1.4426950408889634f}}; pg8::gemm_phase(lds, g, S, E, wave0); }
            GSYNC();
            { pg8::Gemm g{(const bf16_t*)(ws + OV_KVH), (const bf16_t*)(ws + WS_WC1), 2048, 2048, 512}; CmpSched S{G, bid};
              pg8::EpiCols8<StoreF32> E{StoreF32{(float*)(ws + MS_PAB), 256, (size_t)4096 * 256}}; pg8::gemm_phase(lds, g, S, E, wave0); }
            GSYNC();
            cmp_combine((const float*)(ws + MS_PAB), (const float*)(ws + MS_CB), INP(I_CW2K), INP(I_CW2V), (bf16_t*)(ws + MS_KCMP), gw, NGW, lane);
            GSYNC();
            for (int vb = bid; vb < 256; vb += G) {
                const int bgi = vb >> 5, sidx = vb & 31;
                for (int i = 0; i < 4; ++i) { const int qt = (i == 0) ? sidx : (i == 1) ? 63 - sidx : (i == 2) ? 64 + sidx : 127 - sidx;
                    nsa::unit(lds, (const bf16_t*)(ws + OV_KVH), (const bf16_t*)(ws + OV_QH), (const bf16_t*)(ws + MS_KCMP), (const float*)(ws + MS_GATES), T1, bgi >> 2, bgi & 3, qt, tid, wave, lane); }
            }
            GSYNC();
            { pg8::Gemm g{T1, (const bf16_t*)(ws + WS_WNO), DM, DM, DM}; pg8::StaticOrder S; S.init(MTOK, DM, DM, DM, G, bid);
              pg8::EpiRes<1> E{XF, XF, STP, ln_g + 2 * DM, ln_b + 2 * DM, DM, DN_ALPHA}; pg8::gemm_phase(lds, g, S, E, wave0); }
            GSYNC();
            ln_phase<false>(XF, 1.f, XF, XB, STP, ln_g + (layer * 3 + 0) * DM, ln_b + (layer * 3 + 0) * DM, gw, NGW, lane);
        }
        GSYNC();
        for (int base = 0; base < 256; base += G) {
            pg8::Gemm g{XB, (const bf16_t*)(ws + WS_MT), DM, DM, DM}; ScoreSched S{G, bid, base, (base + G < 256) ? base + G : 256, layer};
            EpiSoftmax E{T2}; pg8::gemm_phase(lds, g, S, E, wave0);
        }
        GSYNC();
        { pg8::Gemm g{T2, (const bf16_t*)(ws + WS_VWT), 1024, 1024, 1024}; PvoSched S; S.so.init(MTOK, DM, 1024, 1024, G, bid); S.layer = layer;
          pg8::EpiRes<1> E{XF, XF, STP, ln_g + (layer * 3 + 0) * DM, ln_b + (layer * 3 + 0) * DM, DM, DN_ALPHA}; pg8::gemm_phase(lds, g, S, E, wave0); }
        GSYNC();
        ln_phase<false>(XF, 1.f, XF, XB, STP, ln_g + (layer * 3 + 1) * DM, ln_b + (layer * 3 + 1) * DM, gw, NGW, lane);
        GSYNC();
        {
            pg8::Gemm g{XB, (const bf16_t*)(ws + WS_WUP + layer * 32 * MiB), DM, DM, DM};
            pg8::StaticOrder S; S.init(MTOK, DFF, DM, DM, G, bid);
            pg8::EpiCols8<StoreRelu2> E{StoreRelu2{HID, DFF}};
            pg8::gemm_phase(lds, g, S, E, wave0);
        }
        GSYNC();
        {
            pg8::Gemm g{HID, (const bf16_t*)(ws + WS_WDN + layer * 32 * MiB), DFF, DFF, DFF};
            pg8::StaticOrder S; S.init(MTOK, DM, DFF, DFF, G, bid);
            pg8::EpiRes<1> E{XF, XF, STP, ln_g + (layer * 3 + 1) * DM, ln_b + (layer * 3 + 1) * DM, DM, DN_ALPHA};
            pg8::gemm_phase(lds, g, S, E, wave0);
        }
        GSYNC();
        if (layer == 1) ln_phase<true>(XF, 1.f, XF, XB, STP, ln_g + (layer * 3 + 2) * DM, ln_b + (layer * 3 + 2) * DM, gw, NGW, lane);
        else ln_phase<false>(XF, 1.f, XF, XB, STP, ln_g + (layer * 3 + 2) * DM, ln_b + (layer * 3 + 2) * DM, gw, NGW, lane);
        GSYNC();
    }
}

#undef ws
#undef XF
#undef XB
#undef HID
#undef ln_g
#undef ln_b
#undef T1
#undef T2
#undef T3
#undef STP
#undef bid
#undef tid
#undef lane
#undef wave
#undef gw
#undef gtid
extern "C" void kernel_launch(void* const* d_in, const int* in_sizes, int n_in, void* d_out, int out_size, void* d_ws, size_t ws_size, hipStream_t stream) {
    static int grid = 0;
    if (grid == 0) {
        if (n_in != 29 || ws_size < WS_END) { fprintf(stderr, "kernel_launch: unexpected n_in %d or ws %zu (< %zu)\n", n_in, ws_size, (size_t)WS_END); grid = -1; return; }
        int dev = 0, cus = 0, per_cu = 0;
        hipGetDevice(&dev); hipDeviceGetAttribute(&cus, hipDeviceAttributeMultiprocessorCount, dev);
        hipFuncSetAttribute((const void*)fwd_kernel, hipFuncAttributeMaxDynamicSharedMemorySize, LDS_BYTES);
        hipOccupancyMaxActiveBlocksPerMultiprocessor(&per_cu, (const void*)fwd_kernel, NTHREADS, LDS_BYTES);
        if (per_cu < 1) { fprintf(stderr, "kernel_launch: occupancy query says %d blocks/CU\n", per_cu); per_cu = 1; }
        (void)hipGetLastError();
        grid = cus;
    }
    if (grid < 0) return;
    if (hipMemsetAsync((char*)d_ws + WS_CTL, 0, CTL_ZERO_BYTES, stream) != hipSuccess) { fprintf(stderr, "kernel_launch: memset of the barrier words failed\n"); return; }
    Args a{};
    for (int i = 0; i < 29; ++i) a.in[i] = (const float*)d_in[i];
    a.out = (float*)d_out; a.ws = (unsigned char*)d_ws; a.ph_lo = 0; a.ph_hi = 100;
    void* kargs[] = {&a};
    hipError_t e = hipLaunchCooperativeKernel((const void*)fwd_kernel, dim3(grid), dim3(NTHREADS), kargs, LDS_BYTES, stream);
    if (e != hipSuccess) fprintf(stderr, "cooperative launch failed: %s (grid %d)\n", hipGetErrorString(e), grid);
}
```

```cpp
#include <hip/hip_runtime.h>
#include <hip/hip_cooperative_groups.h>
#include <cstdio>
#include <cstdint>
namespace cg = cooperative_groups;

#define LAS __attribute__((address_space(3)))
typedef unsigned short bf16_t;
typedef short bf16x8 __attribute__((ext_vector_type(8)));
typedef float f32x4 __attribute__((ext_vector_type(4)));
typedef float f32x2 __attribute__((ext_vector_type(2)));
typedef float f32x16 __attribute__((ext_vector_type(16)));
typedef unsigned u32x4 __attribute__((ext_vector_type(4)));
typedef unsigned u32x2 __attribute__((ext_vector_type(2)));

constexpr int SEQ = 8192, BATCH = 2, DM = 2048, MTOK = BATCH * SEQ, DFF = 8192;
constexpr float LN_EPS = 1e-5f;
constexpr float DN_ALPHA = 1.4142135623730951f;
constexpr int NWAVES = 8, NTHREADS = 512;
constexpr int LDS_BYTES = 147456;

constexpr size_t MiB = 1u << 20;
constexpr size_t WS_WIN = 0;
constexpr size_t WS_WGLU = WS_WIN + 8 * MiB;
constexpr size_t WS_WOUT = WS_WGLU + 16 * MiB;
constexpr size_t WS_WKVQ = WS_WOUT + 8 * MiB;
constexpr size_t WS_WNO = WS_WKVQ + 22 * MiB;
constexpr size_t WS_WMQ = WS_WNO + 8 * MiB;
constexpr size_t WS_WMKV = WS_WMQ + 16 * MiB;
constexpr size_t WS_WMO = WS_WMKV + 32 * MiB;
constexpr size_t WS_WUP = WS_WMO + 16 * MiB;
constexpr size_t WS_WDN = WS_WUP + 64 * MiB;
constexpr size_t WS_WC1 = WS_WDN + 64 * MiB;
constexpr size_t WS_XB = WS_WC1 + 2 * MiB;
constexpr size_t WS_OVL = WS_XB + 64 * MiB;
constexpr size_t WS_MISC = WS_OVL + 256 * MiB;
constexpr size_t WS_END = WS_MISC + 64 * MiB;
constexpr size_t OV_T1 = WS_OVL;
constexpr size_t OV_T2 = WS_OVL + 64 * MiB;
constexpr size_t OV_T3 = WS_OVL + 128 * MiB;
constexpr size_t OV_KV = WS_OVL + 128 * MiB;
constexpr size_t OV_HID = WS_OVL;
constexpr size_t MS_MEMB = WS_MISC;
constexpr size_t MS_MKV = WS_MISC + 2 * MiB;
constexpr size_t MS_MK = WS_MISC + 2 * MiB;
constexpr size_t MS_MVT = WS_MISC + 6 * MiB;
constexpr size_t MS_S5AB = WS_MISC + 10 * MiB;
constexpr size_t MS_S5ABL = MS_S5AB + 65536;
constexpr size_t MS_S5BM = MS_S5ABL + 65536;
constexpr size_t MS_S5CM = MS_S5BM + 524288;
constexpr size_t MS_S5E = MS_S5CM + 524288;
constexpr size_t MS_S5SIN = MS_S5E + 1048576;
constexpr int S5_NCH = 8, S5_LC = SEQ / S5_NCH;
constexpr size_t MS_STATS = WS_MISC + 14 * MiB;
constexpr size_t WS_MT = WS_MISC + 22 * MiB;
constexpr size_t WS_VWT = WS_MISC + 38 * MiB;
constexpr size_t MS_GATES = WS_MISC + 16 * MiB;
constexpr size_t MS_CB = WS_MISC + 20 * MiB;
constexpr size_t MS_PAB = OV_T1;
constexpr size_t MS_KCMP = WS_MISC + 54 * MiB;
constexpr size_t OV_KVH = WS_OVL + 64 * MiB;
constexpr size_t OV_QH = WS_OVL + 160 * MiB;
constexpr size_t KVH_SLOT = (size_t)2 * 4 * 8192 * 128;

__device__ __forceinline__ unsigned f2bf(float f) { unsigned u = __builtin_bit_cast(unsigned, f); return (u + 0x7fffu + ((u >> 16) & 1u)) >> 16; }
__device__ __forceinline__ unsigned pk2(float lo, float hi) { unsigned r; asm volatile("v_cvt_pk_bf16_f32 %0, %1, %2" : "=v"(r) : "v"(lo), "v"(hi)); return r; }
__device__ __forceinline__ float bf2f(unsigned short h) { return __builtin_bit_cast(float, (unsigned)h << 16); }

__device__ __forceinline__ int lane_now() { int l_; asm volatile("v_mbcnt_lo_u32_b32 %0, -1, 0\n\tv_mbcnt_hi_u32_b32 %0, -1, %0" : "=v"(l_)); return l_; }
__device__ __forceinline__ float my_shfl_xor(float v, int o) { return __builtin_bit_cast(float, __builtin_amdgcn_ds_bpermute((lane_now() ^ o) << 2, __builtin_bit_cast(int, v))); }
__device__ __forceinline__ int my_shfl_xor(int v, int o) { return __builtin_amdgcn_ds_bpermute((lane_now() ^ o) << 2, v); }
__device__ __forceinline__ float my_shfl(float v, int src) { return __builtin_bit_cast(float, __builtin_amdgcn_ds_bpermute(src << 2, __builtin_bit_cast(int, v))); }
__device__ __forceinline__ float wave_sum(float v) {
#pragma unroll
    for (int o = 1; o < 64; o <<= 1) v += my_shfl_xor(v, o);
    return v;
}
#define LDS_WAIT() asm volatile("s_waitcnt lgkmcnt(0)" ::: "memory")

namespace pg8 {
constexpr int BM = 256, BK = 64, HALF = 128, HTB = HALF * BK * 2, STAGE_BYTES = 8 * HTB, NXCD = 8, WGM = 8;
__host__ __device__ __forceinline__ int lds_byte(int r, int c) { const int st = (r >> 4) * 2 + (c >> 5), rr = r & 15, cc = c & 31, ob = rr * 64 + cc * 2; return st * 1024 + (ob ^ (((ob >> 9) & 1) << 5)); }
__host__ __device__ __forceinline__ void stage_rc(int b, int& R, int& C) { const int st = b / 1024, sb = b % 1024, swz = sb ^ (((sb >> 9) & 1) << 5); R = (st >> 1) * 16 + swz / 64; C = (st & 1) * 32 + (swz % 64) / 2; }
__host__ __device__ __forceinline__ int perm32(int rho) { const int n = rho >> 4, i = rho & 15; return 8 * (i >> 2) + 4 * n + (i & 3); }

struct Unit { int pm, pn, z; unsigned ao, bo; };
struct Gemm { const bf16_t* A; const bf16_t* Bt; int lda, ldb, K; };

struct StaticOrder {
    int nM, nN, nwg, G, c; unsigned ta, tb;
    __device__ void init(int M, int N, int lda, int ldb, int G_, int c_) { nM = M / BM; nN = N / BM; nwg = nM * nN; G = G_; c = c_; ta = (unsigned)BM * lda * 2; tb = (unsigned)BM * ldb * 2; }
    __device__ bool next(int i, Unit& u) const {
        const long L = (long)i * G + c; if (L >= nwg) return false;
        int wgid = (int)L; { const int q = nwg / NXCD, r = nwg % NXCD, xcd = wgid % NXCD, off = wgid / NXCD; wgid = (xcd < r ? xcd * (q + 1) : r * (q + 1) + (xcd - r) * q) + off; }
        const int nig = WGM * nN, gid = wgid / nig, fm = gid * WGM, gsz = (nM - fm) < WGM ? (nM - fm) : WGM;
        u.pm = fm + ((wgid % nig) % gsz); u.pn = (wgid % nig) / gsz; u.z = 0; u.ao = (unsigned)u.pm * ta; u.bo = (unsigned)u.pn * tb; return true;
    }
};

__device__ __forceinline__ unsigned cvt_pk_bf16(float lo, float hi) { unsigned r; asm volatile("v_cvt_pk_bf16_f32 %0, %1, %2" : "=v"(r) : "v"(lo), "v"(hi)); return r; }


template <class Epi, class Sched>
__device__ __forceinline__ void gemm_phase(LAS unsigned char* lds, const Gemm g, const Sched& S, const Epi& E, int wv) {
    int tid; asm volatile("v_mbcnt_lo_u32_b32 %0, -1, 0\n\tv_mbcnt_hi_u32_b32 %0, -1, %0" : "=v"(tid)); tid += wv * 64;
    const int wid = __builtin_amdgcn_readfirstlane(tid >> 6), lane = tid & 63, wr = wid >> 2, wc = wid & 3, fr = lane & 15, fq = lane >> 4;
    int nt = g.K / BK; asm volatile("" : "+s"(nt));
    unsigned voffA[2], voffB[2];
#pragma unroll
    for (int i = 0; i < 2; ++i) { int R, C; stage_rc(tid * 16 + i * 8192, R, C); const int Rb = Epi::PERM ? ((R & ~31) + perm32(R & 31)) : R;
        voffA[i] = (unsigned)(R * g.lda + C) * 2u; voffB[i] = (unsigned)(Rb * g.ldb + C) * 2u; }
    const size_t kstep = (size_t)(BK * 2);
    const size_t hsA = (size_t)HALF * g.lda * 2, hsB = (size_t)HALF * g.ldb * 2;
    const unsigned ldsw = (unsigned)wid * 1024u;
    const int aoff = lds_byte(wr * 64 + fr, fq * 8), boff = lds_byte(wc * 32 + fr, fq * 8);
#define PG8_SA(b, h) (((b) * 2 + (h)) * HTB)
#define PG8_SB(b, h) ((4 + (b) * 2 + (h)) * HTB)
#define PG8_STAGE(bufoff, gbase, voff) do { _Pragma("unroll") for (int _i = 0; _i < 2; ++_i) \
        __builtin_amdgcn_global_load_lds((const unsigned*)((const char*)(gbase) + (voff)[_i]), (LAS unsigned*)(lds + (bufoff) + ldsw + _i * 8192), 16, 0, 0); } while (0)
#define PG8_LDA(dst, b, h) do { _Pragma("unroll") for (int m = 0; m < 4; ++m) _Pragma("unroll") for (int k = 0; k < 2; ++k) dst[m][k] = *(const LAS bf16x8*)(lds + PG8_SA(b, h) + aoff + m * 2048 + k * 1024); } while (0)
#define PG8_LDB(dst, b, h) do { _Pragma("unroll") for (int n = 0; n < 2; ++n) _Pragma("unroll") for (int k = 0; k < 2; ++k) dst[n][k] = *(const LAS bf16x8*)(lds + PG8_SB(b, h) + boff + n * 2048 + k * 1024); } while (0)
#define PG8_MMA(ai, bj, At, Bt) do { __builtin_amdgcn_s_setprio(1); _Pragma("unroll") for (int m = 0; m < 4; ++m) _Pragma("unroll") for (int n = 0; n < 2; ++n) _Pragma("unroll") for (int k = 0; k < 2; ++k) \
        acc[ai][bj][m][n] = __builtin_amdgcn_mfma_f32_16x16x32_bf16(Bt[n][k], At[m][k], acc[ai][bj][m][n], 0, 0, 0); __builtin_amdgcn_s_setprio(0); } while (0)
#define PG8_WAIT_V(n) asm volatile("s_waitcnt vmcnt(" #n ")" ::: "memory")
#define PG8_WAIT_L(n) asm volatile("s_waitcnt lgkmcnt(" #n ")" ::: "memory")
#define PG8_BAR __builtin_amdgcn_s_barrier()
#define PG8_SCHED __builtin_amdgcn_sched_barrier(0)
    Unit cur, nxt; int ui = 0;
    if (!S.next(0, cur)) return;
    f32x4 acc[2][2][4][2];
#pragma unroll
    for (int a = 0; a < 2; ++a)
#pragma unroll
        for (int b = 0; b < 2; ++b)
#pragma unroll
            for (int m = 0; m < 4; ++m)
#pragma unroll
                for (int n = 0; n < 2; ++n) acc[a][b][m][n] = (f32x4){0.f, 0.f, 0.f, 0.f};
    bf16x8 At[4][2], B0[2][2], B1[2][2];
    const char* cA = (const char*)g.A + cur.ao; const char* cB = (const char*)g.Bt + cur.bo;
    PG8_STAGE(PG8_SB(0, 0), cB, voffB); PG8_STAGE(PG8_SB(0, 1), cB + hsB, voffB); PG8_STAGE(PG8_SA(0, 0), cA, voffA); PG8_STAGE(PG8_SA(0, 1), cA + hsA, voffA);
    if (wr == 1) PG8_BAR;
    PG8_WAIT_V(2); PG8_BAR;
    PG8_STAGE(PG8_SB(1, 0), cB + kstep, voffB); PG8_STAGE(PG8_SA(1, 0), cA + kstep, voffA); PG8_STAGE(PG8_SB(1, 1), cB + hsB + kstep, voffB);
    PG8_WAIT_V(6); PG8_BAR;
    for (;;) {
        const bool has_next = S.next(ui + 1, nxt);
        const char* nA = has_next ? (const char*)g.A + nxt.ao : cA; const char* nB = has_next ? (const char*)g.Bt + nxt.bo : cB;
        for (int t = 0; t < nt; t += 2) {
            const bool last = (t == nt - 2);
            const char* a1 = cA + (size_t)(t + 1) * kstep;
            const char* a2 = last ? nA : cA + (size_t)(t + 2) * kstep; const char* b2 = last ? nB : cB + (size_t)(t + 2) * kstep;
            const char* a3 = a2 + kstep; const char* b3 = b2 + kstep;
            PG8_LDB(B0, 0, 0); PG8_LDB(B1, 0, 1); PG8_SCHED; PG8_LDA(At, 0, 0); PG8_STAGE(PG8_SA(1, 1), a1 + hsA, voffA);
            PG8_WAIT_V(8); PG8_WAIT_L(0); PG8_BAR; PG8_MMA(0, 0, At, B0); PG8_MMA(0, 1, At, B1); PG8_BAR; PG8_SCHED;
            PG8_LDA(At, 0, 1); PG8_STAGE(PG8_SB(0, 0), b2, voffB); PG8_STAGE(PG8_SB(0, 1), b2 + hsB, voffB); PG8_STAGE(PG8_SA(0, 0), a2, voffA);
            PG8_WAIT_V(8); PG8_WAIT_L(0); PG8_BAR; PG8_MMA(1, 0, At, B0); PG8_MMA(1, 1, At, B1); PG8_BAR; PG8_SCHED;
            PG8_LDB(B0, 1, 0); PG8_LDB(B1, 1, 1); PG8_SCHED; PG8_LDA(At, 1, 0); PG8_STAGE(PG8_SA(0, 1), a2 + hsA, voffA);
            PG8_WAIT_V(8); PG8_WAIT_L(0); PG8_BAR; PG8_MMA(0, 0, At, B0); PG8_MMA(0, 1, At, B1); PG8_BAR; PG8_SCHED;
            PG8_LDA(At, 1, 1); PG8_STAGE(PG8_SB(1, 0), b3, voffB); PG8_STAGE(PG8_SB(1, 1), b3 + hsB, voffB); PG8_STAGE(PG8_SA(1, 0), a3, voffA);
            PG8_WAIT_V(8); PG8_WAIT_L(0); PG8_BAR; PG8_MMA(1, 0, At, B0); PG8_MMA(1, 1, At, B1); PG8_BAR; PG8_SCHED;
        }
        if (wr == 0) PG8_BAR;
        if constexpr (!Epi::AFTER_DRAIN) { E(acc, cur, wr, wc, fr, fq); }
        if (!has_next) break;
#pragma unroll
        for (int a = 0; a < 2; ++a)
#pragma unroll
            for (int b = 0; b < 2; ++b)
#pragma unroll
                for (int m = 0; m < 4; ++m)
#pragma unroll
                    for (int n = 0; n < 2; ++n) acc[a][b][m][n] = (f32x4){0.f, 0.f, 0.f, 0.f};
        cur = nxt; cA = nA; cB = nB; ++ui;
        if (wr == 1) PG8_BAR;
    }
    PG8_WAIT_V(0);
    PG8_BAR;
    if constexpr (Epi::AFTER_DRAIN) { E.fused(acc, cur, wr, wc, fr, fq, lds, wid, lane); }
#undef PG8_SA
#undef PG8_SB
#undef PG8_STAGE
#undef PG8_LDA
#undef PG8_LDB
#undef PG8_MMA
#undef PG8_WAIT_V
#undef PG8_WAIT_L
#undef PG8_BAR
#undef PG8_SCHED
}

template <class F> struct EpiCols8 {
    static constexpr bool PERM = true, AFTER_DRAIN = false; F f;
    __device__ __forceinline__ void operator()(const f32x4 (&acc)[2][2][4][2], const Unit& u, int wr, int wc, int fr, int fq) const {
#pragma unroll
        for (int ai = 0; ai < 2; ++ai)
#pragma unroll
            for (int m = 0; m < 4; ++m) { const int row = u.pm * BM + ai * HALF + wr * 64 + m * 16 + fr;
#pragma unroll
                for (int bj = 0; bj < 2; ++bj) f(u, row, u.pn * BM + bj * HALF + wc * 32 + 8 * fq, acc[ai][bj][m][0], acc[ai][bj][m][1]); }
    }
};
template <int MODE> struct EpiRes {
    static constexpr bool PERM = false, AFTER_DRAIN = false; const float* res; float* out; const f32x2* st; const float* g; const float* b; int ldc; float alpha;
    __device__ __forceinline__ void operator()(const f32x4 (&acc)[2][2][4][2], const Unit& u, int wr, int wc, int fr, int fq) const {
        const unsigned row0 = (unsigned)(u.pm * BM + wr * 64 + fr), col0 = (unsigned)(u.pn * BM + wc * 32 + 4 * fq);
        const unsigned base = row0 * (unsigned)ldc + col0;
        f32x4 gv[2][2], bv[2][2];
        if (MODE == 1) {
#pragma unroll
            for (int bj = 0; bj < 2; ++bj)
#pragma unroll
                for (int n = 0; n < 2; ++n) { gv[bj][n] = *(const f32x4*)(g + col0 + bj * HALF + n * 16); bv[bj][n] = *(const f32x4*)(b + col0 + bj * HALF + n * 16); }
        }
#pragma unroll
        for (int ai = 0; ai < 2; ++ai)
#pragma unroll
            for (int mp = 0; mp < 2; ++mp) {
                f32x4 r[2][2][2]; f32x2 sv[2];
#pragma unroll
                for (int mm = 0; mm < 2; ++mm) { const int m = 2 * mp + mm; const unsigned off = base + (unsigned)(ai * HALF + m * 16) * (unsigned)ldc;
                    if (MODE == 1) sv[mm] = st[row0 + ai * HALF + m * 16];
#pragma unroll
                    for (int bj = 0; bj < 2; ++bj)
#pragma unroll
                        for (int n = 0; n < 2; ++n) r[mm][bj][n] = *(const f32x4*)(res + (off + bj * HALF + n * 16)); }
                asm volatile("" ::: "memory");
#pragma unroll
                for (int mm = 0; mm < 2; ++mm) { const int m = 2 * mp + mm; const unsigned off = base + (unsigned)(ai * HALF + m * 16) * (unsigned)ldc;
#pragma unroll
                    for (int bj = 0; bj < 2; ++bj)
#pragma unroll
                        for (int n = 0; n < 2; ++n) { f32x4 x = r[mm][bj][n];
                            if (MODE == 1) x = (x - sv[mm].x) * sv[mm].y * gv[bj][n] + bv[bj][n];
                            *(f32x4*)(out + (off + bj * HALF + n * 16)) = x * alpha + acc[ai][bj][m][n]; } }
                asm volatile("" ::: "memory");
            }
    }
};
}

struct Args { const float* in[29]; float* out; unsigned char* ws; int ph_lo, ph_hi; };
enum { I_X = 0, I_MEM, I_S5_WIN, I_S5_ARE, I_S5_AIM, I_S5_LOGDT, I_S5_BRE, I_S5_BIM, I_S5_CRE, I_S5_CIM, I_S5_D, I_S5_WGLU, I_S5_WOUT, I_KVW,
       I_CPK, I_CW1K, I_CW2K, I_CPV, I_CW1V, I_CW2V, I_WQG, I_WNO, I_MWQ, I_MWKV, I_MWO, I_WUP, I_WDN, I_LNG, I_LNB };

__device__ __forceinline__ const float* argp(int i) {
    const char* kp = (const char*)__builtin_amdgcn_kernarg_segment_ptr(); const float* p;
    asm volatile("s_load_dwordx2 %0, %1, %2\n\ts_waitcnt lgkmcnt(0)" : "=s"(p) : "s"(kp), "i"(i * 8)); return p; }
#define INP(i) argp(i)

__device__ __forceinline__ void conv_item(const float* W, int ldw, int ncols, bf16_t* WT, int ldt, int k0, int n0, int drow0, LAS float* scr, int lane) {
    const int r8 = lane >> 3, c4 = (lane & 7) * 4; const bool ok = (n0 + c4) < ncols;
    f32x4 v[8];
#pragma unroll
    for (int i = 0; i < 8; ++i) v[i] = ok ? *(const f32x4*)(W + (size_t)(k0 + 8 * i + r8) * ldw + n0 + c4) : (f32x4){0.f, 0.f, 0.f, 0.f};
#pragma unroll
    for (int i = 0; i < 8; ++i) { LAS float* d = scr + (8 * i + r8) * 33 + c4; d[0] = v[i].x; d[1] = v[i].y; d[2] = v[i].z; d[3] = v[i].w; }
    LDS_WAIT(); asm volatile("" ::: "memory");
    const int c = lane & 7;
#pragma unroll
    for (int j = 0; j < 4; ++j) { const int n = (lane >> 3) + 8 * j; const LAS float* s = scr + (8 * c) * 33 + n;
        u32x4 o; o.x = pk2(s[0 * 33], s[1 * 33]); o.y = pk2(s[2 * 33], s[3 * 33]); o.z = pk2(s[4 * 33], s[5 * 33]); o.w = pk2(s[6 * 33], s[7 * 33]);
        *(u32x4*)(WT + (size_t)(drow0 + n) * ldt + k0 + 8 * c) = o; }
    LDS_WAIT(); asm volatile("" ::: "memory");
}
template <int MODE>
__device__ __forceinline__ void conv_matrix(const float* W, int K, int ldw, int ncols, bf16_t* WT, int ldt, int row_off, LAS float* scr, int gw, int NGW, int lane) {
    const int nblk = (ncols + 31) / 32, nitems = (K / 64) * nblk;
    for (int it = gw; it < nitems; it += NGW) {
        const int kb = it / nblk, nb = it % nblk, n0 = 32 * nb;
        int drow0;
        if (MODE == 1) { const int bj = n0 >> 11, j = n0 & 2047; drow0 = 256 * (j >> 7) + 128 * bj + (j & 127); } else drow0 = row_off + n0;
        conv_item(W, ldw, ncols, WT, ldt, 64 * kb, n0, drow0, scr, lane);
    }
}
__device__ __forceinline__ void cvt_rows(const float* src, bf16_t* dst, size_t n, int gtid, int gthreads) {
    for (size_t i = (size_t)gtid * 8; i < n; i += (size_t)gthreads * 8) {
        const f32x4 a = *(const f32x4*)(src + i), b = *(const f32x4*)(src + i + 4);
        u32x4 o; o.x = pk2(a.x, a.y); o.y = pk2(a.z, a.w); o.z = pk2(b.x, b.y); o.w = pk2(b.z, b.w);
        *(u32x4*)(dst + i) = o;
    }
}
template <bool WF32>
__device__ __forceinline__ void ln_phase(const float* src, float prescale, float* XF, bf16_t* XB, f32x2* ST, const float* g, const float* b, int gw, int NGW, int lane) {
    asm volatile("" : "+v"(lane));
    for (int row = gw; row < MTOK; row += NGW) {
        const f32x4* xr = (const f32x4*)(src + (size_t)row * DM) + lane;
        f32x4 v[8]; float s = 0.f;
#pragma unroll
        for (int j = 0; j < 8; ++j) { v[j] = xr[64 * j] * prescale; s += (v[j].x + v[j].y) + (v[j].z + v[j].w); }
        const float mean = wave_sum(s) * (1.f / DM); float s2 = 0.f;
#pragma unroll
        for (int j = 0; j < 8; ++j) { v[j] = v[j] - mean; s2 += (v[j].x * v[j].x + v[j].y * v[j].y) + (v[j].z * v[j].z + v[j].w * v[j].w); }
        const float rstd = 1.f / sqrtf(wave_sum(s2) * (1.f / DM) + LN_EPS);
        if (!WF32 && lane == 0) ST[row] = (f32x2){mean, rstd};
        f32x4* xo = (f32x4*)(XF + (size_t)row * DM) + lane; u32x2* bo = (u32x2*)(XB + (size_t)row * DM) + lane;
#pragma unroll
        for (int j = 0; j < 8; ++j) { const f32x4 gv = ((const f32x4*)g)[lane + 64 * j], bv = ((const f32x4*)b)[lane + 64 * j];
            const f32x4 o = v[j] * rstd * gv + bv; if (WF32) xo[64 * j] = o; else { u32x2 w; w.x = pk2(o.x, o.y); w.y = pk2(o.z, o.w); bo[64 * j] = w; } }
    }
}

struct StoreBf16 { bf16_t* O; int ldc; float scale;
    __device__ __forceinline__ void operator()(const pg8::Unit&, int row, int col, f32x4 v0, f32x4 v1) const {
        u32x4 w; w.x = pg8::cvt_pk_bf16(v0[0] * scale, v0[1] * scale); w.y = pg8::cvt_pk_bf16(v0[2] * scale, v0[3] * scale); w.z = pg8::cvt_pk_bf16(v1[0] * scale, v1[1] * scale); w.w = pg8::cvt_pk_bf16(v1[2] * scale, v1[3] * scale);
        *(u32x4*)(O + (size_t)row * ldc + col) = w; } };
struct StoreRelu2 { bf16_t* O; int ldc;
    __device__ __forceinline__ void operator()(const pg8::Unit&, int row, int col, f32x4 v0, f32x4 v1) const {
#pragma unroll
        for (int i = 0; i < 4; ++i) { const float a = v0[i] > 0.f ? v0[i] : 0.f, c = v1[i] > 0.f ? v1[i] : 0.f; v0[i] = a * a; v1[i] = c * c; }
        u32x4 w; w.x = pg8::cvt_pk_bf16(v0[0], v0[1]); w.y = pg8::cvt_pk_bf16(v0[2], v0[3]); w.z = pg8::cvt_pk_bf16(v1[0], v1[1]); w.w = pg8::cvt_pk_bf16(v1[2], v1[3]);
        *(u32x4*)(O + (size_t)row * ldc + col) = w; } };


__device__ __forceinline__ void s5_tables(const float* a_re, const float* a_im, const float* log_dt, const float* b_re, const float* b_im, const float* c_re, const float* c_im,
                                          unsigned char* ws, int gtid, int gthreads) {
    f32x2* AB = (f32x2*)(ws + MS_S5AB); f32x2* ABL = (f32x2*)(ws + MS_S5ABL); bf16_t* BM = (bf16_t*)(ws + MS_S5BM); bf16_t* CM = (bf16_t*)(ws + MS_S5CM);
    for (int i = gtid; i < 128 * 64 * 16; i += gthreads) {
        const int h = i & 15, p = (i >> 4) & 63, g = i >> 10;
        const float dt = expf(log_dt[g]), lr = a_re[g * 64 + p], li = a_im[g * 64 + p];
        const float mag = expf(lr * dt), abr = mag * cosf(li * dt), abi = mag * sinf(li * dt);
        const float den = lr * lr + li * li, nr = abr - 1.0f, ni = abi;
        const float fre = (nr * lr + ni * li) / den, fim = (ni * lr - nr * li) / den;
        const float br = b_re[(g * 64 + p) * 16 + h], bi = b_im[(g * 64 + p) * 16 + h];
        BM[(g * 128 + p) * 16 + h] = (bf16_t)f2bf(fre * br - fim * bi);
        BM[(g * 128 + 64 + p) * 16 + h] = (bf16_t)f2bf(fre * bi + fim * br);
        CM[(g * 16 + h) * 128 + p] = (bf16_t)f2bf(c_re[(g * 16 + h) * 64 + p]);
        CM[(g * 16 + h) * 128 + 64 + p] = (bf16_t)f2bf(-c_im[(g * 16 + h) * 64 + p]);
        if (h == 0) { AB[g * 64 + p] = (f32x2){abr, abi}; float xr = abr, xi = abi;
            for (int k = S5_LC; k > 1; k >>= 1) { const float t = xr * xr - xi * xi; xi = 2.f * xr * xi; xr = t; }
            ABL[g * 64 + p] = (f32x2){xr, xi}; }
    }
}
__device__ __forceinline__ float gelu_tanh(float y) { const float z = 0.7978845608028654f * (y + 0.044715f * y * y * y); const float e = __expf(2.f * z); return y * (1.f - __builtin_amdgcn_rcpf(1.f + e)); }
template <bool FINAL>
__device__ __forceinline__ void s5_pass(const bf16_t* U, bf16_t* Y, const float* dskip, unsigned char* ws, LAS unsigned char* lds, int gw, int NGW, int wave, int lane) {
    asm volatile("" : "+v"(lane));
    const int fr = lane & 15, fq = lane >> 4;
    LAS float* BU = (LAS float*)(lds + wave * 12800); LAS bf16_t* SB = (LAS bf16_t*)(lds + wave * 12800 + 8448);
    constexpr int LDB = 132, LDSB = 136;
    for (int item = gw; item < 2 * 128 * S5_NCH; item += NGW) {
        const int g = item & 127, b = (item >> 7) & 1, ch = item >> 8;
        const bf16_t* BMg = (const bf16_t*)(ws + MS_S5BM) + (size_t)g * 128 * 16; const bf16_t* CMg = (const bf16_t*)(ws + MS_S5CM) + (size_t)g * 16 * 128;
        bf16x8 bmf[8];
#pragma unroll
        for (int nt = 0; nt < 8; ++nt) { bmf[nt] = (bf16x8){0, 0, 0, 0, 0, 0, 0, 0}; if (fq < 2) bmf[nt] = *(const bf16x8*)(BMg + (16 * nt + fr) * 16 + 8 * fq); }
        bf16x8 cmf[4];
        if (FINAL) {
#pragma unroll
            for (int kk = 0; kk < 4; ++kk) cmf[kk] = *(const bf16x8*)(CMg + fr * 128 + 32 * kk + 8 * fq);
        }
        const f32x2 ab = ((const f32x2*)(ws + MS_S5AB))[g * 64 + lane];
        const float ar = ab.x, ai = ab.y;
        float sr = 0.f, si = 0.f;
        if (FINAL) { const f32x2 al = ((const f32x2*)(ws + MS_S5ABL))[g * 64 + lane]; const f32x2* E = (const f32x2*)(ws + MS_S5E) + (size_t)(b * 128 + g) * S5_NCH * 64 + lane;
            for (int c = 0; c < ch; ++c) { const f32x2 e = E[c * 64]; const float nr = al.x * sr - al.y * si + e.x, ni = al.x * si + al.y * sr + e.y; sr = nr; si = ni; } }
        const float dsk = FINAL ? dskip[g * 16 + fr] : 0.f;
        const size_t row0 = (size_t)b * SEQ + (size_t)ch * S5_LC;
        const bf16_t* Up = U + (row0 + fr) * DM + g * 16 + 8 * fq;
        bf16x8 uf = (bf16x8){0, 0, 0, 0, 0, 0, 0, 0}; if (fq < 2) uf = *(const bf16x8*)Up;
        for (int t0 = 0; t0 < S5_LC; t0 += 16) {
            bf16x8 un = (bf16x8){0, 0, 0, 0, 0, 0, 0, 0};
            if (fq < 2 && t0 + 16 < S5_LC) un = *(const bf16x8*)(Up + (size_t)(t0 + 16) * DM);
#pragma unroll
            for (int nt = 0; nt < 8; ++nt) { const f32x4 d = __builtin_amdgcn_mfma_f32_16x16x32_bf16(uf, bmf[nt], (f32x4){0.f, 0.f, 0.f, 0.f}, 0, 0, 0);
#pragma unroll
                for (int r = 0; r < 4; ++r) BU[(4 * fq + r) * LDB + 16 * nt + fr] = d[r]; }
#pragma unroll
            for (int t = 0; t < 16; ++t) { const float br = BU[t * LDB + lane], bi = BU[t * LDB + 64 + lane];
                const float nr = ar * sr - ai * si + br, ni = ar * si + ai * sr + bi; sr = nr; si = ni;
                if (FINAL) { SB[t * LDSB + lane] = (bf16_t)f2bf(sr); SB[t * LDSB + 64 + lane] = (bf16_t)f2bf(si); } }
            if (FINAL) {
                f32x4 y = (f32x4){0.f, 0.f, 0.f, 0.f};
#pragma unroll
                for (int kk = 0; kk < 4; ++kk) { const bf16x8 sf = *(const LAS bf16x8*)(SB + fr * LDSB + 32 * kk + 8 * fq); y = __builtin_amdgcn_mfma_f32_16x16x32_bf16(sf, cmf[kk], y, 0, 0, 0); }
#pragma unroll
                for (int r = 0; r < 4; ++r) { const size_t o = (row0 + t0 + 4 * fq + r) * DM + g * 16 + fr; const float uu = bf2f(U[o]); Y[o] = (bf16_t)f2bf(gelu_tanh(y[r] + dsk * uu)); }
            }
            uf = un;
        }
        if (!FINAL) ((f32x2*)(ws + MS_S5E))[((b * 128 + g) * S5_NCH + ch) * 64 + lane] = (f32x2){sr, si};
    }
}
__device__ __forceinline__ void s5_carry(unsigned char* ws, int gtid, int gthreads) {
    for (int i = gtid; i < 2 * 128 * 64; i += gthreads) {
        const int p = i & 63, bg = i >> 6, g = bg & 127;
        const f32x2 al = ((const f32x2*)(ws + MS_S5ABL))[g * 64 + p];
        const f32x2* E = (const f32x2*)(ws + MS_S5E) + (size_t)bg * S5_NCH * 64 + p; f32x2* SI = (f32x2*)(ws + MS_S5SIN) + (size_t)bg * S5_NCH * 64 + p;
        float sr = 0.f, si = 0.f;
        for (int c = 0; c < S5_NCH; ++c) { SI[c * 64] = (f32x2){sr, si}; const f32x2 e = E[c * 64]; const float nr = al.x * sr - al.y * si + e.x, ni = al.x * si + al.y * sr + e.y; sr = nr; si = ni; }
    }
}

struct EpiGlu {
    static constexpr bool PERM = true, AFTER_DRAIN = false; bf16_t* O; int ldc;
    __device__ __forceinline__ void operator()(const f32x4 (&acc)[2][2][4][2], const pg8::Unit& u, int wr, int wc, int fr, int fq) const {
        const int col = u.pn * 128 + wc * 32 + 8 * fq;
#pragma unroll
        for (int ai = 0; ai < 2; ++ai)
#pragma unroll
            for (int m = 0; m < 4; ++m) { const int row = u.pm * 256 + ai * 128 + wr * 64 + m * 16 + fr; float o[8];
#pragma unroll
                for (int n = 0; n < 2; ++n)
#pragma unroll
                    for (int i = 0; i < 4; ++i) { const float v = acc[ai][0][m][n][i], gt = acc[ai][1][m][n][i]; o[4 * n + i] = v * __builtin_amdgcn_rcpf(1.f + __expf(-gt)); }
                u32x4 w; w.x = pg8::cvt_pk_bf16(o[0], o[1]); w.y = pg8::cvt_pk_bf16(o[2], o[3]); w.z = pg8::cvt_pk_bf16(o[4], o[5]); w.w = pg8::cvt_pk_bf16(o[6], o[7]);
                *(u32x4*)(O + (size_t)row * ldc + col) = w; }
    }
};
struct EpiSoftmax {
    static constexpr bool PERM = false, AFTER_DRAIN = true; bf16_t* P;
    __device__ __forceinline__ void fused(f32x4 (&acc)[2][2][4][2], const pg8::Unit& u, int wr, int wc, int fr, int fq, LAS unsigned char* lds, int wid, int lane) const {
        LAS f32x2* X = (LAS f32x2*)lds;
        float mw[2][4];
#pragma unroll
        for (int ai = 0; ai < 2; ++ai)
#pragma unroll
            for (int m = 0; m < 4; ++m) {
                float mx = -3.0e38f;
#pragma unroll
                for (int bj = 0; bj < 2; ++bj)
#pragma unroll
                    for (int n = 0; n < 2; ++n)
#pragma unroll
                        for (int i = 0; i < 4; ++i) mx = fmaxf(mx, acc[ai][bj][m][n][i]);
                mx = fmaxf(mx, my_shfl_xor(mx, 16)); mx = fmaxf(mx, my_shfl_xor(mx, 32));
                float sm = 0.f;
#pragma unroll
                for (int bj = 0; bj < 2; ++bj)
#pragma unroll
                    for (int n = 0; n < 2; ++n)
#pragma unroll
                        for (int i = 0; i < 4; ++i) { const float e = __builtin_amdgcn_exp2f(acc[ai][bj][m][n][i] - mx); acc[ai][bj][m][n][i] = e; sm += e; }
                sm += my_shfl_xor(sm, 16); sm += my_shfl_xor(sm, 32);
                mw[ai][m] = mx;
                if (fq == 0) X[(ai * 128 + wr * 64 + m * 16 + fr) * 4 + wc] = (f32x2){mx, sm};
            }
        LDS_WAIT(); __builtin_amdgcn_s_barrier(); asm volatile("" ::: "memory");
#pragma unroll
        for (int ai = 0; ai < 2; ++ai)
#pragma unroll
            for (int m = 0; m < 4; ++m) { const int r = ai * 128 + wr * 64 + m * 16 + fr;
                const f32x2 a = X[r * 4 + 0], b = X[r * 4 + 1], c = X[r * 4 + 2], d = X[r * 4 + 3];
                const float M = fmaxf(fmaxf(a.x, b.x), fmaxf(c.x, d.x));
                const float tot = a.y * __builtin_amdgcn_exp2f(a.x - M) + b.y * __builtin_amdgcn_exp2f(b.x - M) + c.y * __builtin_amdgcn_exp2f(c.x - M) + d.y * __builtin_amdgcn_exp2f(d.x - M);
                const float f = __builtin_amdgcn_exp2f(mw[ai][m] - M) / tot;
                bf16_t* rowp = P + (size_t)(u.pm * 256 + r) * 1024 + u.z * 256 + wc * 32 + 4 * fq;
#pragma unroll
                for (int bj = 0; bj < 2; ++bj)
#pragma unroll
                    for (int n = 0; n < 2; ++n) { const f32x4 v = acc[ai][bj][m][n] * f; u32x2 w; w.x = pg8::cvt_pk_bf16(v[0], v[1]); w.y = pg8::cvt_pk_bf16(v[2], v[3]); *(u32x2*)(rowp + bj * 128 + n * 16) = w; } }
        LDS_WAIT(); __builtin_amdgcn_s_barrier(); asm volatile("" ::: "memory");
    }
};
struct CmpSched {
    int G, c;
    __device__ bool next(int i, pg8::Unit& u) const {
        const int L = i * G + c; if (L >= 128) return false;
        const int which = L >> 6, ks = (L >> 4) & 3, pm = L & 15; u.pm = pm; u.pn = 0; u.z = which * 4 + ks;
        u.ao = (unsigned)(((size_t)which * KVH_SLOT + (size_t)pm * 256 * 2048 + ks * 512) * 2); u.bo = (unsigned)(((size_t)which * 256 * 2048 + ks * 512) * 2);
        return true;
    }
};
struct StoreBf16Z { bf16_t* O; int ldc; float scale; size_t zstride;
    __device__ __forceinline__ void operator()(const pg8::Unit& u, int row, int col, f32x4 v0, f32x4 v1) const {
        u32x4 w; w.x = pg8::cvt_pk_bf16(v0[0] * scale, v0[1] * scale); w.y = pg8::cvt_pk_bf16(v0[2] * scale, v0[3] * scale); w.z = pg8::cvt_pk_bf16(v1[0] * scale, v1[1] * scale); w.w = pg8::cvt_pk_bf16(v1[2] * scale, v1[3] * scale);
        *(u32x4*)(O + (size_t)u.z * zstride + (size_t)row * ldc + col) = w; } };
struct KvSched { int G, c;
    __device__ bool next(int i, pg8::Unit& u) const { const int L = i * G + c; if (L >= 64) return false;
        const int l = L >> 5, pm = (L >> 4) & 1, pn = L & 15; u.pm = pm; u.pn = pn; u.z = l;
        u.ao = (unsigned)((size_t)pm * 256 * 2048 * 2); u.bo = (unsigned)((size_t)l * 16 * MiB + (size_t)pn * 256 * 2048 * 2); return true; } };
struct MtSched { int G, c;
    __device__ bool next(int i, pg8::Unit& u) const { const int L = i * G + c; if (L >= 128 || L < 0) return false;
        const int l = L >> 6, b = (L >> 5) & 1, h = (L >> 3) & 3, pn = L & 7; u.pm = h; u.pn = pn; u.z = l * 2 + b;
        u.ao = (unsigned)((size_t)l * 4 * MiB + ((size_t)(b * 256) * 4096 + h * 512) * 2); u.bo = (unsigned)((size_t)l * 8 * MiB + ((size_t)(pn * 256) * 2048 + h * 512) * 2); return true; } };
struct VwSched { int G, c;
    __device__ bool next(int i, pg8::Unit& u) const { const int L = i * G + c; if (L >= 128 || L < 0) return false;
        const int l = L >> 6, b = (L >> 5) & 1, h = (L >> 3) & 3, pmn = L & 7; u.pm = pmn; u.pn = h; u.z = l * 2 + b;
        u.ao = (unsigned)((size_t)l * 8 * MiB + ((size_t)(pmn * 256) * 2048 + h * 512) * 2); u.bo = (unsigned)((size_t)l * 4 * MiB + ((size_t)(b * 256) * 4096 + 2048 + h * 512) * 2); return true; } };
struct ScoreSched { int G, c, base, lim, layer;
    __device__ bool next(int i, pg8::Unit& u) const { const int L0 = base + i * G + c; if (L0 >= lim) return false;
        const int L = (G == 256) ? ((L0 & 7) * 32 + (L0 >> 3)) : L0;
        const int b = L >> 7, pmp = (L >> 2) & 31, h = L & 3; u.pm = b * 32 + pmp; u.pn = 0; u.z = h;
        u.ao = (unsigned)((size_t)(b * SEQ + 256 * pmp) * 2048 * 2); u.bo = (unsigned)((size_t)(layer * 2 + b) * 4 * MiB + (size_t)(h * 256) * 2048 * 2); return true; } };
struct PvoSched { pg8::StaticOrder so; int layer;
    __device__ bool next(int i, pg8::Unit& u) const { if (!so.next(i, u)) return false; u.bo += (unsigned)((size_t)(layer * 2 + (u.pm >> 5)) * 4 * MiB); return true; } };
template <int MODE> struct MemSched {
    int G, c, base, lim;
    __device__ bool next(int i, pg8::Unit& u) const {
        const int L = base + i * G + c; if (L >= lim) return false;
        if (MODE == 0) { const int b = L >> 7, h = (L >> 5) & 3, pmp = L & 31; u.pm = b * 32 + pmp; u.pn = 0; u.z = h;
            u.ao = (unsigned)(((b * SEQ + 256 * pmp) * 2048 + h * 512) * 2); u.bo = (unsigned)(((b * 256) * 2048 + h * 512) * 2); }
        else { const int pn = L & 1, pmp = (L >> 1) & 31, h = (L >> 6) & 3, b = L >> 8; u.pm = b * 32 + pmp; u.pn = h * 2 + pn; u.z = 0;
            u.ao = (unsigned)(((b * SEQ + 256 * pmp) * 1024 + h * 256) * 2); u.bo = (unsigned)(((h * 512 + 256 * pn) * 512 + b * 256) * 2); }
        return true;
    }
};


struct StoreKVQ { bf16_t* KVH; bf16_t* QH; float* GATES; float qscale;
    __device__ __forceinline__ void operator()(const pg8::Unit&, int row, int col, f32x4 v0, f32x4 v1) const {
        const int b = row >> 13, t = row & 8191;
        if (col < 3072) { const int slot = col >> 9, g = (col >> 7) & 3, d = col & 127;
            u32x4 w; w.x = pg8::cvt_pk_bf16(v0[0], v0[1]); w.y = pg8::cvt_pk_bf16(v0[2], v0[3]); w.z = pg8::cvt_pk_bf16(v1[0], v1[1]); w.w = pg8::cvt_pk_bf16(v1[2], v1[3]);
            *(u32x4*)(KVH + ((((size_t)slot * 2 + b) * 4 + g) * 8192 + t) * 128 + d) = w; }
        else if (col < 5120) { const int c2 = col - 3072, head = c2 >> 7, d = c2 & 127, g = head >> 2, r = head & 3; v0 = v0 * qscale; v1 = v1 * qscale;
            u32x4 w; w.x = pg8::cvt_pk_bf16(v0[0], v0[1]); w.y = pg8::cvt_pk_bf16(v0[2], v0[3]); w.z = pg8::cvt_pk_bf16(v1[0], v1[1]); w.w = pg8::cvt_pk_bf16(v1[2], v1[3]);
            *(u32x4*)(QH + ((((size_t)b * 4 + g) * 8192 + t) * 4 + r) * 128 + d) = w; }
        else if (col < 5168) { float* gp = GATES + (size_t)row * 48 + (col - 5120);
#pragma unroll
            for (int i = 0; i < 4; ++i) { v0[i] = __builtin_amdgcn_rcpf(1.f + __expf(-v0[i])); v1[i] = __builtin_amdgcn_rcpf(1.f + __expf(-v1[i])); }
            *(f32x4*)gp = v0; *(f32x4*)(gp + 4) = v1; }
    } };
struct StoreF32 { float* O; int ldc; size_t zstride;
    __device__ __forceinline__ void operator()(const pg8::Unit& u, int row, int col, f32x4 v0, f32x4 v1) const { float* p = O + (size_t)u.z * zstride + (size_t)row * ldc + col; *(f32x4*)p = v0; *(f32x4*)(p + 4) = v1; } };
__device__ __forceinline__ void cmp_bias(const float* pos_k, const float* w1_k, const float* pos_v, const float* w1_v, float* CB, int tid) {
    if (tid < 256) { const int which = tid >> 7, n = tid & 127; const float* pos = which ? pos_v : pos_k; const float* w1 = which ? w1_v : w1_k; float a = 0.f;
        for (int k = 0; k < 4096; ++k) a += pos[k] * w1[(size_t)k * 128 + n];
        CB[tid] = a; }
}
__device__ __forceinline__ void cmp_combine(const float* PAB, const float* CB, const float* w2k, const float* w2v, bf16_t* KCMP, int gw, int NGW, int lane) {
    asm volatile("" : "+v"(lane));
    for (int it = gw; it < 2 * 4096; it += NGW) {
        const int which = it >> 12, row = it & 4095, c = row & 511;
        bf16_t* out = KCMP + ((size_t)which * 4096 + row) * 128;
        if (c == 511) { out[lane] = 0; out[lane + 64] = 0; continue; }
        const float* P = PAB + (size_t)which * 4 * 4096 * 256; const float* w2 = which ? w2v : w2k;
        float sa = CB[which * 128 + lane], sb = CB[which * 128 + 64 + lane];
#pragma unroll
        for (int ks = 0; ks < 4; ++ks) { const float* Pk = P + (size_t)ks * 4096 * 256;
            sa += Pk[(size_t)row * 256 + lane] + Pk[(size_t)(row + 1) * 256 + 128 + lane]; sb += Pk[(size_t)row * 256 + 64 + lane] + Pk[(size_t)(row + 1) * 256 + 192 + lane]; }
        const float va = gelu_tanh(sa), vb = gelu_tanh(sb);
        float o0 = 0.f, o1 = 0.f;
        for (int n = 0; n < 64; ++n) { const float x = my_shfl(va, n); o0 += x * w2[n * 128 + lane]; o1 += x * w2[n * 128 + 64 + lane]; }
        for (int n = 0; n < 64; ++n) { const float x = my_shfl(vb, n); o0 += x * w2[(64 + n) * 128 + lane]; o1 += x * w2[(64 + n) * 128 + 64 + lane]; }
        out[lane] = (bf16_t)f2bf(o0); out[lane + 64] = (bf16_t)f2bf(o1);
    }
}

namespace nsa {
constexpr int L_K0 = 0, L_V0 = 32768, L_IMP = 65536, IMP_LD = 132, IMP_WAVE = 8 * IMP_LD * 4, L_SELM = L_IMP + 8 * IMP_WAVE, L_UNI = L_SELM + 8 * 128, L_NTL = L_UNI + 16, L_TL = L_NTL + 16, L_WSF = L_TL + 512;
constexpr float NEGB = -1.0e30f;
typedef short v4i16_t __attribute__((ext_vector_type(4)));
__device__ __forceinline__ unsigned off_b(unsigned row, unsigned ch) { return 256u * row + 16u * (ch ^ (((row & 3) << 2) | ((row >> 2) & 3))); }
__device__ __forceinline__ int crow(int r, int hi) { return (r & 3) + 8 * (r >> 2) + 4 * hi; }
__device__ __forceinline__ float xhalf(float v) { return my_shfl_xor(v, 32); }

template <int BR, int MODE>
__device__ __forceinline__ void run_tiles(LAS unsigned char* lds, const bf16_t* Kb, const bf16_t* Vb, int ntiles, int first, int qt, const bf16x8 (&qf)[8], f32x16 (&o)[4], float& l_run,
                                          int t, unsigned selw0, unsigned selw1, unsigned selw2, unsigned selw3, float pscale, float gate, int tid, int wave, int lane) {
    const int l32 = lane & 31, hi = lane >> 5;
    LAS const int* TL = (LAS const int*)(lds + L_TL);
    LAS float* imp = (LAS float*)(lds + L_IMP + wave * IMP_WAVE) + ((l32 >> 2) * IMP_LD);
    const unsigned soff = (unsigned)((4 * wave + (lane >> 4)) * 128 + (((lane & 15) ^ (((lane >> 4) << 2) | (wave & 3))) * 8));
    auto tile_of = [&](int i) -> int { return (BR == 1) ? TL[i] : first + i; };
    auto stage = [&](int tile, int buf) { const bf16_t* ks = Kb + (size_t)tile * 8192 + soff; LAS unsigned char* kd = lds + L_K0 + buf * 16384 + wave * 1024;
        __builtin_amdgcn_global_load_lds((const unsigned*)ks, (LAS unsigned*)kd, 16, 0, 0); __builtin_amdgcn_global_load_lds((const unsigned*)(ks + 4096), (LAS unsigned*)(kd + 8192), 16, 0, 0);
        if (MODE != 0) { const bf16_t* vs = Vb + (size_t)tile * 8192 + soff; LAS unsigned char* vd = lds + L_V0 + buf * 16384 + wave * 1024;
            __builtin_amdgcn_global_load_lds((const unsigned*)vs, (LAS unsigned*)vd, 16, 0, 0); __builtin_amdgcn_global_load_lds((const unsigned*)(vs + 4096), (LAS unsigned*)(vd + 8192), 16, 0, 0); } };
    if (ntiles <= 0) return;
    stage(tile_of(0), 0);
    asm volatile("s_waitcnt vmcnt(0) lgkmcnt(0)" ::: "memory"); __builtin_amdgcn_s_barrier(); asm volatile("" ::: "memory");
    const unsigned kx = ((l32 & 3) << 2) | ((l32 >> 2) & 3);
    const int blk = (lane >> 4) & 1, tq = (lane & 15) >> 2, tp = lane & 3;
    for (int i = 0; i < ntiles; ++i) {
        const int tile = tile_of(i), buf = i & 1;
        if (i + 1 < ntiles) stage(tile_of(i + 1), buf ^ 1);
        bool selbit = true;
        if (BR == 1) { const unsigned w = (tile < 32) ? selw0 : (tile < 64) ? selw1 : (tile < 96) ? selw2 : selw3; selbit = (w >> (tile & 31)) & 1u; }
        const bool active = (BR == 1) ? (bool)__any((int)selbit) : true;
        if (active) {
            LAS const unsigned char* kb = lds + L_K0 + buf * 16384; LAS const unsigned char* vb = lds + L_V0 + buf * 16384;
            f32x16 p0, p1;
#pragma unroll
            for (int r = 0; r < 16; ++r) { p0[r] = 0.f; p1[r] = 0.f; }
            {
                bf16x8 kq0[3], kq1[3];
#define NSA_LDK(s_, slot_) do { const unsigned ko_ = 256u * l32 + 16u * ((unsigned)(2 * (s_) + hi) ^ kx); kq0[slot_] = *(LAS const bf16x8*)(kb + ko_); kq1[slot_] = *(LAS const bf16x8*)(kb + 8192 + ko_); } while (0)
                NSA_LDK(0, 0); NSA_LDK(1, 1);
                __builtin_amdgcn_sched_barrier(0);
#pragma unroll
                for (int s = 0; s < 8; ++s) {
                    if (s + 2 < 8) NSA_LDK(s + 2, (s + 2) % 3);
                    __builtin_amdgcn_sched_barrier(0);
                    p0 = __builtin_amdgcn_mfma_f32_32x32x16_bf16(kq0[s % 3], qf[s], p0, 0, 0, 0); p1 = __builtin_amdgcn_mfma_f32_32x32x16_bf16(kq1[s % 3], qf[s], p1, 0, 0, 0);
                    __builtin_amdgcn_sched_barrier(0);
                }
#undef NSA_LDK
            }
            const int kbase = tile * 64;
            const bool need_mask = (BR == 0) ? true : (BR == 1) ? (tile == qt) : ((tile == qt) || (tile == first && qt >= 8));
            const float ps = (BR == 1) ? 1.f : pscale;
            if (need_mask) {
                const int cmax = (t - 31) >> 4;
#pragma unroll
                for (int r = 0; r < 16; ++r) { const int k0i = kbase + crow(r, hi), k1i = k0i + 32; bool v0, v1;
                    if (BR == 0) { v0 = k0i <= cmax; v1 = k1i <= cmax; }
                    else if (BR == 1) { v0 = (k0i <= t); v1 = (k1i <= t); }
                    else { v0 = (k0i <= t) && (k0i > t - 512); v1 = (k1i <= t) && (k1i > t - 512); }
                    p0[r] = v0 ? __builtin_amdgcn_exp2f(p0[r]) * ps : 0.f; p1[r] = v1 ? __builtin_amdgcn_exp2f(p1[r]) * ps : 0.f; }
            } else {
#pragma unroll
                for (int r = 0; r < 16; ++r) { p0[r] = __builtin_amdgcn_exp2f(p0[r]) * ps; p1[r] = __builtin_amdgcn_exp2f(p1[r]) * ps; }
            }
            if (MODE != 1) { float sum = 0.f;
#pragma unroll
                for (int r = 0; r < 16; ++r) sum += p0[r] + p1[r];
                l_run += (BR == 1) ? (selbit ? sum : 0.f) : sum; }
            if (MODE == 1) {
#pragma unroll
                for (int h2 = 0; h2 < 2; ++h2)
#pragma unroll
                    for (int a = 0; a < 4; ++a) { const f32x16& pp = h2 ? p1 : p0; float gs = (pp[4 * a] + pp[4 * a + 1]) + (pp[4 * a + 2] + pp[4 * a + 3]), ls = pp[4 * a + 3];
                        gs += my_shfl_xor(gs, 1); gs += my_shfl_xor(gs, 2); ls += my_shfl_xor(ls, 1); ls += my_shfl_xor(ls, 2);
                        if ((lane & 3) == 0) { const int sidx = 16 * tile + 2 * a + hi + 8 * h2; atomicAdd((float*)(imp + sidx), gs); atomicAdd((float*)(imp + sidx + 1), ls); } }
#pragma unroll
                for (int r = 0; r < 16; ++r) { p0[r] *= gate; p1[r] *= gate; }
            }
            if (MODE != 0) {
                bf16x8 pa[4];
#pragma unroll
                for (int ks = 0; ks < 4; ++ks) { const f32x16& pp = (ks < 2) ? p0 : p1; const int b0 = 8 * (ks & 1); u32x4 w;
                    w.x = pg8::cvt_pk_bf16(pp[b0], pp[b0 + 1]); w.y = pg8::cvt_pk_bf16(pp[b0 + 2], pp[b0 + 3]); w.z = pg8::cvt_pk_bf16(pp[b0 + 4], pp[b0 + 5]); w.w = pg8::cvt_pk_bf16(pp[b0 + 6], pp[b0 + 7]);
                    if (BR == 1) { const unsigned msk = selbit ? 0xffffffffu : 0u; w.x &= msk; w.y &= msk; w.z &= msk; w.w &= msk; }
                    pa[ks] = __builtin_bit_cast(bf16x8, w); }
                bf16x8 vfr[2][4];
#define NSA_LDV(d_, slot_) do { _Pragma("unroll") for (int ks_ = 0; ks_ < 4; ++ks_) { \
                        const unsigned a0_ = off_b(16 * ks_ + 4 * hi + tq, 4 * (d_) + 2 * blk + (tp >> 1)) + 8 * (tp & 1); \
                        const unsigned a1_ = off_b(16 * ks_ + 8 + 4 * hi + tq, 4 * (d_) + 2 * blk + (tp >> 1)) + 8 * (tp & 1); \
                        const v4i16_t lo_ = __builtin_amdgcn_ds_read_tr16_b64_v4i16((LAS v4i16_t*)(vb + a0_)); \
                        const v4i16_t hv_ = __builtin_amdgcn_ds_read_tr16_b64_v4i16((LAS v4i16_t*)(vb + a1_)); \
                        vfr[slot_][ks_] = (bf16x8){lo_[0], lo_[1], lo_[2], lo_[3], hv_[0], hv_[1], hv_[2], hv_[3]}; } } while (0)
                NSA_LDV(0, 0);
                __builtin_amdgcn_sched_barrier(0);
#pragma unroll
                for (int d = 0; d < 4; ++d) {
                    if (d + 1 < 4) NSA_LDV(d + 1, (d + 1) & 1);
                    __builtin_amdgcn_sched_barrier(0);
#pragma unroll
                    for (int ks = 0; ks < 4; ++ks) o[d] = __builtin_amdgcn_mfma_f32_32x32x16_bf16(pa[ks], vfr[d & 1][ks], o[d], 0, 0, 0);
                    __builtin_amdgcn_sched_barrier(0);
                }
#undef NSA_LDV
            }
        }
        asm volatile("s_waitcnt vmcnt(0) lgkmcnt(0)" ::: "memory"); __builtin_amdgcn_s_barrier(); asm volatile("" ::: "memory");
    }
}

template <int BR>
__device__ __forceinline__ void run_tiles_stag(LAS unsigned char* lds, const bf16_t* Kb, const bf16_t* Vb, int ntiles, int first, int qt, const bf16x8 (&qf)[8], f32x16 (&o)[4], float& l_run,
                                               int t, unsigned selw0, unsigned selw1, unsigned selw2, unsigned selw3, int tid, int wave, int lane) {
    int wv_ = wave; asm volatile("" : "+s"(wv_)); const bool halfB = wv_ >= 4;
    LAS const int* TL = (LAS const int*)(lds + L_TL);
    const unsigned soff = (unsigned)((4 * wave + (lane >> 4)) * 128 + (((lane & 15) ^ (((lane >> 4) << 2) | (wave & 3))) * 8));
    auto tile_of = [&](int i) -> int { return (BR == 1) ? TL[i] : first + i; };
    auto stageK = [&](int tile, int buf) { const bf16_t* ks = Kb + (size_t)tile * 8192 + soff; LAS unsigned char* kd = lds + L_K0 + buf * 16384 + wave * 1024;
        __builtin_amdgcn_global_load_lds((const unsigned*)ks, (LAS unsigned*)kd, 16, 0, 0); __builtin_amdgcn_global_load_lds((const unsigned*)(ks + 4096), (LAS unsigned*)(kd + 8192), 16, 0, 0); };
    auto stageV = [&](int tile, int buf) { const bf16_t* vs = Vb + (size_t)tile * 8192 + soff; LAS unsigned char* vd = lds + L_V0 + buf * 16384 + wave * 1024;
        __builtin_amdgcn_global_load_lds((const unsigned*)vs, (LAS unsigned*)vd, 16, 0, 0); __builtin_amdgcn_global_load_lds((const unsigned*)(vs + 4096), (LAS unsigned*)(vd + 8192), 16, 0, 0); };
    if (ntiles <= 0) return;
    { const int t0_ = tile_of(0); stageK(t0_, 0); stageV(t0_, 0); }
    asm volatile("s_waitcnt vmcnt(0) lgkmcnt(0)" ::: "memory"); __builtin_amdgcn_s_barrier(); asm volatile("" ::: "memory");
    bf16x8 pa[4]; bool act = false;
#pragma unroll
    for (int ks = 0; ks < 4; ++ks) pa[ks] = (bf16x8){0, 0, 0, 0, 0, 0, 0, 0};
    auto qk_sm = [&](int tile, int buf) {
        bool selbit = true;
        if (BR == 1) { const unsigned w = (tile < 32) ? selw0 : (tile < 64) ? selw1 : (tile < 96) ? selw2 : selw3; selbit = (w >> (tile & 31)) & 1u; }
        act = (BR == 1) ? (bool)__any((int)selbit) : true;
        if (!act) return;
        int lv = lane; asm volatile("" : "+v"(lv));
        const int l32 = lv & 31, hi = lv >> 5; const unsigned kx = ((l32 & 3) << 2) | ((l32 >> 2) & 3);
        LAS const unsigned char* kb = lds + L_K0 + buf * 16384;
        const int kbase = tile * 64;
        const bool need_mask = (BR == 1) ? (tile == qt) : ((tile == qt) || (tile == first && qt >= 8));
        const float ps = (BR == 1) ? (selbit ? 1.f : 0.f) : 1.f;
        float sum = 0.f;
#pragma unroll
        for (int h2 = 0; h2 < 2; ++h2) {
            f32x16 pp;
#pragma unroll
            for (int r = 0; r < 16; ++r) pp[r] = 0.f;
            {
                bf16x8 kq[2];
#define NSA_LDK(s_, slot_) do { const unsigned ko_ = 256u * l32 + 16u * ((unsigned)(2 * (s_) + hi) ^ kx); kq[slot_] = *(LAS const bf16x8*)(kb + h2 * 8192 + ko_); } while (0)
                NSA_LDK(0, 0); NSA_LDK(1, 1);
                __builtin_amdgcn_sched_barrier(0);
#pragma unroll
                for (int s = 0; s < 8; s += 2) {
                    pp = __builtin_amdgcn_mfma_f32_32x32x16_bf16(kq[0], qf[s], pp, 0, 0, 0);
                    if (s + 2 < 8) NSA_LDK(s + 2, 0);
                    pp = __builtin_amdgcn_mfma_f32_32x32x16_bf16(kq[1], qf[s + 1], pp, 0, 0, 0);
                    if (s + 3 < 8) NSA_LDK(s + 3, 1);
                    __builtin_amdgcn_sched_barrier(0);
                }
#undef NSA_LDK
            }
            if (need_mask) {
#pragma unroll
                for (int r = 0; r < 16; ++r) { const int ki = kbase + 32 * h2 + crow(r, hi); bool v0;
                    if (BR == 1) v0 = (ki <= t); else v0 = (ki <= t) && (ki > t - 512);
                    pp[r] = v0 ? __builtin_amdgcn_exp2f(pp[r]) * ps : 0.f; }
            } else {
#pragma unroll
                for (int r = 0; r < 16; ++r) pp[r] = __builtin_amdgcn_exp2f(pp[r]) * ps;
            }
#pragma unroll
            for (int r = 0; r < 16; ++r) sum += pp[r];
#pragma unroll
            for (int kk = 0; kk < 2; ++kk) { const int b0 = 8 * kk; u32x4 w;
                w.x = pg8::cvt_pk_bf16(pp[b0], pp[b0 + 1]); w.y = pg8::cvt_pk_bf16(pp[b0 + 2], pp[b0 + 3]); w.z = pg8::cvt_pk_bf16(pp[b0 + 4], pp[b0 + 5]); w.w = pg8::cvt_pk_bf16(pp[b0 + 6], pp[b0 + 7]);
                pa[2 * h2 + kk] = __builtin_bit_cast(bf16x8, w); }
        }
        l_run += sum;
    };
    auto pv = [&](int buf) {
        int lv = lane; asm volatile("" : "+v"(lv));
        const int hi = lv >> 5, blk = (lv >> 4) & 1, tq = (lv & 15) >> 2, tp = lv & 3;
        LAS const unsigned char* vb = lds + L_V0 + buf * 16384;
        bf16x8 vfr[3];
#define NSA_LDV(j_, slot_) do { const int d_ = (j_) >> 2, ks_ = (j_) & 3; \
                const unsigned a0_ = off_b(16 * ks_ + 4 * hi + tq, 4 * d_ + 2 * blk + (tp >> 1)) + 8 * (tp & 1); \
                const unsigned a1_ = off_b(16 * ks_ + 8 + 4 * hi + tq, 4 * d_ + 2 * blk + (tp >> 1)) + 8 * (tp & 1); \
                const v4i16_t lo_ = __builtin_amdgcn_ds_read_tr16_b64_v4i16((LAS v4i16_t*)(vb + a0_)); \
                const v4i16_t hv_ = __builtin_amdgcn_ds_read_tr16_b64_v4i16((LAS v4i16_t*)(vb + a1_)); \
                vfr[slot_] = (bf16x8){lo_[0], lo_[1], lo_[2], lo_[3], hv_[0], hv_[1], hv_[2], hv_[3]}; } while (0)
        NSA_LDV(0, 0); NSA_LDV(1, 1);
        __builtin_amdgcn_sched_barrier(0);
#pragma unroll
        for (int j = 0; j < 16; ++j) {
            if (j + 2 < 16) NSA_LDV(j + 2, (j + 2) % 3);
            __builtin_amdgcn_sched_barrier(0);
            o[j >> 2] = __builtin_amdgcn_mfma_f32_32x32x16_bf16(pa[j & 3], vfr[j % 3], o[j >> 2], 0, 0, 0);
            __builtin_amdgcn_sched_barrier(0);
        }
#undef NSA_LDV
    };
#define NSA_SLOT_END() do { asm volatile("s_waitcnt vmcnt(0) lgkmcnt(0)" ::: "memory"); __builtin_amdgcn_s_barrier(); asm volatile("" ::: "memory"); } while (0)
    const int hsel = halfB ? 1 : 0;
    for (int sl = 0; sl <= 2 * ntiles; ++sl) {
        const int inext = (sl >> 1) + 1;
        const bool staged = inext < ntiles;
        if (staged) { const int tn = tile_of(inext); if (sl & 1) stageV(tn, inext & 1); else stageK(tn, inext & 1); }
        if ((sl & 1) == hsel) { const int i = (sl - hsel) >> 1; if (i < ntiles) qk_sm(tile_of(i), i & 1); }
        else { const int i = (sl - 1 - hsel) >> 1; if (sl - 1 - hsel >= 0 && i < ntiles && act) pv(i & 1); }
        if (staged) asm volatile("s_waitcnt vmcnt(2) lgkmcnt(0)" ::: "memory"); else asm volatile("s_waitcnt vmcnt(0) lgkmcnt(0)" ::: "memory");
        __builtin_amdgcn_s_barrier(); asm volatile("" ::: "memory");
    }
#undef NSA_SLOT_END
}

template <bool FIRST>
__device__ __forceinline__ void flush(f32x16 (&o)[4], float fac, bf16_t* Obase, LAS float* wsf, int l32, int hi) {
    if (hi == 0) wsf[l32] = fac;
    LDS_WAIT(); asm volatile("" ::: "memory");
    bf16_t* pa = Obase + (size_t)hi * DM + l32;
#pragma unroll
    for (int a = 0; a < 4; ++a) { const f32x4 f = *(LAS const f32x4*)(wsf + 8 * a + 4 * hi);
        asm volatile("" : "+v"(pa));
#pragma unroll
        for (int i2 = 0; i2 < 4; ++i2)
#pragma unroll
            for (int d = 0; d < 4; ++d) { bf16_t* op = pa + i2 * 128 + 32 * d; float v = o[d][4 * a + i2] * f[i2]; if (!FIRST) v += bf2f(*op); *op = (bf16_t)f2bf(v); o[d][4 * a + i2] = 0.f; }
        pa += 2 * DM; }
    LDS_WAIT(); asm volatile("" ::: "memory");
}

__device__ __forceinline__ void unit(LAS unsigned char* lds, const bf16_t* KVH, const bf16_t* QH, const bf16_t* KCMP, const float* GATES, bf16_t* O, int b, int g, int qt, int tid, int wave, int lane) {
    asm volatile("" : "+v"(tid)); lane = tid & 63; wave = __builtin_amdgcn_readfirstlane(tid >> 6);
    const int l32 = lane & 31, hi = lane >> 5, tokl = l32 >> 2, rr = l32 & 3;
    const int t0 = qt * 64, t = t0 + wave * 8 + tokl;
    const size_t bg = (size_t)b * 4 + g;
    LAS float* impw = (LAS float*)(lds + L_IMP + wave * IMP_WAVE);
    LAS unsigned* selm = (LAS unsigned*)(lds + L_SELM + wave * 128);
    LAS unsigned* uni = (LAS unsigned*)(lds + L_UNI);
    LAS int* NTL = (LAS int*)(lds + L_NTL); LAS int* TL = (LAS int*)(lds + L_TL);
    LAS float* wsf = (LAS float*)(lds + L_WSF + wave * 128);
    for (int i = lane; i < 8 * IMP_LD; i += 64) impw[i] = 0.f;
    if (tid < 4) uni[tid] = 0u;
    bf16x8 qf[8];
    { const bf16_t* qp = QH + ((bg * 8192 + t0 + wave * 8) * 4 + l32) * 128 + 8 * hi;
#pragma unroll
      for (int s = 0; s < 8; ++s) qf[s] = *(const bf16x8*)(qp + 16 * s); }
    const float* gp = GATES + ((size_t)b * 8192 + t) * 48 + (g * 4 + rr) * 3;
    const float g_cmp = gp[0], g_slc = gp[1], g_win = gp[2];
    bf16_t* Obase = O + ((size_t)b * 8192 + t0 + wave * 8) * DM + g * 512;
    f32x16 o[4];
#pragma unroll
    for (int d = 0; d < 4; ++d)
#pragma unroll
        for (int r = 0; r < 16; ++r) o[d][r] = 0.f;
    LDS_WAIT(); __builtin_amdgcn_s_barrier(); asm volatile("" ::: "memory");
    const bf16_t* Kc = KCMP + bg * 512 * 128; const bf16_t* Vc = KCMP + (size_t)4096 * 128 + bg * 512 * 128;
    const int ntc = ((4 * qt + 2) >> 6) + 1;
    { float l = 0.f;
      run_tiles<0, 0>(lds, Kc, Vc, ntc, 0, qt, qf, o, l, t, 0u, 0u, 0u, 0u, 1.f, 1.f, tid, wave, lane);
      const float ltot = l + xhalf(l); const float inv = ltot > 0.f ? 1.f / ltot : 0.f;
      run_tiles<0, 1>(lds, Kc, Vc, ntc, 0, qt, qf, o, l, t, 0u, 0u, 0u, 0u, inv, g_cmp, tid, wave, lane); }
    flush<true>(o, 1.f, Obase, wsf, l32, hi);
    {
        const int tk = lane >> 3, j = lane & 7; const int nvalid = qt + 1;
        unsigned m0 = 0u, m1 = 0u, m2 = 0u, m3 = 0u;
        auto setbit = [&](int s) { const unsigned bit = 1u << (s & 31); const int w = s >> 5; m0 |= (w == 0) ? bit : 0u; m1 |= (w == 1) ? bit : 0u; m2 |= (w == 2) ? bit : 0u; m3 |= (w == 3) ? bit : 0u; };
        if (nvalid <= 16) { for (int s2 = 0; s2 < nvalid; ++s2) setbit(s2); }
        else {
            setbit(0); setbit(qt); setbit(qt - 1);
            unsigned key[16];
#pragma unroll
            for (int i = 0; i < 16; ++i) { const int s2 = 16 * j + i; const float v = impw[tk * IMP_LD + s2];
                const bool cand = (s2 < nvalid) && (s2 != 0) && (s2 != qt) && (s2 != qt - 1);
                key[i] = cand ? ((__float_as_uint(fmaxf(v, 0.f)) & ~0x7Fu) + (unsigned)(128 - s2)) : 0u; }
            for (int round = 0; round < 13; ++round) {
                unsigned mx = key[0];
#pragma unroll
                for (int i = 1; i < 16; ++i) mx = mx > key[i] ? mx : key[i];
                unsigned o1 = (unsigned)my_shfl_xor((int)mx, 1); mx = mx > o1 ? mx : o1;
                o1 = (unsigned)my_shfl_xor((int)mx, 2); mx = mx > o1 ? mx : o1;
                o1 = (unsigned)my_shfl_xor((int)mx, 4); mx = mx > o1 ? mx : o1;
                if (mx != 0u) { const int sw = (128 - (int)(mx & 0x7Fu)) & 127; setbit(sw); }
#pragma unroll
                for (int i = 0; i < 16; ++i) key[i] = (key[i] == mx) ? 0u : key[i];
            }
        }
        if (j == 0) { selm[tk * 4 + 0] = m0; selm[tk * 4 + 1] = m1; selm[tk * 4 + 2] = m2; selm[tk * 4 + 3] = m3;
            atomicOr((unsigned*)(uni + 0), m0); atomicOr((unsigned*)(uni + 1), m1); atomicOr((unsigned*)(uni + 2), m2); atomicOr((unsigned*)(uni + 3), m3); }
    }
    LDS_WAIT(); __builtin_amdgcn_s_barrier(); asm volatile("" ::: "memory");
    if (tid == 0) { int n = 0; for (int w = 0; w < 4; ++w) { unsigned u = uni[w]; while (u) { const int bpos = __builtin_ctz(u); u &= u - 1; TL[n++] = 32 * w + bpos; } } NTL[0] = n; }
    LDS_WAIT(); __builtin_amdgcn_s_barrier(); asm volatile("" ::: "memory");
    const unsigned sw0 = selm[tokl * 4 + 0], sw1 = selm[tokl * 4 + 1], sw2 = selm[tokl * 4 + 2], sw3 = selm[tokl * 4 + 3];
    const int nsel = __builtin_amdgcn_readfirstlane(NTL[0]);
    { const bf16_t* Ks = KVH + 2 * KVH_SLOT + bg * 8192 * 128; const bf16_t* Vs = KVH + 3 * KVH_SLOT + bg * 8192 * 128;
      float l = 0.f;
      run_tiles<1, 2>(lds, Ks, Vs, nsel, 0, qt, qf, o, l, t, sw0, sw1, sw2, sw3, 1.f, 1.f, tid, wave, lane);
      const float ltot = l + xhalf(l);
      flush<false>(o, ltot > 0.f ? g_slc / ltot : 0.f, Obase, wsf, l32, hi); }
    { const bf16_t* Kw = KVH + 4 * KVH_SLOT + bg * 8192 * 128; const bf16_t* Vw = KVH + 5 * KVH_SLOT + bg * 8192 * 128;
      const int first = qt >= 8 ? qt - 8 : 0; float l = 0.f;
      run_tiles<2, 2>(lds, Kw, Vw, qt - first + 1, first, qt, qf, o, l, t, 0u, 0u, 0u, 0u, 1.f, 1.f, tid, wave, lane);
      const float ltot = l + xhalf(l);
      flush<false>(o, ltot > 0.f ? g_win / ltot : 0.f, Obase, wsf, l32, hi); }
    LDS_WAIT(); __builtin_amdgcn_s_barrier(); asm volatile("" ::: "memory");
}
}


constexpr size_t WS_CTL = WS_MISC + 63 * MiB; constexpr size_t CTL_ZERO_BYTES = 16384;
#define XB_TMO      128
#define XB_XCNT(j)  (256  + 64 * (j))
#define XB_XSUB(j)  (1280 + 64 * (j))
#define XB_XGEN(j)  (2304 + 64 * (j))
#define XB_TOP      3328
#define XB_TOPGEN   3392
#define XB_SPIN_CAP (1u << 18)
__device__ __forceinline__ unsigned xb_ld(unsigned* p)              { return __hip_atomic_load(p, __ATOMIC_RELAXED, __HIP_MEMORY_SCOPE_AGENT); }
__device__ __forceinline__ unsigned xb_add(unsigned* p, unsigned v) { return __hip_atomic_fetch_add(p, v, __ATOMIC_RELAXED, __HIP_MEMORY_SCOPE_AGENT); }
__device__ __forceinline__ unsigned xb_xcc_id() { return (unsigned)__builtin_amdgcn_s_getreg((3 << 11) | 20) & 0xFu; }
#define XB_SPIN(cond, bar) do { unsigned _sp = 0; while (cond) { __builtin_amdgcn_s_sleep(1); \
    if ((++_sp & 255u) == 0u) { if (xb_ld(&(bar)[XB_TMO])) break; if (_sp > XB_SPIN_CAP) { atomicAdd(&(bar)[XB_TMO], 1u); break; } } } } while (0)
struct XcdBarrier { unsigned* bar; unsigned x; volatile LAS unsigned* st; };
__device__ __forceinline__ XcdBarrier xcd_barrier_post(unsigned* bar, volatile LAS unsigned* st, bool t0) {
    XcdBarrier b; b.bar = bar; b.x = xb_xcc_id(); b.st = st;
    if (t0) (void)xb_add(&bar[XB_XCNT(b.x)], 1u);
    return b;
}
__device__ __forceinline__ void xcd_barrier_complete(unsigned* bar, unsigned x, unsigned& nloc, unsigned& nx) {
    const unsigned G = gridDim.x * gridDim.y * gridDim.z;
    unsigned sum, cnt, mine, sp = 0u;
    for (;;) {
        sum = 0u; cnt = 0u; mine = 0u;
#pragma unroll
        for (unsigned j = 0; j < 16; ++j) { const unsigned c = xb_ld(&bar[XB_XCNT(j)]); sum += c; cnt += (c > 0u) ? 1u : 0u; mine = (j == x) ? c : mine; }
        if (sum == G) break;
        __builtin_amdgcn_s_sleep(1);
        if ((++sp & 255u) == 0u) { if (xb_ld(&bar[XB_TMO])) break; if (sp > XB_SPIN_CAP) { atomicAdd(&bar[XB_TMO], 1u); break; } }
    }
    nloc = mine > 0u ? mine : 1u; nx = cnt > 0u ? cnt : 1u;
}
__device__ __forceinline__ void xcd_barrier(const XcdBarrier& b, bool t0) {
    asm volatile("s_waitcnt vmcnt(0)" ::: "memory");
    __syncthreads();
    if (t0) {
        unsigned* bar = b.bar;
        __builtin_amdgcn_s_waitcnt(0);
        unsigned nloc = b.st[0], nx = b.st[1];
        if (nloc == 0u) { xcd_barrier_complete(bar, b.x, nloc, nx); b.st[0] = nloc; b.st[1] = nx; }
        const unsigned old = xb_add(&bar[XB_XSUB(b.x)], 1u);
        const unsigned gen = old / nloc;
        if (old + 1u == (gen + 1u) * nloc) {
            __builtin_amdgcn_fence(__ATOMIC_RELEASE, "agent");
            asm volatile("s_waitcnt vmcnt(0)" ::: "memory");
            const unsigned og = xb_add(&bar[XB_TOP], 1u);
            const unsigned tg = og / nx;
            if (og + 1u == (tg + 1u) * nx) xb_add(&bar[XB_TOPGEN], 1u);
            else XB_SPIN(xb_ld(&bar[XB_TOPGEN]) == tg, bar);
            __builtin_amdgcn_fence(__ATOMIC_ACQUIRE, "agent");
            xb_add(&bar[XB_XGEN(b.x)], 1u);
            asm volatile("s_waitcnt vmcnt(0)" ::: "memory");
        } else {
            XB_SPIN(xb_ld(&bar[XB_XGEN(b.x)]) == gen, bar);
            __builtin_amdgcn_fence(__ATOMIC_ACQUIRE, "agent");
            asm volatile("s_waitcnt vmcnt(0)" ::: "memory");
        }
    }
    __syncthreads();
}

__global__ void __launch_bounds__(NTHREADS, 2) fwd_kernel(Args args) {
    extern __shared__ __attribute__((aligned(16))) unsigned char lds_raw[];
    LAS unsigned char* lds = (LAS unsigned char*)lds_raw;
    cg::grid_group grid = cg::this_grid();
    const int G = gridDim.x;
    const int NGW = G * NWAVES, gthreads = G * NTHREADS;
#define bid ({ int b_ = (int)blockIdx.x; asm volatile("" : "+s"(b_)); b_; })
    const int wave0 = __builtin_amdgcn_readfirstlane((int)threadIdx.x >> 6);
#define lane ({ int l_; asm volatile("v_mbcnt_lo_u32_b32 %0, -1, 0\n\tv_mbcnt_hi_u32_b32 %0, -1, %0" : "=v"(l_)); l_; })
#define wave wave0
#define tid (wave0 * 64 + lane)
#define gw (bid * NWAVES + wave)
#define gtid (bid * NTHREADS + tid)
#define ws ((unsigned char*)argp(30))
#define XF ((float*)argp(29))
#define XB ((bf16_t*)(ws + WS_XB))
#define HID ((bf16_t*)(ws + OV_HID))
#define ln_g INP(I_LNG)
#define ln_b INP(I_LNB)
#define T1 ((bf16_t*)(ws + OV_T1))
#define T2 ((bf16_t*)(ws + OV_T2))
#define T3 ((bf16_t*)(ws + OV_T3))
#define STP ((f32x2*)(ws + MS_STATS))
#define GSYNC_CG() do { asm volatile("s_waitcnt vmcnt(0) lgkmcnt(0)" ::: "memory"); grid.sync(); asm volatile("s_waitcnt vmcnt(0) lgkmcnt(0)" ::: "memory"); __builtin_amdgcn_s_barrier(); asm volatile("" ::: "memory"); } while (0)
#define GSYNC() do { asm volatile("s_waitcnt vmcnt(0) lgkmcnt(0)" ::: "memory"); XcdBarrier xb_; xb_.bar = (unsigned*)(ws + WS_CTL); xb_.x = xb_xcc_id(); xb_.st = (volatile LAS unsigned*)(lds + LDS_BYTES - 64); xcd_barrier(xb_, tid == 0); asm volatile("" ::: "memory"); } while (0)
    volatile LAS unsigned* xst = (volatile LAS unsigned*)(lds + LDS_BYTES - 64);
    if (tid == 0) { xst[0] = 0u; xst[1] = 0u; }
    __syncthreads();
    (void)xcd_barrier_post((unsigned*)(ws + WS_CTL), xst, tid == 0);

    {
        LAS float* scr = (LAS float*)(lds + wave * 16384);
        conv_matrix<0>(INP(I_S5_WIN), 2048, 2048, 2048, (bf16_t*)(ws + WS_WIN), 2048, 0, scr, gw, NGW, lane);
        conv_matrix<1>(INP(I_S5_WGLU), 2048, 4096, 4096, (bf16_t*)(ws + WS_WGLU), 2048, 0, scr, gw, NGW, lane);
        conv_matrix<0>(INP(I_S5_WOUT), 2048, 2048, 2048, (bf16_t*)(ws + WS_WOUT), 2048, 0, scr, gw, NGW, lane);
        conv_matrix<0>(INP(I_KVW), 2048, 3072, 3072, (bf16_t*)(ws + WS_WKVQ), 2048, 0, scr, gw, NGW, lane);
        conv_matrix<0>(INP(I_WQG), 2048, 2096, 2048, (bf16_t*)(ws + WS_WKVQ), 2048, 3072, scr, gw, NGW, lane);
        conv_matrix<0>(INP(I_WQG) + 2048, 2048, 2096, 48, (bf16_t*)(ws + WS_WKVQ), 2048, 5120, scr, gw, NGW, lane);
        conv_matrix<0>(INP(I_WNO), 2048, 2048, 2048, (bf16_t*)(ws + WS_WNO), 2048, 0, scr, gw, NGW, lane);
        for (int l = 0; l < 2; ++l) {
            cvt_rows(INP(I_MWQ) + (size_t)l * 2048 * 2048, (bf16_t*)(ws + WS_WMQ + l * 8 * MiB), (size_t)2048 * 2048, gtid, gthreads);
            conv_matrix<0>(INP(I_MWKV) + (size_t)l * 2048 * 4096, 2048, 4096, 4096, (bf16_t*)(ws + WS_WMKV + l * 16 * MiB), 2048, 0, scr, gw, NGW, lane);
            conv_matrix<0>(INP(I_MWO) + (size_t)l * 2048 * 2048, 2048, 2048, 2048, (bf16_t*)(ws + WS_WMO + l * 8 * MiB), 2048, 0, scr, gw, NGW, lane);
            conv_matrix<0>(INP(I_WUP) + (size_t)l * 2048 * 8192, 2048, 8192, 8192, (bf16_t*)(ws + WS_WUP + l * 32 * MiB), 2048, 0, scr, gw, NGW, lane);
            conv_matrix<0>(INP(I_WDN) + (size_t)l * 8192 * 2048, 8192, 2048, 2048, (bf16_t*)(ws + WS_WDN + l * 32 * MiB), 8192, 0, scr, gw, NGW, lane);
        }
        cvt_rows(INP(I_X), XB, (size_t)MTOK * DM, gtid, gthreads);
        cvt_rows(INP(I_MEM), (bf16_t*)(ws + MS_MEMB), (size_t)512 * DM, gtid, gthreads);
        for (int q = 0; q < 4; ++q) { const int which = q >> 1, half = q & 1;
            conv_matrix<0>((which ? INP(I_CW1V) : INP(I_CW1K)) + (size_t)half * 2048 * 128, 2048, 128, 128, (bf16_t*)(ws + WS_WC1 + which * MiB), 2048, 128 * half, scr, gw, NGW, lane); }
        if (bid == G - 1) cmp_bias(INP(I_CPK), INP(I_CW1K), INP(I_CPV), INP(I_CW1V), (float*)(ws + MS_CB), tid);
        s5_tables(INP(I_S5_ARE), INP(I_S5_AIM), INP(I_S5_LOGDT), INP(I_S5_BRE), INP(I_S5_BIM), INP(I_S5_CRE), INP(I_S5_CIM), ws, gtid, gthreads);
    }
    GSYNC_CG();
    for (int layer = 0; layer < 2; ++layer) {

        if (layer == 0) {
            { pg8::Gemm g{XB, (const bf16_t*)(ws + WS_WIN), DM, DM, DM}; pg8::StaticOrder S; S.init(MTOK, DM, DM, DM, G, bid);
              pg8::EpiCols8<StoreBf16> E{StoreBf16{T1, DM, 1.f}}; pg8::gemm_phase(lds, g, S, E, wave0); }
            { pg8::Gemm g{(const bf16_t*)(ws + MS_MEMB), (const bf16_t*)(ws + WS_WMKV), DM, DM, DM}; KvSched S{G, bid};
              pg8::EpiCols8<StoreBf16Z> E{StoreBf16Z{(bf16_t*)(ws + MS_MKV), 4096, 1.f, (size_t)512 * 4096}}; pg8::gemm_phase(lds, g, S, E, wave0); }
            GSYNC();
            s5_pass<false>(T1, T2, INP(I_S5_D), ws, lds, gw, NGW, wave, lane);
            GSYNC();
            s5_pass<true>(T1, T2, INP(I_S5_D), ws, lds, gw, NGW, wave, lane);
            GSYNC();
            { pg8::Gemm g{T2, (const bf16_t*)(ws + WS_WGLU), DM, DM, DM}; pg8::StaticOrder S; S.init(MTOK, 2 * DM, DM, DM, G, bid);
              EpiGlu E{T1, DM}; pg8::gemm_phase(lds, g, S, E, wave0); }
            { pg8::Gemm g{(const bf16_t*)(ws + MS_MKV), (const bf16_t*)(ws + WS_WMQ), 4096, 2048, 512}; MtSched S{G, bid};
              pg8::EpiCols8<StoreBf16Z> E{StoreBf16Z{(bf16_t*)(ws + WS_MT), 2048, 0.044194173824159216f * 1.4426950408889634f, (size_t)1024 * 2048}}; pg8::gemm_phase(lds, g, S, E, wave0); }
            { pg8::Gemm g{(const bf16_t*)(ws + WS_WMO), (const bf16_t*)(ws + MS_MKV), 2048, 4096, 512}; VwSched S{G, (G == 256) ? ((bid + 128) & 255) : bid};
              pg8::EpiCols8<StoreBf16Z> E{StoreBf16Z{(bf16_t*)(ws + WS_VWT), 1024, 1.f, (size_t)2048 * 1024}}; pg8::gemm_phase(lds, g, S, E, wave0); }
            GSYNC();
            { pg8::Gemm g{T1, (const bf16_t*)(ws + WS_WOUT), DM, DM, DM}; pg8::StaticOrder S; S.init(MTOK, DM, DM, DM, G, bid);
              pg8::EpiRes<0> E{INP(I_X), XF, nullptr, nullptr, nullptr, DM, DN_ALPHA}; pg8::gemm_phase(lds, g, S, E, wave0); }
            GSYNC();
            ln_phase<false>(XF, 1.f, XF, XB, STP, ln_g + (layer * 3 + 0) * DM, ln_b + (layer * 3 + 0) * DM, gw, NGW, lane);
        } else {
            { pg8::Gemm g{XB, (const bf16_t*)(ws + WS_WKVQ), DM, DM, DM}; pg8::StaticOrder S; S.init(MTOK, 5376, DM, DM, G, bid);
              pg8::EpiCols8<StoreKVQ> E{StoreKVQ{(bf16_t*)(ws + OV_KVH), (bf16_t*)(ws + OV_QH), (float*)(ws + MS_GATES), 0.08838834764831845f * 1.4426950408889634f}}; pg8::gemm_phase(lds, g, S, E, wave0); }
            GSYNC();
            { pg8::Gemm g{(const bf16_t*)(ws + OV_KVH), (const bf16_t*)(ws + WS_WC1), 2048, 2048, 512}; CmpSched S{G, bid};
              pg8::EpiCols8<StoreF32> E{StoreF32{(float*)(ws + MS_PAB), 256, (size_t)4096 * 256}}; pg8::gemm_phase(lds, g, S, E, wave0); }
            GSYNC();
            cmp_combine((const float*)(ws + MS_PAB), (const float*)(ws + MS_CB), INP(I_CW2K), INP(I_CW2V), (bf16_t*)(ws + MS_KCMP), gw, NGW, lane);
            GSYNC();
            for (int vb = bid; vb < 256; vb += G) {
                const int bgi = vb >> 5, sidx = vb & 31;
                for (int i = 0; i < 4; ++i) { const int qt = (i == 0) ? sidx : (i == 1) ? 63 - sidx : (i == 2) ? 64 + sidx : 127 - sidx;
                    nsa::unit(lds, (const bf16_t*)(ws + OV_KVH), (const bf16_t*)(ws + OV_QH), (const bf16_t*)(ws + MS_KCMP), (const float*)(ws + MS_GATES), T1, bgi >> 2, bgi & 3, qt, tid, wave, lane); }
            }
            GSYNC();
            { pg8::Gemm g{T1, (const bf16_t*)(ws + WS_WNO), DM, DM, DM}; pg8::StaticOrder S; S.init(MTOK, DM, DM, DM, G, bid);
              pg8::EpiRes<1> E{XF, XF, STP, ln_g + 2 * DM, ln_b + 2 * DM, DM, DN_ALPHA}; pg8::gemm_phase(lds, g, S, E, wave0); }
            GSYNC();
            ln_phase<false>(XF, 1.f, XF, XB, STP, ln_g + (layer * 3 + 0) * DM, ln_b + (layer * 3 + 0) * DM, gw, NGW, lane);
        }
        GSYNC();
        for (int base = 0; base < 256; base += G) {
            pg8::Gemm g{XB, (const bf16_t*)(ws + WS_MT), DM, DM, DM}; ScoreSched S{G, bid, base, (base + G < 256) ? base + G : 256, layer};
            EpiSoftmax E{T2}; pg8::gemm_phase(lds, g, S, E, wave0);
        }
        GSYNC();
        { pg8::Gemm g{T2, (const bf16_t*)(ws + WS_VWT), 1024, 1024, 1024}; PvoSched S; S.so.init(MTOK, DM, 1024, 1024, G, bid); S.layer = layer;
          pg8::EpiRes<1> E{XF, XF, STP, ln_g + (layer * 3 + 0) * DM, ln_b + (layer * 3 + 0) * DM, DM, DN_ALPHA}; pg8::gemm_phase(lds, g, S, E, wave0); }
        GSYNC();
        ln_phase<false>(XF, 1.f, XF, XB, STP, ln_g + (layer * 3 + 1) * DM, ln_b + (layer * 3 + 1) * DM, gw, NGW, lane);
        GSYNC();
        {
            pg8::Gemm g{XB, (const bf16_t*)(ws + WS_WUP + layer * 32 * MiB), DM, DM, DM};
            pg8::StaticOrder S; S.init(MTOK, DFF, DM, DM, G, bid);
            pg8::EpiCols8<StoreRelu2> E{StoreRelu2{HID, DFF}};
            pg8::gemm_phase(lds, g, S, E, wave0);
        }
        GSYNC();
        {
            pg8::Gemm g{HID, (const bf16_t*)(ws + WS_WDN + layer * 32 * MiB), DFF, DFF, DFF};
            pg8::StaticOrder S; S.init(MTOK, DM, DFF, DFF, G, bid);
            pg8::EpiRes<1> E{XF, XF, STP, ln_g + (layer * 3 + 1) * DM, ln_b + (layer * 3 + 1) * DM, DM, DN_ALPHA};
            pg8::gemm_phase(lds, g, S, E, wave0);
        }
        GSYNC();
        if (layer == 1) ln_phase<true>(XF, 1.f, XF, XB, STP, ln_g + (layer * 3 + 2) * DM, ln_b + (layer * 3 + 2) * DM, gw, NGW, lane);
        else ln_phase<false>(XF, 1.f, XF, XB, STP, ln_g + (layer * 3 + 2) * DM, ln_b + (layer * 3 + 2) * DM, gw, NGW, lane);
        if (layer == 0) GSYNC();
    }
}

#undef ws
#undef XF
#undef XB
#undef HID
#undef ln_g
#undef ln_b
#undef T1
#undef T2
#undef T3
#undef STP
#undef bid
#undef tid
#undef lane
#undef wave
#undef gw
#undef gtid
extern "C" void kernel_launch(void* const* d_in, const int* in_sizes, int n_in, void* d_out, int out_size, void* d_ws, size_t ws_size, hipStream_t stream) {
    static int grid = 0;
    if (grid == 0) {
        if (n_in != 29 || ws_size < WS_END) { fprintf(stderr, "kernel_launch: unexpected n_in %d or ws %zu (< %zu)\n", n_in, ws_size, (size_t)WS_END); grid = -1; return; }
        int dev = 0, cus = 0, per_cu = 0;
        hipGetDevice(&dev); hipDeviceGetAttribute(&cus, hipDeviceAttributeMultiprocessorCount, dev);
        hipFuncSetAttribute((const void*)fwd_kernel, hipFuncAttributeMaxDynamicSharedMemorySize, LDS_BYTES);
        hipOccupancyMaxActiveBlocksPerMultiprocessor(&per_cu, (const void*)fwd_kernel, NTHREADS, LDS_BYTES);
        if (per_cu < 1) { fprintf(stderr, "kernel_launch: occupancy query says %d blocks/CU\n", per_cu); per_cu = 1; }
        (void)hipGetLastError();
        grid = cus;
    }
    if (grid < 0) return;
    if (hipMemsetAsync((char*)d_ws + WS_CTL, 0, CTL_ZERO_BYTES, stream) != hipSuccess) { fprintf(stderr, "kernel_launch: memset of the barrier words failed\n"); return; }
    Args a{};
    for (int i = 0; i < 29; ++i) a.in[i] = (const float*)d_in[i];
    a.out = (float*)d_out; a.ws = (unsigned char*)d_ws; a.ph_lo = 0; a.ph_hi = 100;
    void* kargs[] = {&a};
    hipError_t e = hipLaunchCooperativeKernel((const void*)fwd_kernel, dim3(grid), dim3(NTHREADS), kargs, LDS_BYTES, stream);
    if (e != hipSuccess) fprintf(stderr, "cooperative launch failed: %s (grid %d)\n", hipGetErrorString(e), grid);
}
```

```cpp
#include <hip/hip_runtime.h>
#include <hip/hip_cooperative_groups.h>
#include <cstdio>
#include <cstdint>
namespace cg = cooperative_groups;

#define LAS __attribute__((address_space(3)))
typedef unsigned short bf16_t;
typedef short bf16x8 __attribute__((ext_vector_type(8)));
typedef float f32x4 __attribute__((ext_vector_type(4)));
typedef float f32x2 __attribute__((ext_vector_type(2)));
typedef float f32x16 __attribute__((ext_vector_type(16)));
typedef unsigned u32x4 __attribute__((ext_vector_type(4)));
typedef unsigned u32x2 __attribute__((ext_vector_type(2)));

constexpr int SEQ = 8192, BATCH = 2, DM = 2048, MTOK = BATCH * SEQ, DFF = 8192;
constexpr float LN_EPS = 1e-5f;
constexpr float DN_ALPHA = 1.4142135623730951f;
constexpr int NWAVES = 8, NTHREADS = 512;
constexpr int LDS_BYTES = 147456;

constexpr size_t MiB = 1u << 20;
constexpr size_t WS_WIN = 0;
constexpr size_t WS_WGLU = WS_WIN + 8 * MiB;
constexpr size_t WS_WOUT = WS_WGLU + 16 * MiB;
constexpr size_t WS_WKVQ = WS_WOUT + 8 * MiB;
constexpr size_t WS_WNO = WS_WKVQ + 22 * MiB;
constexpr size_t WS_WMQ = WS_WNO + 8 * MiB;
constexpr size_t WS_WMKV = WS_WMQ + 16 * MiB;
constexpr size_t WS_WMO = WS_WMKV + 32 * MiB;
constexpr size_t WS_WUP = WS_WMO + 16 * MiB;
constexpr size_t WS_WDN = WS_WUP + 64 * MiB;
constexpr size_t WS_WC1 = WS_WDN + 64 * MiB;
constexpr size_t WS_XB = WS_WC1 + 2 * MiB;
constexpr size_t WS_OVL = WS_XB + 64 * MiB;
constexpr size_t WS_MISC = WS_OVL + 256 * MiB;
constexpr size_t WS_END = WS_MISC + 64 * MiB;
constexpr size_t OV_T1 = WS_OVL;
constexpr size_t OV_T2 = WS_OVL + 64 * MiB;
constexpr size_t OV_T3 = WS_OVL + 128 * MiB;
constexpr size_t OV_KV = WS_OVL + 128 * MiB;
constexpr size_t OV_HID = WS_OVL;
constexpr size_t MS_MEMB = WS_MISC;
constexpr size_t MS_MKV = WS_MISC + 2 * MiB;
constexpr size_t MS_MK = WS_MISC + 2 * MiB;
constexpr size_t MS_MVT = WS_MISC + 6 * MiB;
constexpr size_t MS_S5AB = WS_MISC + 10 * MiB;
constexpr size_t MS_S5ABL = MS_S5AB + 65536;
constexpr size_t MS_S5BM = MS_S5ABL + 65536;
constexpr size_t MS_S5CM = MS_S5BM + 524288;
constexpr size_t MS_S5E = MS_S5CM + 524288;
constexpr size_t MS_S5SIN = MS_S5E + 1048576;
constexpr int S5_NCH = 8, S5_LC = SEQ / S5_NCH;
constexpr size_t MS_STATS = WS_MISC + 14 * MiB;
constexpr size_t WS_MT = WS_MISC + 22 * MiB;
constexpr size_t WS_VWT = WS_MISC + 38 * MiB;
constexpr size_t MS_GATES = WS_MISC + 16 * MiB;
constexpr size_t MS_CB = WS_MISC + 20 * MiB;
constexpr size_t MS_PAB = OV_T1;
constexpr size_t MS_KCMP = WS_MISC + 54 * MiB;
constexpr size_t OV_KVH = WS_OVL + 64 * MiB;
constexpr size_t OV_QH = WS_OVL + 160 * MiB;
constexpr size_t KVH_SLOT = (size_t)2 * 4 * 8192 * 128;

__device__ __forceinline__ unsigned f2bf(float f) { unsigned u = __builtin_bit_cast(unsigned, f); return (u + 0x7fffu + ((u >> 16) & 1u)) >> 16; }
__device__ __forceinline__ unsigned pk2(float lo, float hi) { unsigned r; asm volatile("v_cvt_pk_bf16_f32 %0, %1, %2" : "=v"(r) : "v"(lo), "v"(hi)); return r; }
__device__ __forceinline__ float bf2f(unsigned short h) { return __builtin_bit_cast(float, (unsigned)h << 16); }

__device__ __forceinline__ int lane_now() { int l_; asm volatile("v_mbcnt_lo_u32_b32 %0, -1, 0\n\tv_mbcnt_hi_u32_b32 %0, -1, %0" : "=v"(l_)); return l_; }
__device__ __forceinline__ float my_shfl_xor(float v, int o) { return __builtin_bit_cast(float, __builtin_amdgcn_ds_bpermute((lane_now() ^ o) << 2, __builtin_bit_cast(int, v))); }
__device__ __forceinline__ int my_shfl_xor(int v, int o) { return __builtin_amdgcn_ds_bpermute((lane_now() ^ o) << 2, v); }
__device__ __forceinline__ float my_shfl(float v, int src) { return __builtin_bit_cast(float, __builtin_amdgcn_ds_bpermute(src << 2, __builtin_bit_cast(int, v))); }
__device__ __forceinline__ float wave_sum(float v) {
#pragma unroll
    for (int o = 1; o < 64; o <<= 1) v += my_shfl_xor(v, o);
    return v;
}
#define LDS_WAIT() asm volatile("s_waitcnt lgkmcnt(0)" ::: "memory")

namespace pg8 {
constexpr int BM = 256, BK = 64, HALF = 128, HTB = HALF * BK * 2, STAGE_BYTES = 8 * HTB, NXCD = 8, WGM = 8;
__host__ __device__ __forceinline__ int lds_byte(int r, int c) { const int st = (r >> 4) * 2 + (c >> 5), rr = r & 15, cc = c & 31, ob = rr * 64 + cc * 2; return st * 1024 + (ob ^ (((ob >> 9) & 1) << 5)); }
__host__ __device__ __forceinline__ void stage_rc(int b, int& R, int& C) { const int st = b / 1024, sb = b % 1024, swz = sb ^ (((sb >> 9) & 1) << 5); R = (st >> 1) * 16 + swz / 64; C = (st & 1) * 32 + (swz % 64) / 2; }
__host__ __device__ __forceinline__ int perm32(int rho) { const int n = rho >> 4, i = rho & 15; return 8 * (i >> 2) + 4 * n + (i & 3); }

struct Unit { int pm, pn, z; unsigned ao, bo; };
struct Gemm { const bf16_t* A; const bf16_t* Bt; int lda, ldb, K; };

struct StaticOrder {
    int nM, nN, nwg, G, c; unsigned ta, tb;
    __device__ void init(int M, int N, int lda, int ldb, int G_, int c_) { nM = M / BM; nN = N / BM; nwg = nM * nN; G = G_; c = c_; ta = (unsigned)BM * lda * 2; tb = (unsigned)BM * ldb * 2; }
    __device__ bool next(int i, Unit& u) const {
        const long L = (long)i * G + c; if (L >= nwg) return false;
        int wgid = (int)L; { const int q = nwg / NXCD, r = nwg % NXCD, xcd = wgid % NXCD, off = wgid / NXCD; wgid = (xcd < r ? xcd * (q + 1) : r * (q + 1) + (xcd - r) * q) + off; }
        const int nig = WGM * nN, gid = wgid / nig, fm = gid * WGM, gsz = (nM - fm) < WGM ? (nM - fm) : WGM;
        u.pm = fm + ((wgid % nig) % gsz); u.pn = (wgid % nig) / gsz; u.z = 0; u.ao = (unsigned)u.pm * ta; u.bo = (unsigned)u.pn * tb; return true;
    }
};

__device__ __forceinline__ unsigned cvt_pk_bf16(float lo, float hi) { unsigned r; asm volatile("v_cvt_pk_bf16_f32 %0, %1, %2" : "=v"(r) : "v"(lo), "v"(hi)); return r; }


template <class Epi, class Sched>
__device__ __forceinline__ void gemm_phase(LAS unsigned char* lds, const Gemm g, const Sched& S, const Epi& E, int wv) {
    int tid; asm volatile("v_mbcnt_lo_u32_b32 %0, -1, 0\n\tv_mbcnt_hi_u32_b32 %0, -1, %0" : "=v"(tid)); tid += wv * 64;
    const int wid = __builtin_amdgcn_readfirstlane(tid >> 6), lane = tid & 63, wr = wid >> 2, wc = wid & 3, fr = lane & 15, fq = lane >> 4;
    int nt = g.K / BK; asm volatile("" : "+s"(nt));
    unsigned voffA[2], voffB[2];
#pragma unroll
    for (int i = 0; i < 2; ++i) { int R, C; stage_rc(tid * 16 + i * 8192, R, C); const int Rb = Epi::PERM ? ((R & ~31) + perm32(R & 31)) : R;
        voffA[i] = (unsigned)(R * g.lda + C) * 2u; voffB[i] = (unsigned)(Rb * g.ldb + C) * 2u; }
    const size_t kstep = (size_t)(BK * 2);
    const size_t hsA = (size_t)HALF * g.lda * 2, hsB = (size_t)HALF * g.ldb * 2;
    const unsigned ldsw = (unsigned)wid * 1024u;
    const int aoff = lds_byte(wr * 64 + fr, fq * 8), boff = lds_byte(wc * 32 + fr, fq * 8);
#define PG8_SA(b, h) (((b) * 2 + (h)) * HTB)
#define PG8_SB(b, h) ((4 + (b) * 2 + (h)) * HTB)
#define PG8_STAGE(bufoff, gbase, voff) do { _Pragma("unroll") for (int _i = 0; _i < 2; ++_i) \
        __builtin_amdgcn_global_load_lds((const unsigned*)((const char*)(gbase) + (voff)[_i]), (LAS unsigned*)(lds + (bufoff) + ldsw + _i * 8192), 16, 0, 0); } while (0)
#define PG8_LDA(dst, b, h) do { _Pragma("unroll") for (int m = 0; m < 4; ++m) _Pragma("unroll") for (int k = 0; k < 2; ++k) dst[m][k] = *(const LAS bf16x8*)(lds + PG8_SA(b, h) + aoff + m * 2048 + k * 1024); } while (0)
#define PG8_LDB(dst, b, h) do { _Pragma("unroll") for (int n = 0; n < 2; ++n) _Pragma("unroll") for (int k = 0; k < 2; ++k) dst[n][k] = *(const LAS bf16x8*)(lds + PG8_SB(b, h) + boff + n * 2048 + k * 1024); } while (0)
#define PG8_MMA(ai, bj, At, Bt) do { __builtin_amdgcn_s_setprio(1); _Pragma("unroll") for (int m = 0; m < 4; ++m) _Pragma("unroll") for (int n = 0; n < 2; ++n) _Pragma("unroll") for (int k = 0; k < 2; ++k) \
        acc[ai][bj][m][n] = __builtin_amdgcn_mfma_f32_16x16x32_bf16(Bt[n][k], At[m][k], acc[ai][bj][m][n], 0, 0, 0); __builtin_amdgcn_s_setprio(0); } while (0)
#define PG8_WAIT_V(n) asm volatile("s_waitcnt vmcnt(" #n ")" ::: "memory")
#define PG8_WAIT_L(n) asm volatile("s_waitcnt lgkmcnt(" #n ")" ::: "memory")
#define PG8_BAR __builtin_amdgcn_s_barrier()
#define PG8_SCHED __builtin_amdgcn_sched_barrier(0)
    Unit cur, nxt; int ui = 0;
    if (!S.next(0, cur)) return;
    f32x4 acc[2][2][4][2];
#pragma unroll
    for (int a = 0; a < 2; ++a)
#pragma unroll
        for (int b = 0; b < 2; ++b)
#pragma unroll
            for (int m = 0; m < 4; ++m)
#pragma unroll
                for (int n = 0; n < 2; ++n) acc[a][b][m][n] = (f32x4){0.f, 0.f, 0.f, 0.f};
    bf16x8 At[4][2], B0[2][2], B1[2][2];
    const char* cA = (const char*)g.A + cur.ao; const char* cB = (const char*)g.Bt + cur.bo;
    PG8_STAGE(PG8_SB(0, 0), cB, voffB); PG8_STAGE(PG8_SB(0, 1), cB + hsB, voffB); PG8_STAGE(PG8_SA(0, 0), cA, voffA); PG8_STAGE(PG8_SA(0, 1), cA + hsA, voffA);
    if (wr == 1) PG8_BAR;
    PG8_WAIT_V(2); PG8_BAR;
    PG8_STAGE(PG8_SB(1, 0), cB + kstep, voffB); PG8_STAGE(PG8_SA(1, 0), cA + kstep, voffA); PG8_STAGE(PG8_SB(1, 1), cB + hsB + kstep, voffB);
    PG8_WAIT_V(6); PG8_BAR;
    for (;;) {
        const bool has_next = S.next(ui + 1, nxt);
        const char* nA = has_next ? (const char*)g.A + nxt.ao : cA; const char* nB = has_next ? (const char*)g.Bt + nxt.bo : cB;
        for (int t = 0; t < nt; t += 2) {
            const bool last = (t == nt - 2);
            const char* a1 = cA + (size_t)(t + 1) * kstep;
            const char* a2 = last ? nA : cA + (size_t)(t + 2) * kstep; const char* b2 = last ? nB : cB + (size_t)(t + 2) * kstep;
            const char* a3 = a2 + kstep; const char* b3 = b2 + kstep;
            PG8_LDB(B0, 0, 0); PG8_LDB(B1, 0, 1); PG8_SCHED; PG8_LDA(At, 0, 0); PG8_STAGE(PG8_SA(1, 1), a1 + hsA, voffA);
            PG8_WAIT_V(8); PG8_WAIT_L(0); PG8_BAR; PG8_MMA(0, 0, At, B0); PG8_MMA(0, 1, At, B1); PG8_BAR; PG8_SCHED;
            PG8_LDA(At, 0, 1); PG8_STAGE(PG8_SB(0, 0), b2, voffB); PG8_STAGE(PG8_SB(0, 1), b2 + hsB, voffB); PG8_STAGE(PG8_SA(0, 0), a2, voffA);
            PG8_WAIT_V(8); PG8_WAIT_L(0); PG8_BAR; PG8_MMA(1, 0, At, B0); PG8_MMA(1, 1, At, B1); PG8_BAR; PG8_SCHED;
            PG8_LDB(B0, 1, 0); PG8_LDB(B1, 1, 1); PG8_SCHED; PG8_LDA(At, 1, 0); PG8_STAGE(PG8_SA(0, 1), a2 + hsA, voffA);
            PG8_WAIT_V(8); PG8_WAIT_L(0); PG8_BAR; PG8_MMA(0, 0, At, B0); PG8_MMA(0, 1, At, B1); PG8_BAR; PG8_SCHED;
            PG8_LDA(At, 1, 1); PG8_STAGE(PG8_SB(1, 0), b3, voffB); PG8_STAGE(PG8_SB(1, 1), b3 + hsB, voffB); PG8_STAGE(PG8_SA(1, 0), a3, voffA);
            PG8_WAIT_V(8); PG8_WAIT_L(0); PG8_BAR; PG8_MMA(1, 0, At, B0); PG8_MMA(1, 1, At, B1); PG8_BAR; PG8_SCHED;
        }
        if (wr == 0) PG8_BAR;
        if constexpr (!Epi::AFTER_DRAIN) { E(acc, cur, wr, wc, fr, fq); }
        if (!has_next) break;
#pragma unroll
        for (int a = 0; a < 2; ++a)
#pragma unroll
            for (int b = 0; b < 2; ++b)
#pragma unroll
                for (int m = 0; m < 4; ++m)
#pragma unroll
                    for (int n = 0; n < 2; ++n) acc[a][b][m][n] = (f32x4){0.f, 0.f, 0.f, 0.f};
        cur = nxt; cA = nA; cB = nB; ++ui;
        if (wr == 1) PG8_BAR;
    }
    PG8_WAIT_V(0);
    PG8_BAR;
    if constexpr (Epi::AFTER_DRAIN) { E.fused(acc, cur, wr, wc, fr, fq, lds, wid, lane); }
#undef PG8_SA
#undef PG8_SB
#undef PG8_STAGE
#undef PG8_LDA
#undef PG8_LDB
#undef PG8_MMA
#undef PG8_WAIT_V
#undef PG8_WAIT_L
#undef PG8_BAR
#undef PG8_SCHED
}

template <class F> struct EpiCols8 {
    static constexpr bool PERM = true, AFTER_DRAIN = false; F f;
    __device__ __forceinline__ void operator()(const f32x4 (&acc)[2][2][4][2], const Unit& u, int wr, int wc, int fr, int fq) const {
#pragma unroll
        for (int ai = 0; ai < 2; ++ai)
#pragma unroll
            for (int m = 0; m < 4; ++m) { const int row = u.pm * BM + ai * HALF + wr * 64 + m * 16 + fr;
#pragma unroll
                for (int bj = 0; bj < 2; ++bj) f(u, row, u.pn * BM + bj * HALF + wc * 32 + 8 * fq, acc[ai][bj][m][0], acc[ai][bj][m][1]); }
    }
};
template <int MODE> struct EpiRes {
    static constexpr bool PERM = false, AFTER_DRAIN = false; const float* res; float* out; const f32x2* st; const float* g; const float* b; int ldc; float alpha;
    __device__ __forceinline__ void operator()(const f32x4 (&acc)[2][2][4][2], const Unit& u, int wr, int wc, int fr, int fq) const {
        const unsigned row0 = (unsigned)(u.pm * BM + wr * 64 + fr), col0 = (unsigned)(u.pn * BM + wc * 32 + 4 * fq);
        const unsigned base = row0 * (unsigned)ldc + col0;
        f32x4 gv[2][2], bv[2][2];
        if (MODE == 1) {
#pragma unroll
            for (int bj = 0; bj < 2; ++bj)
#pragma unroll
                for (int n = 0; n < 2; ++n) { gv[bj][n] = *(const f32x4*)(g + col0 + bj * HALF + n * 16); bv[bj][n] = *(const f32x4*)(b + col0 + bj * HALF + n * 16); }
        }
#pragma unroll
        for (int ai = 0; ai < 2; ++ai)
#pragma unroll
            for (int mp = 0; mp < 2; ++mp) {
                f32x4 r[2][2][2]; f32x2 sv[2];
#pragma unroll
                for (int mm = 0; mm < 2; ++mm) { const int m = 2 * mp + mm; const unsigned off = base + (unsigned)(ai * HALF + m * 16) * (unsigned)ldc;
                    if (MODE == 1) sv[mm] = st[row0 + ai * HALF + m * 16];
#pragma unroll
                    for (int bj = 0; bj < 2; ++bj)
#pragma unroll
                        for (int n = 0; n < 2; ++n) r[mm][bj][n] = *(const f32x4*)(res + (off + bj * HALF + n * 16)); }
                asm volatile("" ::: "memory");
#pragma unroll
                for (int mm = 0; mm < 2; ++mm) { const int m = 2 * mp + mm; const unsigned off = base + (unsigned)(ai * HALF + m * 16) * (unsigned)ldc;
#pragma unroll
                    for (int bj = 0; bj < 2; ++bj)
#pragma unroll
                        for (int n = 0; n < 2; ++n) { f32x4 x = r[mm][bj][n];
                            if (MODE == 1) x = (x - sv[mm].x) * sv[mm].y * gv[bj][n] + bv[bj][n];
                            *(f32x4*)(out + (off + bj * HALF + n * 16)) = x * alpha + acc[ai][bj][m][n]; } }
                asm volatile("" ::: "memory");
            }
    }
};
}

struct Args { const float* in[29]; float* out; unsigned char* ws; int ph_lo, ph_hi; };
enum { I_X = 0, I_MEM, I_S5_WIN, I_S5_ARE, I_S5_AIM, I_S5_LOGDT, I_S5_BRE, I_S5_BIM, I_S5_CRE, I_S5_CIM, I_S5_D, I_S5_WGLU, I_S5_WOUT, I_KVW,
       I_CPK, I_CW1K, I_CW2K, I_CPV, I_CW1V, I_CW2V, I_WQG, I_WNO, I_MWQ, I_MWKV, I_MWO, I_WUP, I_WDN, I_LNG, I_LNB };

__device__ __forceinline__ const float* argp(int i) {
    const char* kp = (const char*)__builtin_amdgcn_kernarg_segment_ptr(); const float* p;
    asm volatile("s_load_dwordx2 %0, %1, %2\n\ts_waitcnt lgkmcnt(0)" : "=s"(p) : "s"(kp), "i"(i * 8)); return p; }
#define INP(i) argp(i)

__device__ __forceinline__ void conv_item(const float* W, int ldw, int ncols, bf16_t* WT, int ldt, int k0, int n0, int drow0, LAS float* scr, int lane) {
    const int r8 = lane >> 3, c4 = (lane & 7) * 4; const bool ok = (n0 + c4) < ncols;
    f32x4 v[8];
#pragma unroll
    for (int i = 0; i < 8; ++i) v[i] = ok ? *(const f32x4*)(W + (size_t)(k0 + 8 * i + r8) * ldw + n0 + c4) : (f32x4){0.f, 0.f, 0.f, 0.f};
#pragma unroll
    for (int i = 0; i < 8; ++i) { LAS float* d = scr + (8 * i + r8) * 33 + c4; d[0] = v[i].x; d[1] = v[i].y; d[2] = v[i].z; d[3] = v[i].w; }
    LDS_WAIT(); asm volatile("" ::: "memory");
    const int c = lane & 7;
#pragma unroll
    for (int j = 0; j < 4; ++j) { const int n = (lane >> 3) + 8 * j; const LAS float* s = scr + (8 * c) * 33 + n;
        u32x4 o; o.x = pk2(s[0 * 33], s[1 * 33]); o.y = pk2(s[2 * 33], s[3 * 33]); o.z = pk2(s[4 * 33], s[5 * 33]); o.w = pk2(s[6 * 33], s[7 * 33]);
        *(u32x4*)(WT + (size_t)(drow0 + n) * ldt + k0 + 8 * c) = o; }
    LDS_WAIT(); asm volatile("" ::: "memory");
}
template <int MODE>
__device__ __forceinline__ void conv_matrix(const float* W, int K, int ldw, int ncols, bf16_t* WT, int ldt, int row_off, LAS float* scr, int gw, int NGW, int lane) {
    const int nblk = (ncols + 31) / 32, nitems = (K / 64) * nblk;
    for (int it = gw; it < nitems; it += NGW) {
        const int kb = it / nblk, nb = it % nblk, n0 = 32 * nb;
        int drow0;
        if (MODE == 1) { const int bj = n0 >> 11, j = n0 & 2047; drow0 = 256 * (j >> 7) + 128 * bj + (j & 127); } else drow0 = row_off + n0;
        conv_item(W, ldw, ncols, WT, ldt, 64 * kb, n0, drow0, scr, lane);
    }
}
__device__ __forceinline__ void cvt_rows(const float* src, bf16_t* dst, size_t n, int gtid, int gthreads) {
    for (size_t i = (size_t)gtid * 8; i < n; i += (size_t)gthreads * 8) {
        const f32x4 a = *(const f32x4*)(src + i), b = *(const f32x4*)(src + i + 4);
        u32x4 o; o.x = pk2(a.x, a.y); o.y = pk2(a.z, a.w); o.z = pk2(b.x, b.y); o.w = pk2(b.z, b.w);
        *(u32x4*)(dst + i) = o;
    }
}
template <bool WF32>
__device__ __forceinline__ void ln_phase(const float* src, float prescale, float* XF, bf16_t* XB, f32x2* ST, const float* g, const float* b, int gw, int NGW, int lane) {
    asm volatile("" : "+v"(lane));
    for (int row = gw; row < MTOK; row += NGW) {
        const f32x4* xr = (const f32x4*)(src + (size_t)row * DM) + lane;
        f32x4 v[8]; float s = 0.f;
#pragma unroll
        for (int j = 0; j < 8; ++j) { v[j] = xr[64 * j] * prescale; s += (v[j].x + v[j].y) + (v[j].z + v[j].w); }
        const float mean = wave_sum(s) * (1.f / DM); float s2 = 0.f;
#pragma unroll
        for (int j = 0; j < 8; ++j) { v[j] = v[j] - mean; s2 += (v[j].x * v[j].x + v[j].y * v[j].y) + (v[j].z * v[j].z + v[j].w * v[j].w); }
        const float rstd = 1.f / sqrtf(wave_sum(s2) * (1.f / DM) + LN_EPS);
        if (!WF32 && lane == 0) ST[row] = (f32x2){mean, rstd};
        f32x4* xo = (f32x4*)(XF + (size_t)row * DM) + lane; u32x2* bo = (u32x2*)(XB + (size_t)row * DM) + lane;
#pragma unroll
        for (int j = 0; j < 8; ++j) { const f32x4 gv = ((const f32x4*)g)[lane + 64 * j], bv = ((const f32x4*)b)[lane + 64 * j];
            const f32x4 o = v[j] * rstd * gv + bv; if (WF32) xo[64 * j] = o; else { u32x2 w; w.x = pk2(o.x, o.y); w.y = pk2(o.z, o.w); bo[64 * j] = w; } }
    }
}

struct StoreBf16 { bf16_t* O; int ldc; float scale;
    __device__ __forceinline__ void operator()(const pg8::Unit&, int row, int col, f32x4 v0, f32x4 v1) const {
        u32x4 w; w.x = pg8::cvt_pk_bf16(v0[0] * scale, v0[1] * scale); w.y = pg8::cvt_pk_bf16(v0[2] * scale, v0[3] * scale); w.z = pg8::cvt_pk_bf16(v1[0] * scale, v1[1] * scale); w.w = pg8::cvt_pk_bf16(v1[2] * scale, v1[3] * scale);
        *(u32x4*)(O + (size_t)row * ldc + col) = w; } };
struct StoreRelu2 { bf16_t* O; int ldc;
    __device__ __forceinline__ void operator()(const pg8::Unit&, int row, int col, f32x4 v0, f32x4 v1) const {
#pragma unroll
        for (int i = 0; i < 4; ++i) { const float a = v0[i] > 0.f ? v0[i] : 0.f, c = v1[i] > 0.f ? v1[i] : 0.f; v0[i] = a * a; v1[i] = c * c; }
        u32x4 w; w.x = pg8::cvt_pk_bf16(v0[0], v0[1]); w.y = pg8::cvt_pk_bf16(v0[2], v0[3]); w.z = pg8::cvt_pk_bf16(v1[0], v1[1]); w.w = pg8::cvt_pk_bf16(v1[2], v1[3]);
        *(u32x4*)(O + (size_t)row * ldc + col) = w; } };


__device__ __forceinline__ void s5_tables(const float* a_re, const float* a_im, const float* log_dt, const float* b_re, const float* b_im, const float* c_re, const float* c_im,
                                          unsigned char* ws, int gtid, int gthreads) {
    f32x2* AB = (f32x2*)(ws + MS_S5AB); f32x2* ABL = (f32x2*)(ws + MS_S5ABL); bf16_t* BM = (bf16_t*)(ws + MS_S5BM); bf16_t* CM = (bf16_t*)(ws + MS_S5CM);
    for (int i = gtid; i < 128 * 64 * 16; i += gthreads) {
        const int h = i & 15, p = (i >> 4) & 63, g = i >> 10;
        const float dt = expf(log_dt[g]), lr = a_re[g * 64 + p], li = a_im[g * 64 + p];
        const float mag = expf(lr * dt), abr = mag * cosf(li * dt), abi = mag * sinf(li * dt);
        const float den = lr * lr + li * li, nr = abr - 1.0f, ni = abi;
        const float fre = (nr * lr + ni * li) / den, fim = (ni * lr - nr * li) / den;
        const float br = b_re[(g * 64 + p) * 16 + h], bi = b_im[(g * 64 + p) * 16 + h];
        BM[(g * 128 + p) * 16 + h] = (bf16_t)f2bf(fre * br - fim * bi);
        BM[(g * 128 + 64 + p) * 16 + h] = (bf16_t)f2bf(fre * bi + fim * br);
        CM[(g * 16 + h) * 128 + p] = (bf16_t)f2bf(c_re[(g * 16 + h) * 64 + p]);
        CM[(g * 16 + h) * 128 + 64 + p] = (bf16_t)f2bf(-c_im[(g * 16 + h) * 64 + p]);
        if (h == 0) { AB[g * 64 + p] = (f32x2){abr, abi}; float xr = abr, xi = abi;
            for (int k = S5_LC; k > 1; k >>= 1) { const float t = xr * xr - xi * xi; xi = 2.f * xr * xi; xr = t; }
            ABL[g * 64 + p] = (f32x2){xr, xi}; }
    }
}
__device__ __forceinline__ float gelu_tanh(float y) { const float z = 0.7978845608028654f * (y + 0.044715f * y * y * y); const float e = __expf(2.f * z); return y * (1.f - __builtin_amdgcn_rcpf(1.f + e)); }
template <bool FINAL>
__device__ __forceinline__ void s5_pass(const bf16_t* U, bf16_t* Y, const float* dskip, unsigned char* ws, LAS unsigned char* lds, int gw, int NGW, int wave, int lane) {
    asm volatile("" : "+v"(lane));
    const int fr = lane & 15, fq = lane >> 4;
    LAS float* BU = (LAS float*)(lds + wave * 12800); LAS bf16_t* SB = (LAS bf16_t*)(lds + wave * 12800 + 8448);
    constexpr int LDB = 132, LDSB = 136;
    for (int item = gw; item < 2 * 128 * S5_NCH; item += NGW) {
        const int g = item & 127, b = (item >> 7) & 1, ch = item >> 8;
        const bf16_t* BMg = (const bf16_t*)(ws + MS_S5BM) + (size_t)g * 128 * 16; const bf16_t* CMg = (const bf16_t*)(ws + MS_S5CM) + (size_t)g * 16 * 128;
        bf16x8 bmf[8];
#pragma unroll
        for (int nt = 0; nt < 8; ++nt) { bmf[nt] = (bf16x8){0, 0, 0, 0, 0, 0, 0, 0}; if (fq < 2) bmf[nt] = *(const bf16x8*)(BMg + (16 * nt + fr) * 16 + 8 * fq); }
        bf16x8 cmf[4];
        if (FINAL) {
#pragma unroll
            for (int kk = 0; kk < 4; ++kk) cmf[kk] = *(const bf16x8*)(CMg + fr * 128 + 32 * kk + 8 * fq);
        }
        const f32x2 ab = ((const f32x2*)(ws + MS_S5AB))[g * 64 + lane];
        const float ar = ab.x, ai = ab.y;
        float sr = 0.f, si = 0.f;
        if (FINAL) { const f32x2 al = ((const f32x2*)(ws + MS_S5ABL))[g * 64 + lane]; const f32x2* E = (const f32x2*)(ws + MS_S5E) + (size_t)(b * 128 + g) * S5_NCH * 64 + lane;
            for (int c = 0; c < ch; ++c) { const f32x2 e = E[c * 64]; const float nr = al.x * sr - al.y * si + e.x, ni = al.x * si + al.y * sr + e.y; sr = nr; si = ni; } }
        const float dsk = FINAL ? dskip[g * 16 + fr] : 0.f;
        const size_t row0 = (size_t)b * SEQ + (size_t)ch * S5_LC;
        const bf16_t* Up = U + (row0 + fr) * DM + g * 16 + 8 * fq;
        bf16x8 uf = (bf16x8){0, 0, 0, 0, 0, 0, 0, 0}; if (fq < 2) uf = *(const bf16x8*)Up;
        for (int t0 = 0; t0 < S5_LC; t0 += 16) {
            bf16x8 un = (bf16x8){0, 0, 0, 0, 0, 0, 0, 0};
            if (fq < 2 && t0 + 16 < S5_LC) un = *(const bf16x8*)(Up + (size_t)(t0 + 16) * DM);
#pragma unroll
            for (int nt = 0; nt < 8; ++nt) { const f32x4 d = __builtin_amdgcn_mfma_f32_16x16x32_bf16(uf, bmf[nt], (f32x4){0.f, 0.f, 0.f, 0.f}, 0, 0, 0);
#pragma unroll
                for (int r = 0; r < 4; ++r) BU[(4 * fq + r) * LDB + 16 * nt + fr] = d[r]; }
#pragma unroll
            for (int t = 0; t < 16; ++t) { const float br = BU[t * LDB + lane], bi = BU[t * LDB + 64 + lane];
                const float nr = ar * sr - ai * si + br, ni = ar * si + ai * sr + bi; sr = nr; si = ni;
                if (FINAL) { SB[t * LDSB + lane] = (bf16_t)f2bf(sr); SB[t * LDSB + 64 + lane] = (bf16_t)f2bf(si); } }
            if (FINAL) {
                f32x4 y = (f32x4){0.f, 0.f, 0.f, 0.f};
#pragma unroll
                for (int kk = 0; kk < 4; ++kk) { const bf16x8 sf = *(const LAS bf16x8*)(SB + fr * LDSB + 32 * kk + 8 * fq); y = __builtin_amdgcn_mfma_f32_16x16x32_bf16(sf, cmf[kk], y, 0, 0, 0); }
#pragma unroll
                for (int r = 0; r < 4; ++r) { const size_t o = (row0 + t0 + 4 * fq + r) * DM + g * 16 + fr; const float uu = bf2f(U[o]); Y[o] = (bf16_t)f2bf(gelu_tanh(y[r] + dsk * uu)); }
            }
            uf = un;
        }
        if (!FINAL) ((f32x2*)(ws + MS_S5E))[((b * 128 + g) * S5_NCH + ch) * 64 + lane] = (f32x2){sr, si};
    }
}
__device__ __forceinline__ void s5_carry(unsigned char* ws, int gtid, int gthreads) {
    for (int i = gtid; i < 2 * 128 * 64; i += gthreads) {
        const int p = i & 63, bg = i >> 6, g = bg & 127;
        const f32x2 al = ((const f32x2*)(ws + MS_S5ABL))[g * 64 + p];
        const f32x2* E = (const f32x2*)(ws + MS_S5E) + (size_t)bg * S5_NCH * 64 + p; f32x2* SI = (f32x2*)(ws + MS_S5SIN) + (size_t)bg * S5_NCH * 64 + p;
        float sr = 0.f, si = 0.f;
        for (int c = 0; c < S5_NCH; ++c) { SI[c * 64] = (f32x2){sr, si}; const f32x2 e = E[c * 64]; const float nr = al.x * sr - al.y * si + e.x, ni = al.x * si + al.y * sr + e.y; sr = nr; si = ni; }
    }
}

struct EpiGlu {
    static constexpr bool PERM = true, AFTER_DRAIN = false; bf16_t* O; int ldc;
    __device__ __forceinline__ void operator()(const f32x4 (&acc)[2][2][4][2], const pg8::Unit& u, int wr, int wc, int fr, int fq) const {
        const int col = u.pn * 128 + wc * 32 + 8 * fq;
#pragma unroll
        for (int ai = 0; ai < 2; ++ai)
#pragma unroll
            for (int m = 0; m < 4; ++m) { const int row = u.pm * 256 + ai * 128 + wr * 64 + m * 16 + fr; float o[8];
#pragma unroll
                for (int n = 0; n < 2; ++n)
#pragma unroll
                    for (int i = 0; i < 4; ++i) { const float v = acc[ai][0][m][n][i], gt = acc[ai][1][m][n][i]; o[4 * n + i] = v * __builtin_amdgcn_rcpf(1.f + __expf(-gt)); }
                u32x4 w; w.x = pg8::cvt_pk_bf16(o[0], o[1]); w.y = pg8::cvt_pk_bf16(o[2], o[3]); w.z = pg8::cvt_pk_bf16(o[4], o[5]); w.w = pg8::cvt_pk_bf16(o[6], o[7]);
                *(u32x4*)(O + (size_t)row * ldc + col) = w; }
    }
};
struct EpiSoftmax {
    static constexpr bool PERM = false, AFTER_DRAIN = true; bf16_t* P;
    __device__ __forceinline__ void fused(f32x4 (&acc)[2][2][4][2], const pg8::Unit& u, int wr, int wc, int fr, int fq, LAS unsigned char* lds, int wid, int lane) const {
        LAS f32x2* X = (LAS f32x2*)lds;
        float mw[2][4];
#pragma unroll
        for (int ai = 0; ai < 2; ++ai)
#pragma unroll
            for (int m = 0; m < 4; ++m) {
                float mx = -3.0e38f;
#pragma unroll
                for (int bj = 0; bj < 2; ++bj)
#pragma unroll
                    for (int n = 0; n < 2; ++n)
#pragma unroll
                        for (int i = 0; i < 4; ++i) mx = fmaxf(mx, acc[ai][bj][m][n][i]);
                mx = fmaxf(mx, my_shfl_xor(mx, 16)); mx = fmaxf(mx, my_shfl_xor(mx, 32));
                float sm = 0.f;
#pragma unroll
                for (int bj = 0; bj < 2; ++bj)
#pragma unroll
                    for (int n = 0; n < 2; ++n)
#pragma unroll
                        for (int i = 0; i < 4; ++i) { const float e = __builtin_amdgcn_exp2f(acc[ai][bj][m][n][i] - mx); acc[ai][bj][m][n][i] = e; sm += e; }
                sm += my_shfl_xor(sm, 16); sm += my_shfl_xor(sm, 32);
                mw[ai][m] = mx;
                if (fq == 0) X[(ai * 128 + wr * 64 + m * 16 + fr) * 4 + wc] = (f32x2){mx, sm};
            }
        LDS_WAIT(); __builtin_amdgcn_s_barrier(); asm volatile("" ::: "memory");
#pragma unroll
        for (int ai = 0; ai < 2; ++ai)
#pragma unroll
            for (int m = 0; m < 4; ++m) { const int r = ai * 128 + wr * 64 + m * 16 + fr;
                const f32x2 a = X[r * 4 + 0], b = X[r * 4 + 1], c = X[r * 4 + 2], d = X[r * 4 + 3];
                const float M = fmaxf(fmaxf(a.x, b.x), fmaxf(c.x, d.x));
                const float tot = a.y * __builtin_amdgcn_exp2f(a.x - M) + b.y * __builtin_amdgcn_exp2f(b.x - M) + c.y * __builtin_amdgcn_exp2f(c.x - M) + d.y * __builtin_amdgcn_exp2f(d.x - M);
                const float f = __builtin_amdgcn_exp2f(mw[ai][m] - M) / tot;
                bf16_t* rowp = P + (size_t)(u.pm * 256 + r) * 1024 + u.z * 256 + wc * 32 + 4 * fq;
#pragma unroll
                for (int bj = 0; bj < 2; ++bj)
#pragma unroll
                    for (int n = 0; n < 2; ++n) { const f32x4 v = acc[ai][bj][m][n] * f; u32x2 w; w.x = pg8::cvt_pk_bf16(v[0], v[1]); w.y = pg8::cvt_pk_bf16(v[2], v[3]); *(u32x2*)(rowp + bj * 128 + n * 16) = w; } }
        LDS_WAIT(); __builtin_amdgcn_s_barrier(); asm volatile("" ::: "memory");
    }
};
struct CmpSched {
    int G, c;
    __device__ bool next(int i, pg8::Unit& u) const {
        const int L = i * G + c; if (L >= 128) return false;
        const int which = L >> 6, ks = (L >> 4) & 3, pm = L & 15; u.pm = pm; u.pn = 0; u.z = which * 4 + ks;
        u.ao = (unsigned)(((size_t)which * KVH_SLOT + (size_t)pm * 256 * 2048 + ks * 512) * 2); u.bo = (unsigned)(((size_t)which * 256 * 2048 + ks * 512) * 2);
        return true;
    }
};
struct StoreBf16Z { bf16_t* O; int ldc; float scale; size_t zstride;
    __device__ __forceinline__ void operator()(const pg8::Unit& u, int row, int col, f32x4 v0, f32x4 v1) const {
        u32x4 w; w.x = pg8::cvt_pk_bf16(v0[0] * scale, v0[1] * scale); w.y = pg8::cvt_pk_bf16(v0[2] * scale, v0[3] * scale); w.z = pg8::cvt_pk_bf16(v1[0] * scale, v1[1] * scale); w.w = pg8::cvt_pk_bf16(v1[2] * scale, v1[3] * scale);
        *(u32x4*)(O + (size_t)u.z * zstride + (size_t)row * ldc + col) = w; } };
struct KvSched { int G, c;
    __device__ bool next(int i, pg8::Unit& u) const { const int L = i * G + c; if (L >= 64) return false;
        const int l = L >> 5, pm = (L >> 4) & 1, pn = L & 15; u.pm = pm; u.pn = pn; u.z = l;
        u.ao = (unsigned)((size_t)pm * 256 * 2048 * 2); u.bo = (unsigned)((size_t)l * 16 * MiB + (size_t)pn * 256 * 2048 * 2); return true; } };
struct MtSched { int G, c;
    __device__ bool next(int i, pg8::Unit& u) const { const int L = i * G + c; if (L >= 128 || L < 0) return false;
        const int l = L >> 6, b = (L >> 5) & 1, h = (L >> 3) & 3, pn = L & 7; u.pm = h; u.pn = pn; u.z = l * 2 + b;
        u.ao = (unsigned)((size_t)l * 4 * MiB + ((size_t)(b * 256) * 4096 + h * 512) * 2); u.bo = (unsigned)((size_t)l * 8 * MiB + ((size_t)(pn * 256) * 2048 + h * 512) * 2); return true; } };
struct VwSched { int G, c;
    __device__ bool next(int i, pg8::Unit& u) const { const int L = i * G + c; if (L >= 128 || L < 0) return false;
        const int l = L >> 6, b = (L >> 5) & 1, h = (L >> 3) & 3, pmn = L & 7; u.pm = pmn; u.pn = h; u.z = l * 2 + b;
        u.ao = (unsigned)((size_t)l * 8 * MiB + ((size_t)(pmn * 256) * 2048 + h * 512) * 2); u.bo = (unsigned)((size_t)l * 4 * MiB + ((size_t)(b * 256) * 4096 + 2048 + h * 512) * 2); return true; } };
struct ScoreSched { int G, c, base, lim, layer;
    __device__ bool next(int i, pg8::Unit& u) const { const int L0 = base + i * G + c; if (L0 >= lim) return false;
        const int L = (G == 256) ? ((L0 & 7) * 32 + (L0 >> 3)) : L0;
        const int b = L >> 7, pmp = (L >> 2) & 31, h = L & 3; u.pm = b * 32 + pmp; u.pn = 0; u.z = h;
        u.ao = (unsigned)((size_t)(b * SEQ + 256 * pmp) * 2048 * 2); u.bo = (unsigned)((size_t)(layer * 2 + b) * 4 * MiB + (size_t)(h * 256) * 2048 * 2); return true; } };
struct PvoSched { pg8::StaticOrder so; int layer;
    __device__ bool next(int i, pg8::Unit& u) const { if (!so.next(i, u)) return false; u.bo += (unsigned)((size_t)(layer * 2 + (u.pm >> 5)) * 4 * MiB); return true; } };
template <int MODE> struct MemSched {
    int G, c, base, lim;
    __device__ bool next(int i, pg8::Unit& u) const {
        const int L = base + i * G + c; if (L >= lim) return false;
        if (MODE == 0) { const int b = L >> 7, h = (L >> 5) & 3, pmp = L & 31; u.pm = b * 32 + pmp; u.pn = 0; u.z = h;
            u.ao = (unsigned)(((b * SEQ + 256 * pmp) * 2048 + h * 512) * 2); u.bo = (unsigned)(((b * 256) * 2048 + h * 512) * 2); }
        else { const int pn = L & 1, pmp = (L >> 1) & 31, h = (L >> 6) & 3, b = L >> 8; u.pm = b * 32 + pmp; u.pn = h * 2 + pn; u.z = 0;
            u.ao = (unsigned)(((b * SEQ + 256 * pmp) * 1024 + h * 256) * 2); u.bo = (unsigned)(((h * 512 + 256 * pn) * 512 + b * 256) * 2); }
        return true;
    }
};


struct StoreKVQ { bf16_t* KVH; bf16_t* QH; float* GATES; float qscale;
    __device__ __forceinline__ void operator()(const pg8::Unit&, int row, int col, f32x4 v0, f32x4 v1) const {
        const int b = row >> 13, t = row & 8191;
        if (col < 3072) { const int slot = col >> 9, g = (col >> 7) & 3, d = col & 127;
            u32x4 w; w.x = pg8::cvt_pk_bf16(v0[0], v0[1]); w.y = pg8::cvt_pk_bf16(v0[2], v0[3]); w.z = pg8::cvt_pk_bf16(v1[0], v1[1]); w.w = pg8::cvt_pk_bf16(v1[2], v1[3]);
            *(u32x4*)(KVH + ((((size_t)slot * 2 + b) * 4 + g) * 8192 + t) * 128 + d) = w; }
        else if (col < 5120) { const int c2 = col - 3072, head = c2 >> 7, d = c2 & 127, g = head >> 2, r = head & 3; v0 = v0 * qscale; v1 = v1 * qscale;
            u32x4 w; w.x = pg8::cvt_pk_bf16(v0[0], v0[1]); w.y = pg8::cvt_pk_bf16(v0[2], v0[3]); w.z = pg8::cvt_pk_bf16(v1[0], v1[1]); w.w = pg8::cvt_pk_bf16(v1[2], v1[3]);
            *(u32x4*)(QH + ((((size_t)b * 4 + g) * 8192 + t) * 4 + r) * 128 + d) = w; }
        else if (col < 5168) { float* gp = GATES + (size_t)row * 48 + (col - 5120);
#pragma unroll
            for (int i = 0; i < 4; ++i) { v0[i] = __builtin_amdgcn_rcpf(1.f + __expf(-v0[i])); v1[i] = __builtin_amdgcn_rcpf(1.f + __expf(-v1[i])); }
            *(f32x4*)gp = v0; *(f32x4*)(gp + 4) = v1; }
    } };
struct StoreF32 { float* O; int ldc; size_t zstride;
    __device__ __forceinline__ void operator()(const pg8::Unit& u, int row, int col, f32x4 v0, f32x4 v1) const { float* p = O + (size_t)u.z * zstride + (size_t)row * ldc + col; *(f32x4*)p = v0; *(f32x4*)(p + 4) = v1; } };
__device__ __forceinline__ void cmp_bias(const float* pos_k, const float* w1_k, const float* pos_v, const float* w1_v, float* CB, int tid) {
    if (tid < 256) { const int which = tid >> 7, n = tid & 127; const float* pos = which ? pos_v : pos_k; const float* w1 = which ? w1_v : w1_k; float a = 0.f;
        for (int k = 0; k < 4096; ++k) a += pos[k] * w1[(size_t)k * 128 + n];
        CB[tid] = a; }
}
__device__ __forceinline__ void cmp_combine(const float* PAB, const float* CB, const float* w2k, const float* w2v, bf16_t* KCMP, int gw, int NGW, int lane) {
    asm volatile("" : "+v"(lane));
    for (int it = gw; it < 2 * 4096; it += NGW) {
        const int which = it >> 12, row = it & 4095, c = row & 511;
        bf16_t* out = KCMP + ((size_t)which * 4096 + row) * 128;
        if (c == 511) { out[lane] = 0; out[lane + 64] = 0; continue; }
        const float* P = PAB + (size_t)which * 4 * 4096 * 256; const float* w2 = which ? w2v : w2k;
        float sa = CB[which * 128 + lane], sb = CB[which * 128 + 64 + lane];
#pragma unroll
        for (int ks = 0; ks < 4; ++ks) { const float* Pk = P + (size_t)ks * 4096 * 256;
            sa += Pk[(size_t)row * 256 + lane] + Pk[(size_t)(row + 1) * 256 + 128 + lane]; sb += Pk[(size_t)row * 256 + 64 + lane] + Pk[(size_t)(row + 1) * 256 + 192 + lane]; }
        const float va = gelu_tanh(sa), vb = gelu_tanh(sb);
        float o0 = 0.f, o1 = 0.f;
        for (int n = 0; n < 64; ++n) { const float x = my_shfl(va, n); o0 += x * w2[n * 128 + lane]; o1 += x * w2[n * 128 + 64 + lane]; }
        for (int n = 0; n < 64; ++n) { const float x = my_shfl(vb, n); o0 += x * w2[(64 + n) * 128 + lane]; o1 += x * w2[(64 + n) * 128 + 64 + lane]; }
        out[lane] = (bf16_t)f2bf(o0); out[lane + 64] = (bf16_t)f2bf(o1);
    }
}

namespace nsa {
constexpr int L_K0 = 0, L_V0 = 32768, L_IMP = 65536, IMP_LD = 132, IMP_WAVE = 8 * IMP_LD * 4, L_SELM = L_IMP + 8 * IMP_WAVE, L_UNI = L_SELM + 8 * 128, L_NTL = L_UNI + 16, L_TL = L_NTL + 16, L_WSF = L_TL + 512;
constexpr float NEGB = -1.0e30f;
typedef short v4i16_t __attribute__((ext_vector_type(4)));
__device__ __forceinline__ unsigned off_b(unsigned row, unsigned ch) { return 256u * row + 16u * (ch ^ (((row & 3) << 2) | ((row >> 2) & 3))); }
__device__ __forceinline__ int crow(int r, int hi) { return (r & 3) + 8 * (r >> 2) + 4 * hi; }
__device__ __forceinline__ float xhalf(float v) { return my_shfl_xor(v, 32); }

template <int BR, int MODE>
__device__ __forceinline__ void run_tiles(LAS unsigned char* lds, const bf16_t* Kb, const bf16_t* Vb, int ntiles, int first, int qt, const bf16x8 (&qf)[8], f32x16 (&o)[4], float& l_run,
                                          int t, unsigned selw0, unsigned selw1, unsigned selw2, unsigned selw3, float pscale, float gate, int tid, int wave, int lane) {
    const int l32 = lane & 31, hi = lane >> 5;
    LAS const int* TL = (LAS const int*)(lds + L_TL);
    LAS float* imp = (LAS float*)(lds + L_IMP + wave * IMP_WAVE) + ((l32 >> 2) * IMP_LD);
    const unsigned soff = (unsigned)((4 * wave + (lane >> 4)) * 128 + (((lane & 15) ^ (((lane >> 4) << 2) | (wave & 3))) * 8));
    auto tile_of = [&](int i) -> int { return (BR == 1) ? TL[i] : first + i; };
    auto stage = [&](int tile, int buf) { const bf16_t* ks = Kb + (size_t)tile * 8192 + soff; LAS unsigned char* kd = lds + L_K0 + buf * 16384 + wave * 1024;
        __builtin_amdgcn_global_load_lds((const unsigned*)ks, (LAS unsigned*)kd, 16, 0, 0); __builtin_amdgcn_global_load_lds((const unsigned*)(ks + 4096), (LAS unsigned*)(kd + 8192), 16, 0, 0);
        if (MODE != 0) { const bf16_t* vs = Vb + (size_t)tile * 8192 + soff; LAS unsigned char* vd = lds + L_V0 + buf * 16384 + wave * 1024;
            __builtin_amdgcn_global_load_lds((const unsigned*)vs, (LAS unsigned*)vd, 16, 0, 0); __builtin_amdgcn_global_load_lds((const unsigned*)(vs + 4096), (LAS unsigned*)(vd + 8192), 16, 0, 0); } };
    if (ntiles <= 0) return;
    stage(tile_of(0), 0);
    asm volatile("s_waitcnt vmcnt(0) lgkmcnt(0)" ::: "memory"); __builtin_amdgcn_s_barrier(); asm volatile("" ::: "memory");
    const unsigned kx = ((l32 & 3) << 2) | ((l32 >> 2) & 3);
    const int blk = (lane >> 4) & 1, tq = (lane & 15) >> 2, tp = lane & 3;
    for (int i = 0; i < ntiles; ++i) {
        const int tile = tile_of(i), buf = i & 1;
        if (i + 1 < ntiles) stage(tile_of(i + 1), buf ^ 1);
        bool selbit = true;
        if (BR == 1) { const unsigned w = (tile < 32) ? selw0 : (tile < 64) ? selw1 : (tile < 96) ? selw2 : selw3; selbit = (w >> (tile & 31)) & 1u; }
        const bool active = (BR == 1) ? (bool)__any((int)selbit) : true;
        if (active) {
            LAS const unsigned char* kb = lds + L_K0 + buf * 16384; LAS const unsigned char* vb = lds + L_V0 + buf * 16384;
            f32x16 p0, p1;
#pragma unroll
            for (int r = 0; r < 16; ++r) { p0[r] = 0.f; p1[r] = 0.f; }
            {
                bf16x8 kq0[3], kq1[3];
#define NSA_LDK(s_, slot_) do { const unsigned ko_ = 256u * l32 + 16u * ((unsigned)(2 * (s_) + hi) ^ kx); kq0[slot_] = *(LAS const bf16x8*)(kb + ko_); kq1[slot_] = *(LAS const bf16x8*)(kb + 8192 + ko_); } while (0)
                NSA_LDK(0, 0); NSA_LDK(1, 1);
                __builtin_amdgcn_sched_barrier(0);
#pragma unroll
                for (int s = 0; s < 8; ++s) {
                    if (s + 2 < 8) NSA_LDK(s + 2, (s + 2) % 3);
                    __builtin_amdgcn_sched_barrier(0);
                    p0 = __builtin_amdgcn_mfma_f32_32x32x16_bf16(kq0[s % 3], qf[s], p0, 0, 0, 0); p1 = __builtin_amdgcn_mfma_f32_32x32x16_bf16(kq1[s % 3], qf[s], p1, 0, 0, 0);
                    __builtin_amdgcn_sched_barrier(0);
                }
#undef NSA_LDK
            }
            const int kbase = tile * 64;
            const bool need_mask = (BR == 0) ? true : (BR == 1) ? (tile == qt) : ((tile == qt) || (tile == first && qt >= 8));
            const float ps = (BR == 1) ? 1.f : pscale;
            if (need_mask) {
                const int cmax = (t - 31) >> 4;
#pragma unroll
                for (int r = 0; r < 16; ++r) { const int k0i = kbase + crow(r, hi), k1i = k0i + 32; bool v0, v1;
                    if (BR == 0) { v0 = k0i <= cmax; v1 = k1i <= cmax; }
                    else if (BR == 1) { v0 = (k0i <= t); v1 = (k1i <= t); }
                    else { v0 = (k0i <= t) && (k0i > t - 512); v1 = (k1i <= t) && (k1i > t - 512); }
                    p0[r] = v0 ? __builtin_amdgcn_exp2f(p0[r]) * ps : 0.f; p1[r] = v1 ? __builtin_amdgcn_exp2f(p1[r]) * ps : 0.f; }
            } else {
#pragma unroll
                for (int r = 0; r < 16; ++r) { p0[r] = __builtin_amdgcn_exp2f(p0[r]) * ps; p1[r] = __builtin_amdgcn_exp2f(p1[r]) * ps; }
            }
            if (MODE != 1) { float sum = 0.f;
#pragma unroll
                for (int r = 0; r < 16; ++r) sum += p0[r] + p1[r];
                l_run += (BR == 1) ? (selbit ? sum : 0.f) : sum; }
            if (MODE == 1) {
#pragma unroll
                for (int h2 = 0; h2 < 2; ++h2)
#pragma unroll
                    for (int a = 0; a < 4; ++a) { const f32x16& pp = h2 ? p1 : p0; float gs = (pp[4 * a] + pp[4 * a + 1]) + (pp[4 * a + 2] + pp[4 * a + 3]), ls = pp[4 * a + 3];
                        gs += my_shfl_xor(gs, 1); gs += my_shfl_xor(gs, 2); ls += my_shfl_xor(ls, 1); ls += my_shfl_xor(ls, 2);
                        if ((lane & 3) == 0) { const int sidx = 16 * tile + 2 * a + hi + 8 * h2; atomicAdd((float*)(imp + sidx), gs); atomicAdd((float*)(imp + sidx + 1), ls); } }
#pragma unroll
                for (int r = 0; r < 16; ++r) { p0[r] *= gate; p1[r] *= gate; }
            }
            if (MODE != 0) {
                bf16x8 pa[4];
#pragma unroll
                for (int ks = 0; ks < 4; ++ks) { const f32x16& pp = (ks < 2) ? p0 : p1; const int b0 = 8 * (ks & 1); u32x4 w;
                    w.x = pg8::cvt_pk_bf16(pp[b0], pp[b0 + 1]); w.y = pg8::cvt_pk_bf16(pp[b0 + 2], pp[b0 + 3]); w.z = pg8::cvt_pk_bf16(pp[b0 + 4], pp[b0 + 5]); w.w = pg8::cvt_pk_bf16(pp[b0 + 6], pp[b0 + 7]);
                    if (BR == 1) { const unsigned msk = selbit ? 0xffffffffu : 0u; w.x &= msk; w.y &= msk; w.z &= msk; w.w &= msk; }
                    pa[ks] = __builtin_bit_cast(bf16x8, w); }
                bf16x8 vfr[2][4];
#define NSA_LDV(d_, slot_) do { _Pragma("unroll") for (int ks_ = 0; ks_ < 4; ++ks_) { \
                        const unsigned a0_ = off_b(16 * ks_ + 4 * hi + tq, 4 * (d_) + 2 * blk + (tp >> 1)) + 8 * (tp & 1); \
                        const unsigned a1_ = off_b(16 * ks_ + 8 + 4 * hi + tq, 4 * (d_) + 2 * blk + (tp >> 1)) + 8 * (tp & 1); \
                        const v4i16_t lo_ = __builtin_amdgcn_ds_read_tr16_b64_v4i16((LAS v4i16_t*)(vb + a0_)); \
                        const v4i16_t hv_ = __builtin_amdgcn_ds_read_tr16_b64_v4i16((LAS v4i16_t*)(vb + a1_)); \
                        vfr[slot_][ks_] = (bf16x8){lo_[0], lo_[1], lo_[2], lo_[3], hv_[0], hv_[1], hv_[2], hv_[3]}; } } while (0)
                NSA_LDV(0, 0);
                __builtin_amdgcn_sched_barrier(0);
#pragma unroll
                for (int d = 0; d < 4; ++d) {
                    if (d + 1 < 4) NSA_LDV(d + 1, (d + 1) & 1);
                    __builtin_amdgcn_sched_barrier(0);
#pragma unroll
                    for (int ks = 0; ks < 4; ++ks) o[d] = __builtin_amdgcn_mfma_f32_32x32x16_bf16(pa[ks], vfr[d & 1][ks], o[d], 0, 0, 0);
                    __builtin_amdgcn_sched_barrier(0);
                }
#undef NSA_LDV
            }
        }
        asm volatile("s_waitcnt vmcnt(0) lgkmcnt(0)" ::: "memory"); __builtin_amdgcn_s_barrier(); asm volatile("" ::: "memory");
    }
}

template <int BR>
__device__ __forceinline__ void run_tiles_stag(LAS unsigned char* lds, const bf16_t* Kb, const bf16_t* Vb, int ntiles, int first, int qt, const bf16x8 (&qf)[8], f32x16 (&o)[4], float& l_run,
                                               int t, unsigned selw0, unsigned selw1, unsigned selw2, unsigned selw3, int tid, int wave, int lane) {
    int wv_ = wave; asm volatile("" : "+s"(wv_)); const bool halfB = wv_ >= 4;
    LAS const int* TL = (LAS const int*)(lds + L_TL);
    const unsigned soff = (unsigned)((4 * wave + (lane >> 4)) * 128 + (((lane & 15) ^ (((lane >> 4) << 2) | (wave & 3))) * 8));
    auto tile_of = [&](int i) -> int { return (BR == 1) ? TL[i] : first + i; };
    auto stageK = [&](int tile, int buf) { const bf16_t* ks = Kb + (size_t)tile * 8192 + soff; LAS unsigned char* kd = lds + L_K0 + buf * 16384 + wave * 1024;
        __builtin_amdgcn_global_load_lds((const unsigned*)ks, (LAS unsigned*)kd, 16, 0, 0); __builtin_amdgcn_global_load_lds((const unsigned*)(ks + 4096), (LAS unsigned*)(kd + 8192), 16, 0, 0); };
    auto stageV = [&](int tile, int buf) { const bf16_t* vs = Vb + (size_t)tile * 8192 + soff; LAS unsigned char* vd = lds + L_V0 + buf * 16384 + wave * 1024;
        __builtin_amdgcn_global_load_lds((const unsigned*)vs, (LAS unsigned*)vd, 16, 0, 0); __builtin_amdgcn_global_load_lds((const unsigned*)(vs + 4096), (LAS unsigned*)(vd + 8192), 16, 0, 0); };
    if (ntiles <= 0) return;
    { const int t0_ = tile_of(0); stageK(t0_, 0); stageV(t0_, 0); }
    asm volatile("s_waitcnt vmcnt(0) lgkmcnt(0)" ::: "memory"); __builtin_amdgcn_s_barrier(); asm volatile("" ::: "memory");
    bf16x8 pa[4]; bool act = false;
#pragma unroll
    for (int ks = 0; ks < 4; ++ks) pa[ks] = (bf16x8){0, 0, 0, 0, 0, 0, 0, 0};
    auto qk_sm = [&](int tile, int buf) {
        bool selbit = true;
        if (BR == 1) { const unsigned w = (tile < 32) ? selw0 : (tile < 64) ? selw1 : (tile < 96) ? selw2 : selw3; selbit = (w >> (tile & 31)) & 1u; }
        act = (BR == 1) ? (bool)__any((int)selbit) : true;
        if (!act) return;
        int lv = lane; asm volatile("" : "+v"(lv));
        const int l32 = lv & 31, hi = lv >> 5; const unsigned kx = ((l32 & 3) << 2) | ((l32 >> 2) & 3);
        LAS const unsigned char* kb = lds + L_K0 + buf * 16384;
        const int kbase = tile * 64;
        const bool need_mask = (BR == 1) ? (tile == qt) : ((tile == qt) || (tile == first && qt >= 8));
        const float ps = (BR == 1) ? (selbit ? 1.f : 0.f) : 1.f;
        float sum = 0.f;
#pragma unroll
        for (int h2 = 0; h2 < 2; ++h2) {
            f32x16 pp;
#pragma unroll
            for (int r = 0; r < 16; ++r) pp[r] = 0.f;
            {
                bf16x8 kq[2];
#define NSA_LDK(s_, slot_) do { const unsigned ko_ = 256u * l32 + 16u * ((unsigned)(2 * (s_) + hi) ^ kx); kq[slot_] = *(LAS const bf16x8*)(kb + h2 * 8192 + ko_); } while (0)
                NSA_LDK(0, 0); NSA_LDK(1, 1);
                __builtin_amdgcn_sched_barrier(0);
#pragma unroll
                for (int s = 0; s < 8; s += 2) {
                    pp = __builtin_amdgcn_mfma_f32_32x32x16_bf16(kq[0], qf[s], pp, 0, 0, 0);
                    if (s + 2 < 8) NSA_LDK(s + 2, 0);
                    pp = __builtin_amdgcn_mfma_f32_32x32x16_bf16(kq[1], qf[s + 1], pp, 0, 0, 0);
                    if (s + 3 < 8) NSA_LDK(s + 3, 1);
                    __builtin_amdgcn_sched_barrier(0);
                }
#undef NSA_LDK
            }
            if (need_mask) {
#pragma unroll
                for (int r = 0; r < 16; ++r) { const int ki = kbase + 32 * h2 + crow(r, hi); bool v0;
                    if (BR == 1) v0 = (ki <= t); else v0 = (ki <= t) && (ki > t - 512);
                    pp[r] = v0 ? __builtin_amdgcn_exp2f(pp[r]) * ps : 0.f; }
            } else {
#pragma unroll
                for (int r = 0; r < 16; ++r) pp[r] = __builtin_amdgcn_exp2f(pp[r]) * ps;
            }
#pragma unroll
            for (int r = 0; r < 16; ++r) sum += pp[r];
#pragma unroll
            for (int kk = 0; kk < 2; ++kk) { const int b0 = 8 * kk; u32x4 w;
                w.x = pg8::cvt_pk_bf16(pp[b0], pp[b0 + 1]); w.y = pg8::cvt_pk_bf16(pp[b0 + 2], pp[b0 + 3]); w.z = pg8::cvt_pk_bf16(pp[b0 + 4], pp[b0 + 5]); w.w = pg8::cvt_pk_bf16(pp[b0 + 6], pp[b0 + 7]);
                pa[2 * h2 + kk] = __builtin_bit_cast(bf16x8, w); }
        }
        l_run += sum;
    };
    auto pv = [&](int buf) {
        int lv = lane; asm volatile("" : "+v"(lv));
        const int hi = lv >> 5, blk = (lv >> 4) & 1, tq = (lv & 15) >> 2, tp = lv & 3;
        LAS const unsigned char* vb = lds + L_V0 + buf * 16384;
        bf16x8 vfr[3];
#define NSA_LDV(j_, slot_) do { const int d_ = (j_) >> 2, ks_ = (j_) & 3; \
                const unsigned a0_ = off_b(16 * ks_ + 4 * hi + tq, 4 * d_ + 2 * blk + (tp >> 1)) + 8 * (tp & 1); \
                const unsigned a1_ = off_b(16 * ks_ + 8 + 4 * hi + tq, 4 * d_ + 2 * blk + (tp >> 1)) + 8 * (tp & 1); \
                const v4i16_t lo_ = __builtin_amdgcn_ds_read_tr16_b64_v4i16((LAS v4i16_t*)(vb + a0_)); \
                const v4i16_t hv_ = __builtin_amdgcn_ds_read_tr16_b64_v4i16((LAS v4i16_t*)(vb + a1_)); \
                vfr[slot_] = (bf16x8){lo_[0], lo_[1], lo_[2], lo_[3], hv_[0], hv_[1], hv_[2], hv_[3]}; } while (0)
        NSA_LDV(0, 0); NSA_LDV(1, 1);
        __builtin_amdgcn_sched_barrier(0);
#pragma unroll
        for (int j = 0; j < 16; ++j) {
            if (j + 2 < 16) NSA_LDV(j + 2, (j + 2) % 3);
            __builtin_amdgcn_sched_barrier(0);
            o[j >> 2] = __builtin_amdgcn_mfma_f32_32x32x16_bf16(pa[j & 3], vfr[j % 3], o[j >> 2], 0, 0, 0);
            __builtin_amdgcn_sched_barrier(0);
        }
#undef NSA_LDV
    };
#define NSA_SLOT_END() do { asm volatile("s_waitcnt vmcnt(0) lgkmcnt(0)" ::: "memory"); __builtin_amdgcn_s_barrier(); asm volatile("" ::: "memory"); } while (0)
    const int hsel = halfB ? 1 : 0;
    for (int sl = 0; sl <= 2 * ntiles; ++sl) {
        const int inext = (sl >> 1) + 1;
        const bool staged = inext < ntiles;
        if (staged) { const int tn = tile_of(inext); if (sl & 1) stageV(tn, inext & 1); else stageK(tn, inext & 1); }
        if ((sl & 1) == hsel) { const int i = (sl - hsel) >> 1; if (i < ntiles) qk_sm(tile_of(i), i & 1); }
        else { const int i = (sl - 1 - hsel) >> 1; if (sl - 1 - hsel >= 0 && i < ntiles && act) pv(i & 1); }
        if (staged) asm volatile("s_waitcnt vmcnt(2) lgkmcnt(0)" ::: "memory"); else asm volatile("s_waitcnt vmcnt(0) lgkmcnt(0)" ::: "memory");
        __builtin_amdgcn_s_barrier(); asm volatile("" ::: "memory");
    }
#undef NSA_SLOT_END
}

template <bool FIRST>
__device__ __forceinline__ void flush(f32x16 (&o)[4], float fac, bf16_t* Obase, LAS float* wsf, int l32, int hi) {
    if (hi == 0) wsf[l32] = fac;
    LDS_WAIT(); asm volatile("" ::: "memory");
    bf16_t* pa = Obase + (size_t)hi * DM + l32;
    unsigned short old[4][16];
    if (!FIRST) {
        bf16_t* pl = pa;
#pragma unroll
        for (int a = 0; a < 4; ++a) {
            asm volatile("" : "+v"(pl));
#pragma unroll
            for (int i2 = 0; i2 < 4; ++i2)
#pragma unroll
                for (int d = 0; d < 4; ++d) old[a][i2 * 4 + d] = pl[i2 * 128 + 32 * d];
            pl += 2 * DM; }
        asm volatile("" ::: "memory");
    }
#pragma unroll
    for (int a = 0; a < 4; ++a) { const f32x4 f = *(LAS const f32x4*)(wsf + 8 * a + 4 * hi);
        asm volatile("" : "+v"(pa));
#pragma unroll
        for (int i2 = 0; i2 < 4; ++i2)
#pragma unroll
            for (int d = 0; d < 4; ++d) { bf16_t* op = pa + i2 * 128 + 32 * d; float v = o[d][4 * a + i2] * f[i2]; if (!FIRST) v += bf2f(old[a][i2 * 4 + d]); *op = (bf16_t)f2bf(v); o[d][4 * a + i2] = 0.f; }
        pa += 2 * DM; }
    LDS_WAIT(); asm volatile("" ::: "memory");
}

__device__ __forceinline__ void unit(LAS unsigned char* lds, const bf16_t* KVH, const bf16_t* QH, const bf16_t* KCMP, const float* GATES, bf16_t* O, int b, int g, int qt, int tid, int wave, int lane) {
    asm volatile("" : "+v"(tid)); lane = tid & 63; wave = __builtin_amdgcn_readfirstlane(tid >> 6);
    const int l32 = lane & 31, hi = lane >> 5, tokl = l32 >> 2, rr = l32 & 3;
    const int t0 = qt * 64, t = t0 + wave * 8 + tokl;
    const size_t bg = (size_t)b * 4 + g;
    LAS float* impw = (LAS float*)(lds + L_IMP + wave * IMP_WAVE);
    LAS unsigned* selm = (LAS unsigned*)(lds + L_SELM + wave * 128);
    LAS unsigned* uni = (LAS unsigned*)(lds + L_UNI);
    LAS int* NTL = (LAS int*)(lds + L_NTL); LAS int* TL = (LAS int*)(lds + L_TL);
    LAS float* wsf = (LAS float*)(lds + L_WSF + wave * 128);
    for (int i = lane; i < 8 * IMP_LD; i += 64) impw[i] = 0.f;
    if (tid < 4) uni[tid] = 0u;
    bf16x8 qf[8];
    { const bf16_t* qp = QH + ((bg * 8192 + t0 + wave * 8) * 4 + l32) * 128 + 8 * hi;
#pragma unroll
      for (int s = 0; s < 8; ++s) qf[s] = *(const bf16x8*)(qp + 16 * s); }
    const float* gp = GATES + ((size_t)b * 8192 + t) * 48 + (g * 4 + rr) * 3;
    const float g_cmp = gp[0], g_slc = gp[1], g_win = gp[2];
    bf16_t* Obase = O + ((size_t)b * 8192 + t0 + wave * 8) * DM + g * 512;
    f32x16 o[4];
#pragma unroll
    for (int d = 0; d < 4; ++d)
#pragma unroll
        for (int r = 0; r < 16; ++r) o[d][r] = 0.f;
    LDS_WAIT(); __builtin_amdgcn_s_barrier(); asm volatile("" ::: "memory");
    const bf16_t* Kc = KCMP + bg * 512 * 128; const bf16_t* Vc = KCMP + (size_t)4096 * 128 + bg * 512 * 128;
    const int ntc = ((4 * qt + 2) >> 6) + 1;
    { float l = 0.f;
      run_tiles<0, 0>(lds, Kc, Vc, ntc, 0, qt, qf, o, l, t, 0u, 0u, 0u, 0u, 1.f, 1.f, tid, wave, lane);
      const float ltot = l + xhalf(l); const float inv = ltot > 0.f ? 1.f / ltot : 0.f;
      run_tiles<0, 1>(lds, Kc, Vc, ntc, 0, qt, qf, o, l, t, 0u, 0u, 0u, 0u, inv, g_cmp, tid, wave, lane); }
    flush<true>(o, 1.f, Obase, wsf, l32, hi);
    {
        const int tk = lane >> 3, j = lane & 7; const int nvalid = qt + 1;
        unsigned m0 = 0u, m1 = 0u, m2 = 0u, m3 = 0u;
        auto setbit = [&](int s) { const unsigned bit = 1u << (s & 31); const int w = s >> 5; m0 |= (w == 0) ? bit : 0u; m1 |= (w == 1) ? bit : 0u; m2 |= (w == 2) ? bit : 0u; m3 |= (w == 3) ? bit : 0u; };
        if (nvalid <= 16) { for (int s2 = 0; s2 < nvalid; ++s2) setbit(s2); }
        else {
            setbit(0); setbit(qt); setbit(qt - 1);
            unsigned key[16];
#pragma unroll
            for (int i = 0; i < 16; ++i) { const int s2 = 16 * j + i; const float v = impw[tk * IMP_LD + s2];
                const bool cand = (s2 < nvalid) && (s2 != 0) && (s2 != qt) && (s2 != qt - 1);
                key[i] = cand ? ((__float_as_uint(fmaxf(v, 0.f)) & ~0x7Fu) + (unsigned)(128 - s2)) : 0u; }
            for (int round = 0; round < 13; ++round) {
                unsigned mx = key[0];
#pragma unroll
                for (int i = 1; i < 16; ++i) mx = mx > key[i] ? mx : key[i];
                unsigned o1 = (unsigned)my_shfl_xor((int)mx, 1); mx = mx > o1 ? mx : o1;
                o1 = (unsigned)my_shfl_xor((int)mx, 2); mx = mx > o1 ? mx : o1;
                o1 = (unsigned)my_shfl_xor((int)mx, 4); mx = mx > o1 ? mx : o1;
                if (mx != 0u) { const int sw = (128 - (int)(mx & 0x7Fu)) & 127; setbit(sw); }
#pragma unroll
                for (int i = 0; i < 16; ++i) key[i] = (key[i] == mx) ? 0u : key[i];
            }
        }
        if (j == 0) { selm[tk * 4 + 0] = m0; selm[tk * 4 + 1] = m1; selm[tk * 4 + 2] = m2; selm[tk * 4 + 3] = m3;
            atomicOr((unsigned*)(uni + 0), m0); atomicOr((unsigned*)(uni + 1), m1); atomicOr((unsigned*)(uni + 2), m2); atomicOr((unsigned*)(uni + 3), m3); }
    }
    LDS_WAIT(); __builtin_amdgcn_s_barrier(); asm volatile("" ::: "memory");
    if (tid == 0) { int n = 0; for (int w = 0; w < 4; ++w) { unsigned u = uni[w]; while (u) { const int bpos = __builtin_ctz(u); u &= u - 1; TL[n++] = 32 * w + bpos; } } NTL[0] = n; }
    LDS_WAIT(); __builtin_amdgcn_s_barrier(); asm volatile("" ::: "memory");
    const unsigned sw0 = selm[tokl * 4 + 0], sw1 = selm[tokl * 4 + 1], sw2 = selm[tokl * 4 + 2], sw3 = selm[tokl * 4 + 3];
    const int nsel = __builtin_amdgcn_readfirstlane(NTL[0]);
    { const bf16_t* Ks = KVH + 2 * KVH_SLOT + bg * 8192 * 128; const bf16_t* Vs = KVH + 3 * KVH_SLOT + bg * 8192 * 128;
      float l = 0.f;
      run_tiles<1, 2>(lds, Ks, Vs, nsel, 0, qt, qf, o, l, t, sw0, sw1, sw2, sw3, 1.f, 1.f, tid, wave, lane);
      const float ltot = l + xhalf(l);
      flush<false>(o, ltot > 0.f ? g_slc / ltot : 0.f, Obase, wsf, l32, hi); }
    { const bf16_t* Kw = KVH + 4 * KVH_SLOT + bg * 8192 * 128; const bf16_t* Vw = KVH + 5 * KVH_SLOT + bg * 8192 * 128;
      const int first = qt >= 8 ? qt - 8 : 0; float l = 0.f;
      run_tiles<2, 2>(lds, Kw, Vw, qt - first + 1, first, qt, qf, o, l, t, 0u, 0u, 0u, 0u, 1.f, 1.f, tid, wave, lane);
      const float ltot = l + xhalf(l);
      flush<false>(o, ltot > 0.f ? g_win / ltot : 0.f, Obase, wsf, l32, hi); }
    LDS_WAIT(); __builtin_amdgcn_s_barrier(); asm volatile("" ::: "memory");
}
}


constexpr size_t WS_CTL = WS_MISC + 63 * MiB; constexpr size_t CTL_ZERO_BYTES = 16384;
#define XB_TMO      128
#define XB_XCNT(j)  (256  + 64 * (j))
#define XB_XSUB(j)  (1280 + 64 * (j))
#define XB_XGEN(j)  (2304 + 64 * (j))
#define XB_TOP      3328
#define XB_TOPGEN   3392
#define XB_SPIN_CAP (1u << 18)
__device__ __forceinline__ unsigned xb_ld(unsigned* p)              { return __hip_atomic_load(p, __ATOMIC_RELAXED, __HIP_MEMORY_SCOPE_AGENT); }
__device__ __forceinline__ unsigned xb_add(unsigned* p, unsigned v) { return __hip_atomic_fetch_add(p, v, __ATOMIC_RELAXED, __HIP_MEMORY_SCOPE_AGENT); }
__device__ __forceinline__ unsigned xb_xcc_id() { return (unsigned)__builtin_amdgcn_s_getreg((3 << 11) | 20) & 0xFu; }
#define XB_SPIN(cond, bar) do { unsigned _sp = 0; while (cond) { __builtin_amdgcn_s_sleep(1); \
    if ((++_sp & 255u) == 0u) { if (xb_ld(&(bar)[XB_TMO])) break; if (_sp > XB_SPIN_CAP) { atomicAdd(&(bar)[XB_TMO], 1u); break; } } } } while (0)
struct XcdBarrier { unsigned* bar; unsigned x; volatile LAS unsigned* st; };
__device__ __forceinline__ XcdBarrier xcd_barrier_post(unsigned* bar, volatile LAS unsigned* st, bool t0) {
    XcdBarrier b; b.bar = bar; b.x = xb_xcc_id(); b.st = st;
    if (t0) (void)xb_add(&bar[XB_XCNT(b.x)], 1u);
    return b;
}
__device__ __forceinline__ void xcd_barrier_complete(unsigned* bar, unsigned x, unsigned& nloc, unsigned& nx) {
    const unsigned G = gridDim.x * gridDim.y * gridDim.z;
    unsigned sum, cnt, mine, sp = 0u;
    for (;;) {
        sum = 0u; cnt = 0u; mine = 0u;
#pragma unroll
        for (unsigned j = 0; j < 16; ++j) { const unsigned c = xb_ld(&bar[XB_XCNT(j)]); sum += c; cnt += (c > 0u) ? 1u : 0u; mine = (j == x) ? c : mine; }
        if (sum == G) break;
        __builtin_amdgcn_s_sleep(1);
        if ((++sp & 255u) == 0u) { if (xb_ld(&bar[XB_TMO])) break; if (sp > XB_SPIN_CAP) { atomicAdd(&bar[XB_TMO], 1u); break; } }
    }
    nloc = mine > 0u ? mine : 1u; nx = cnt > 0u ? cnt : 1u;
}
__device__ __forceinline__ void xcd_barrier(const XcdBarrier& b, bool t0) {
    asm volatile("s_waitcnt vmcnt(0)" ::: "memory");
    __syncthreads();
    if (t0) {
        unsigned* bar = b.bar;
        __builtin_amdgcn_s_waitcnt(0);
        unsigned nloc = b.st[0], nx = b.st[1];
        if (nloc == 0u) { xcd_barrier_complete(bar, b.x, nloc, nx); b.st[0] = nloc; b.st[1] = nx; }
        const unsigned old = xb_add(&bar[XB_XSUB(b.x)], 1u);
        const unsigned gen = old / nloc;
        if (old + 1u == (gen + 1u) * nloc) {
            __builtin_amdgcn_fence(__ATOMIC_RELEASE, "agent");
            asm volatile("s_waitcnt vmcnt(0)" ::: "memory");
            const unsigned og = xb_add(&bar[XB_TOP], 1u);
            const unsigned tg = og / nx;
            if (og + 1u == (tg + 1u) * nx) xb_add(&bar[XB_TOPGEN], 1u);
            else XB_SPIN(xb_ld(&bar[XB_TOPGEN]) == tg, bar);
            __builtin_amdgcn_fence(__ATOMIC_ACQUIRE, "agent");
            xb_add(&bar[XB_XGEN(b.x)], 1u);
            asm volatile("s_waitcnt vmcnt(0)" ::: "memory");
        } else {
            XB_SPIN(xb_ld(&bar[XB_XGEN(b.x)]) == gen, bar);
            __builtin_amdgcn_fence(__ATOMIC_ACQUIRE, "agent");
            asm volatile("s_waitcnt vmcnt(0)" ::: "memory");
        }
    }
    __syncthreads();
}

__global__ void __launch_bounds__(NTHREADS, 2) fwd_kernel(Args args) {
    extern __shared__ __attribute__((aligned(16))) unsigned char lds_raw[];
    LAS unsigned char* lds = (LAS unsigned char*)lds_raw;
    cg::grid_group grid = cg::this_grid();
    const int G = gridDim.x;
    const int NGW = G * NWAVES, gthreads = G * NTHREADS;
#define bid ({ int b_ = (int)blockIdx.x; asm volatile("" : "+s"(b_)); b_; })
    const int wave0 = __builtin_amdgcn_readfirstlane((int)threadIdx.x >> 6);
#define lane ({ int l_; asm volatile("v_mbcnt_lo_u32_b32 %0, -1, 0\n\tv_mbcnt_hi_u32_b32 %0, -1, %0" : "=v"(l_)); l_; })
#define wave wave0
#define tid (wave0 * 64 + lane)
#define gw (bid * NWAVES + wave)
#define gtid (bid * NTHREADS + tid)
#define ws ((unsigned char*)argp(30))
#define XF ((float*)argp(29))
#define XB ((bf16_t*)(ws + WS_XB))
#define HID ((bf16_t*)(ws + OV_HID))
#define ln_g INP(I_LNG)
#define ln_b INP(I_LNB)
#define T1 ((bf16_t*)(ws + OV_T1))
#define T2 ((bf16_t*)(ws + OV_T2))
#define T3 ((bf16_t*)(ws + OV_T3))
#define STP ((f32x2*)(ws + MS_STATS))
#define GSYNC_CG() do { asm volatile("s_waitcnt vmcnt(0) lgkmcnt(0)" ::: "memory"); grid.sync(); asm volatile("s_waitcnt vmcnt(0) lgkmcnt(0)" ::: "memory"); __builtin_amdgcn_s_barrier(); asm volatile("" ::: "memory"); } while (0)
#define GSYNC() do { asm volatile("s_waitcnt vmcnt(0) lgkmcnt(0)" ::: "memory"); XcdBarrier xb_; xb_.bar = (unsigned*)(ws + WS_CTL); xb_.x = xb_xcc_id(); xb_.st = (volatile LAS unsigned*)(lds + LDS_BYTES - 64); xcd_barrier(xb_, tid == 0); asm volatile("" ::: "memory"); } while (0)
    volatile LAS unsigned* xst = (volatile LAS unsigned*)(lds + LDS_BYTES - 64);
    if (tid == 0) { xst[0] = 0u; xst[1] = 0u; }
    __syncthreads();
    (void)xcd_barrier_post((unsigned*)(ws + WS_CTL), xst, tid == 0);

    {
        LAS float* scr = (LAS float*)(lds + wave * 16384);
        conv_matrix<0>(INP(I_S5_WIN), 2048, 2048, 2048, (bf16_t*)(ws + WS_WIN), 2048, 0, scr, gw, NGW, lane);
        conv_matrix<1>(INP(I_S5_WGLU), 2048, 4096, 4096, (bf16_t*)(ws + WS_WGLU), 2048, 0, scr, gw, NGW, lane);
        conv_matrix<0>(INP(I_S5_WOUT), 2048, 2048, 2048, (bf16_t*)(ws + WS_WOUT), 2048, 0, scr, gw, NGW, lane);
        conv_matrix<0>(INP(I_KVW), 2048, 3072, 3072, (bf16_t*)(ws + WS_WKVQ), 2048, 0, scr, gw, NGW, lane);
        conv_matrix<0>(INP(I_WQG), 2048, 2096, 2048, (bf16_t*)(ws + WS_WKVQ), 2048, 3072, scr, gw, NGW, lane);
        conv_matrix<0>(INP(I_WQG) + 2048, 2048, 2096, 48, (bf16_t*)(ws + WS_WKVQ), 2048, 5120, scr, gw, NGW, lane);
        conv_matrix<0>(INP(I_WNO), 2048, 2048, 2048, (bf16_t*)(ws + WS_WNO), 2048, 0, scr, gw, NGW, lane);
        for (int l = 0; l < 2; ++l) {
            cvt_rows(INP(I_MWQ) + (size_t)l * 2048 * 2048, (bf16_t*)(ws + WS_WMQ + l * 8 * MiB), (size_t)2048 * 2048, gtid, gthreads);
            conv_matrix<0>(INP(I_MWKV) + (size_t)l * 2048 * 4096, 2048, 4096, 4096, (bf16_t*)(ws + WS_WMKV + l * 16 * MiB), 2048, 0, scr, gw, NGW, lane);
            conv_matrix<0>(INP(I_MWO) + (size_t)l * 2048 * 2048, 2048, 2048, 2048, (bf16_t*)(ws + WS_WMO + l * 8 * MiB), 2048, 0, scr, gw, NGW, lane);
            conv_matrix<0>(INP(I_WUP) + (size_t)l * 2048 * 8192, 2048, 8192, 8192, (bf16_t*)(ws + WS_WUP + l * 32 * MiB), 2048, 0, scr, gw, NGW, lane);
            conv_matrix<0>(INP(I_WDN) + (size_t)l * 8192 * 2048, 8192, 2048, 2048, (bf16_t*)(ws + WS_WDN + l * 32 * MiB), 8192, 0, scr, gw, NGW, lane);
        }
        cvt_rows(INP(I_X), XB, (size_t)MTOK * DM, gtid, gthreads);
        cvt_rows(INP(I_MEM), (bf16_t*)(ws + MS_MEMB), (size_t)512 * DM, gtid, gthreads);
        for (int q = 0; q < 4; ++q) { const int which = q >> 1, half = q & 1;
            conv_matrix<0>((which ? INP(I_CW1V) : INP(I_CW1K)) + (size_t)half * 2048 * 128, 2048, 128, 128, (bf16_t*)(ws + WS_WC1 + which * MiB), 2048, 128 * half, scr, gw, NGW, lane); }
        if (bid == G - 1) cmp_bias(INP(I_CPK), INP(I_CW1K), INP(I_CPV), INP(I_CW1V), (float*)(ws + MS_CB), tid);
        s5_tables(INP(I_S5_ARE), INP(I_S5_AIM), INP(I_S5_LOGDT), INP(I_S5_BRE), INP(I_S5_BIM), INP(I_S5_CRE), INP(I_S5_CIM), ws, gtid, gthreads);
    }
    GSYNC_CG();
    for (int layer = 0; layer < 2; ++layer) {

        if (layer == 0) {
            { pg8::Gemm g{XB, (const bf16_t*)(ws + WS_WIN), DM, DM, DM}; pg8::StaticOrder S; S.init(MTOK, DM, DM, DM, G, bid);
              pg8::EpiCols8<StoreBf16> E{StoreBf16{T1, DM, 1.f}}; pg8::gemm_phase(lds, g, S, E, wave0); }
            { pg8::Gemm g{(const bf16_t*)(ws + MS_MEMB), (const bf16_t*)(ws + WS_WMKV), DM, DM, DM}; KvSched S{G, bid};
              pg8::EpiCols8<StoreBf16Z> E{StoreBf16Z{(bf16_t*)(ws + MS_MKV), 4096, 1.f, (size_t)512 * 4096}}; pg8::gemm_phase(lds, g, S, E, wave0); }
            GSYNC();
            s5_pass<false>(T1, T2, INP(I_S5_D), ws, lds, gw, NGW, wave, lane);
            GSYNC();
            s5_pass<true>(T1, T2, INP(I_S5_D), ws, lds, gw, NGW, wave, lane);
            GSYNC();
            { pg8::Gemm g{T2, (const bf16_t*)(ws + WS_WGLU), DM, DM, DM}; pg8::StaticOrder S; S.init(MTOK, 2 * DM, DM, DM, G, bid);
              EpiGlu E{T1, DM}; pg8::gemm_phase(lds, g, S, E, wave0); }
            { pg8::Gemm g{(const bf16_t*)(ws + MS_MKV), (const bf16_t*)(ws + WS_WMQ), 4096, 2048, 512}; MtSched S{G, bid};
              pg8::EpiCols8<StoreBf16Z> E{StoreBf16Z{(bf16_t*)(ws + WS_MT), 2048, 0.044194173824159216f * 1.4426950408889634f, (size_t)1024 * 2048}}; pg8::gemm_phase(lds, g, S, E, wave0); }
            { pg8::Gemm g{(const bf16_t*)(ws + WS_WMO), (const bf16_t*)(ws + MS_MKV), 2048, 4096, 512}; VwSched S{G, (G == 256) ? ((bid + 128) & 255) : bid};
              pg8::EpiCols8<StoreBf16Z> E{StoreBf16Z{(bf16_t*)(ws + WS_VWT), 1024, 1.f, (size_t)2048 * 1024}}; pg8::gemm_phase(lds, g, S, E, wave0); }
            GSYNC();
            { pg8::Gemm g{T1, (const bf16_t*)(ws + WS_WOUT), DM, DM, DM}; pg8::StaticOrder S; S.init(MTOK, DM, DM, DM, G, bid);
              pg8::EpiRes<0> E{INP(I_X), XF, nullptr, nullptr, nullptr, DM, DN_ALPHA}; pg8::gemm_phase(lds, g, S, E, wave0); }
            GSYNC();
            ln_phase<false>(XF, 1.f, XF, XB, STP, ln_g + (layer * 3 + 0) * DM, ln_b + (layer * 3 + 0) * DM, gw, NGW, lane);
        } else {
            { pg8::Gemm g{XB, (const bf16_t*)(ws + WS_WKVQ), DM, DM, DM}; pg8::StaticOrder S; S.init(MTOK, 5376, DM, DM, G, bid);
              pg8::EpiCols8<StoreKVQ> E{StoreKVQ{(bf16_t*)(ws + OV_KVH), (bf16_t*)(ws + OV_QH), (float*)(ws + MS_GATES), 0.08838834764831845f * 1.4426950408889634f}}; pg8::gemm_phase(lds, g, S, E, wave0); }
            GSYNC();
            { pg8::Gemm g{(const bf16_t*)(ws + OV_KVH), (const bf16_t*)(ws + WS_WC1), 2048, 2048, 512}; CmpSched S{G, bid};
              pg8::EpiCols8<StoreF32> E{StoreF32{(float*)(ws + MS_PAB), 256, (size_t)4096 * 256}}; pg8::gemm_phase(lds, g, S, E, wave0); }
            GSYNC();
            cmp_combine((const float*)(ws + MS_PAB), (const float*)(ws + MS_CB), INP(I_CW2K), INP(I_CW2V), (bf16_t*)(ws + MS_KCMP), gw, NGW, lane);
            GSYNC();
            for (int vb = bid; vb < 256; vb += G) {
                const int bgi = vb >> 5, sidx = vb & 31;
                for (int i = 0; i < 4; ++i) { const int qt = (i == 0) ? sidx : (i == 1) ? 63 - sidx : (i == 2) ? 64 + sidx : 127 - sidx;
                    nsa::unit(lds, (const bf16_t*)(ws + OV_KVH), (const bf16_t*)(ws + OV_QH), (const bf16_t*)(ws + MS_KCMP), (const float*)(ws + MS_GATES), T1, bgi >> 2, bgi & 3, qt, tid, wave, lane); }
            }
            GSYNC();
            { pg8::Gemm g{T1, (const bf16_t*)(ws + WS_WNO), DM, DM, DM}; pg8::StaticOrder S; S.init(MTOK, DM, DM, DM, G, bid);
              pg8::EpiRes<1> E{XF, XF, STP, ln_g + 2 * DM, ln_b + 2 * DM, DM, DN_ALPHA}; pg8::gemm_phase(lds, g, S, E, wave0); }
            GSYNC();
            ln_phase<false>(XF, 1.f, XF, XB, STP, ln_g + (layer * 3 + 0) * DM, ln_b + (layer * 3 + 0) * DM, gw, NGW, lane);
        }
        GSYNC();
        for (int base = 0; base < 256; base += G) {
            pg8::Gemm g{XB, (const bf16_t*)(ws + WS_MT), DM, DM, DM}; ScoreSched S{G, bid, base, (base + G < 256) ? base + G : 256, layer};
            EpiSoftmax E{T2}; pg8::gemm_phase(lds, g, S, E, wave0);
        }
        GSYNC();
        { pg8::Gemm g{T2, (const bf16_t*)(ws + WS_VWT), 1024, 1024, 1024}; PvoSched S; S.so.init(MTOK, DM, 1024, 1024, G, bid); S.layer = layer;
          pg8::EpiRes<1> E{XF, XF, STP, ln_g + (layer * 3 + 0) * DM, ln_b + (layer * 3 + 0) * DM, DM, DN_ALPHA}; pg8::gemm_phase(lds, g, S, E, wave0); }
        GSYNC();
        ln_phase<false>(XF, 1.f, XF, XB, STP, ln_g + (layer * 3 + 1) * DM, ln_b + (layer * 3 + 1) * DM, gw, NGW, lane);
        GSYNC();
        {
            pg8::Gemm g{XB, (const bf16_t*)(ws + WS_WUP + layer * 32 * MiB), DM, DM, DM};
            pg8::StaticOrder S; S.init(MTOK, DFF, DM, DM, G, bid);
            pg8::EpiCols8<StoreRelu2> E{StoreRelu2{HID, DFF}};
            pg8::gemm_phase(lds, g, S, E, wave0);
        }
        GSYNC();
        {
            pg8::Gemm g{HID, (const bf16_t*)(ws + WS_WDN + layer * 32 * MiB), DFF, DFF, DFF};
            pg8::StaticOrder S; S.init(MTOK, DM, DFF, DFF, G, bid);
            pg8::EpiRes<1> E{XF, XF, STP, ln_g + (layer * 3 + 1) * DM, ln_b + (layer * 3 + 1) * DM, DM, DN_ALPHA};
            pg8::gemm_phase(lds, g, S, E, wave0);
        }
        GSYNC();
        if (layer == 1) ln_phase<true>(XF, 1.f, XF, XB, STP, ln_g + (layer * 3 + 2) * DM, ln_b + (layer * 3 + 2) * DM, gw, NGW, lane);
        else ln_phase<false>(XF, 1.f, XF, XB, STP, ln_g + (layer * 3 + 2) * DM, ln_b + (layer * 3 + 2) * DM, gw, NGW, lane);
        if (layer == 0) GSYNC();
    }
}

#undef ws
#undef XF
#undef XB
#undef HID
#undef ln_g
#undef ln_b
#undef T1
#undef T2
#undef T3
#undef STP
#undef bid
#undef tid
#undef lane
#undef wave
#undef gw
#undef gtid
extern "C" void kernel_launch(void* const* d_in, const int* in_sizes, int n_in, void* d_out, int out_size, void* d_ws, size_t ws_size, hipStream_t stream) {
    static int grid = 0;
    if (grid == 0) {
        if (n_in != 29 || ws_size < WS_END) { fprintf(stderr, "kernel_launch: unexpected n_in %d or ws %zu (< %zu)\n", n_in, ws_size, (size_t)WS_END); grid = -1; return; }
        int dev = 0, cus = 0, per_cu = 0;
        hipGetDevice(&dev); hipDeviceGetAttribute(&cus, hipDeviceAttributeMultiprocessorCount, dev);
        hipFuncSetAttribute((const void*)fwd_kernel, hipFuncAttributeMaxDynamicSharedMemorySize, LDS_BYTES);
        hipOccupancyMaxActiveBlocksPerMultiprocessor(&per_cu, (const void*)fwd_kernel, NTHREADS, LDS_BYTES);
        if (per_cu < 1) { fprintf(stderr, "kernel_launch: occupancy query says %d blocks/CU\n", per_cu); per_cu = 1; }
        (void)hipGetLastError();
        grid = cus;
    }
    if (grid < 0) return;
    if (hipMemsetAsync((char*)d_ws + WS_CTL, 0, CTL_ZERO_BYTES, stream) != hipSuccess) { fprintf(stderr, "kernel_launch: memset of the barrier words failed\n"); return; }
    Args a{};
    for (int i = 0; i < 29; ++i) a.in[i] = (const float*)d_in[i];
    a.out = (float*)d_out; a.ws = (unsigned char*)d_ws; a.ph_lo = 0; a.ph_hi = 100;
    void* kargs[] = {&a};
    hipError_t e = hipLaunchCooperativeKernel((const void*)fwd_kernel, dim3(grid), dim3(NTHREADS), kargs, LDS_BYTES, stream);
    if (e != hipSuccess) fprintf(stderr, "cooperative launch failed: %s (grid %d)\n", hipGetErrorString(e), grid);
}
```

```cpp
#include <hip/hip_runtime.h>
#include <hip/hip_cooperative_groups.h>
#include <cstdio>
#include <cstdint>
namespace cg = cooperative_groups;

#define LAS __attribute__((address_space(3)))
typedef unsigned short bf16_t;
typedef short bf16x8 __attribute__((ext_vector_type(8)));
typedef float f32x4 __attribute__((ext_vector_type(4)));
typedef float f32x2 __attribute__((ext_vector_type(2)));
typedef float f32x16 __attribute__((ext_vector_type(16)));
typedef unsigned u32x4 __attribute__((ext_vector_type(4)));
typedef unsigned u32x2 __attribute__((ext_vector_type(2)));

constexpr int SEQ = 8192, BATCH = 2, DM = 2048, MTOK = BATCH * SEQ, DFF = 8192;
constexpr float LN_EPS = 1e-5f;
constexpr float DN_ALPHA = 1.4142135623730951f;
constexpr int NWAVES = 8, NTHREADS = 512;
constexpr int LDS_BYTES = 147456;

constexpr size_t MiB = 1u << 20;
constexpr size_t WS_WIN = 0;
constexpr size_t WS_WGLU = WS_WIN + 8 * MiB;
constexpr size_t WS_WOUT = WS_WGLU + 16 * MiB;
constexpr size_t WS_WKVQ = WS_WOUT + 8 * MiB;
constexpr size_t WS_WNO = WS_WKVQ + 22 * MiB;
constexpr size_t WS_WMQ = WS_WNO + 8 * MiB;
constexpr size_t WS_WMKV = WS_WMQ + 16 * MiB;
constexpr size_t WS_WMO = WS_WMKV + 32 * MiB;
constexpr size_t WS_WUP = WS_WMO + 16 * MiB;
constexpr size_t WS_WDN = WS_WUP + 64 * MiB;
constexpr size_t WS_WC1 = WS_WDN + 64 * MiB;
constexpr size_t WS_XB = WS_WC1 + 2 * MiB;
constexpr size_t WS_OVL = WS_XB + 64 * MiB;
constexpr size_t WS_MISC = WS_OVL + 256 * MiB;
constexpr size_t WS_END = WS_MISC + 64 * MiB;
constexpr size_t OV_T1 = WS_OVL;
constexpr size_t OV_T2 = WS_OVL + 64 * MiB;
constexpr size_t OV_T3 = WS_OVL + 128 * MiB;
constexpr size_t OV_KV = WS_OVL + 128 * MiB;
constexpr size_t OV_HID = WS_OVL;
constexpr size_t MS_MEMB = WS_MISC;
constexpr size_t MS_MKV = WS_MISC + 2 * MiB;
constexpr size_t MS_MK = WS_MISC + 2 * MiB;
constexpr size_t MS_MVT = WS_MISC + 6 * MiB;
constexpr size_t MS_S5AB = WS_MISC + 10 * MiB;
constexpr size_t MS_S5ABL = MS_S5AB + 65536;
constexpr size_t MS_S5BM = MS_S5ABL + 65536;
constexpr size_t MS_S5CM = MS_S5BM + 524288;
constexpr size_t MS_S5E = MS_S5CM + 524288;
constexpr size_t MS_S5SIN = MS_S5E + 1048576;
constexpr int S5_NCH = 8, S5_LC = SEQ / S5_NCH;
constexpr size_t MS_STATS = WS_MISC + 14 * MiB;
constexpr size_t WS_MT = WS_MISC + 22 * MiB;
constexpr size_t WS_VWT = WS_MISC + 38 * MiB;
constexpr size_t MS_GATES = WS_MISC + 16 * MiB;
constexpr size_t MS_CB = WS_MISC + 20 * MiB;
constexpr size_t MS_PAB = OV_T1;
constexpr size_t MS_KCMP = WS_MISC + 54 * MiB;
constexpr size_t OV_KVH = WS_OVL + 64 * MiB;
constexpr size_t OV_QH = WS_OVL + 160 * MiB;
constexpr size_t KVH_SLOT = (size_t)2 * 4 * 8192 * 128;

__device__ __forceinline__ unsigned f2bf(float f) { unsigned u = __builtin_bit_cast(unsigned, f); return (u + 0x7fffu + ((u >> 16) & 1u)) >> 16; }
__device__ __forceinline__ unsigned pk2(float lo, float hi) { unsigned r; asm volatile("v_cvt_pk_bf16_f32 %0, %1, %2" : "=v"(r) : "v"(lo), "v"(hi)); return r; }
__device__ __forceinline__ float bf2f(unsigned short h) { return __builtin_bit_cast(float, (unsigned)h << 16); }

__device__ __forceinline__ int lane_now() { int l_; asm volatile("v_mbcnt_lo_u32_b32 %0, -1, 0\n\tv_mbcnt_hi_u32_b32 %0, -1, %0" : "=v"(l_)); return l_; }
__device__ __forceinline__ float my_shfl_xor(float v, int o) { return __builtin_bit_cast(float, __builtin_amdgcn_ds_bpermute((lane_now() ^ o) << 2, __builtin_bit_cast(int, v))); }
__device__ __forceinline__ int my_shfl_xor(int v, int o) { return __builtin_amdgcn_ds_bpermute((lane_now() ^ o) << 2, v); }
__device__ __forceinline__ float my_shfl(float v, int src) { return __builtin_bit_cast(float, __builtin_amdgcn_ds_bpermute(src << 2, __builtin_bit_cast(int, v))); }
__device__ __forceinline__ float wave_sum(float v) {
#pragma unroll
    for (int o = 1; o < 64; o <<= 1) v += my_shfl_xor(v, o);
    return v;
}
#define LDS_WAIT() asm volatile("s_waitcnt lgkmcnt(0)" ::: "memory")

namespace pg8 {
constexpr int BM = 256, BK = 64, HALF = 128, HTB = HALF * BK * 2, STAGE_BYTES = 8 * HTB, NXCD = 8, WGM = 8;
__host__ __device__ __forceinline__ int lds_byte(int r, int c) { const int st = (r >> 4) * 2 + (c >> 5), rr = r & 15, cc = c & 31, ob = rr * 64 + cc * 2; return st * 1024 + (ob ^ (((ob >> 9) & 1) << 5)); }
__host__ __device__ __forceinline__ void stage_rc(int b, int& R, int& C) { const int st = b / 1024, sb = b % 1024, swz = sb ^ (((sb >> 9) & 1) << 5); R = (st >> 1) * 16 + swz / 64; C = (st & 1) * 32 + (swz % 64) / 2; }
__host__ __device__ __forceinline__ int perm32(int rho) { const int n = rho >> 4, i = rho & 15; return 8 * (i >> 2) + 4 * n + (i & 3); }

struct Unit { int pm, pn, z; unsigned ao, bo; };
struct Gemm { const bf16_t* A; const bf16_t* Bt; int lda, ldb, K; };

struct StaticOrder {
    int nM, nN, nwg, G, c; unsigned ta, tb;
    __device__ void init(int M, int N, int lda, int ldb, int G_, int c_) { nM = M / BM; nN = N / BM; nwg = nM * nN; G = G_; c = c_; ta = (unsigned)BM * lda * 2; tb = (unsigned)BM * ldb * 2; }
    __device__ bool next(int i, Unit& u) const {
        const long L = (long)i * G + c; if (L >= nwg) return false;
        int wgid = (int)L; { const int q = nwg / NXCD, r = nwg % NXCD, xcd = wgid % NXCD, off = wgid / NXCD; wgid = (xcd < r ? xcd * (q + 1) : r * (q + 1) + (xcd - r) * q) + off; }
        const int nig = WGM * nN, gid = wgid / nig, fm = gid * WGM, gsz = (nM - fm) < WGM ? (nM - fm) : WGM;
        u.pm = fm + ((wgid % nig) % gsz); u.pn = (wgid % nig) / gsz; u.z = 0; u.ao = (unsigned)u.pm * ta; u.bo = (unsigned)u.pn * tb; return true;
    }
};

__device__ __forceinline__ unsigned cvt_pk_bf16(float lo, float hi) { unsigned r; asm volatile("v_cvt_pk_bf16_f32 %0, %1, %2" : "=v"(r) : "v"(lo), "v"(hi)); return r; }


template <class Epi, class Sched>
__device__ __forceinline__ void gemm_phase(LAS unsigned char* lds, const Gemm g, const Sched& S, const Epi& E, int wv) {
    int tid; asm volatile("v_mbcnt_lo_u32_b32 %0, -1, 0\n\tv_mbcnt_hi_u32_b32 %0, -1, %0" : "=v"(tid)); tid += wv * 64;
    const int wid = __builtin_amdgcn_readfirstlane(tid >> 6), lane = tid & 63, wr = wid >> 2, wc = wid & 3, fr = lane & 15, fq = lane >> 4;
    int nt = g.K / BK; asm volatile("" : "+s"(nt));
    unsigned voffA[2], voffB[2];
#pragma unroll
    for (int i = 0; i < 2; ++i) { int R, C; stage_rc(tid * 16 + i * 8192, R, C); const int Rb = Epi::PERM ? ((R & ~31) + perm32(R & 31)) : R;
        voffA[i] = (unsigned)(R * g.lda + C) * 2u; voffB[i] = (unsigned)(Rb * g.ldb + C) * 2u; }
    const size_t kstep = (size_t)(BK * 2);
    const size_t hsA = (size_t)HALF * g.lda * 2, hsB = (size_t)HALF * g.ldb * 2;
    const unsigned ldsw = (unsigned)wid * 1024u;
    const int aoff = lds_byte(wr * 64 + fr, fq * 8), boff = lds_byte(wc * 32 + fr, fq * 8);
#define PG8_SA(b, h) (((b) * 2 + (h)) * HTB)
#define PG8_SB(b, h) ((4 + (b) * 2 + (h)) * HTB)
#define PG8_STAGE(bufoff, gbase, voff) do { _Pragma("unroll") for (int _i = 0; _i < 2; ++_i) \
        __builtin_amdgcn_global_load_lds((const unsigned*)((const char*)(gbase) + (voff)[_i]), (LAS unsigned*)(lds + (bufoff) + ldsw + _i * 8192), 16, 0, 0); } while (0)
#define PG8_LDA(dst, b, h) do { _Pragma("unroll") for (int m = 0; m < 4; ++m) _Pragma("unroll") for (int k = 0; k < 2; ++k) dst[m][k] = *(const LAS bf16x8*)(lds + PG8_SA(b, h) + aoff + m * 2048 + k * 1024); } while (0)
#define PG8_LDB(dst, b, h) do { _Pragma("unroll") for (int n = 0; n < 2; ++n) _Pragma("unroll") for (int k = 0; k < 2; ++k) dst[n][k] = *(const LAS bf16x8*)(lds + PG8_SB(b, h) + boff + n * 2048 + k * 1024); } while (0)
#define PG8_MMA(ai, bj, At, Bt) do { __builtin_amdgcn_s_setprio(1); _Pragma("unroll") for (int m = 0; m < 4; ++m) _Pragma("unroll") for (int n = 0; n < 2; ++n) _Pragma("unroll") for (int k = 0; k < 2; ++k) \
        acc[ai][bj][m][n] = __builtin_amdgcn_mfma_f32_16x16x32_bf16(Bt[n][k], At[m][k], acc[ai][bj][m][n], 0, 0, 0); __builtin_amdgcn_s_setprio(0); } while (0)
#define PG8_WAIT_V(n) asm volatile("s_waitcnt vmcnt(" #n ")" ::: "memory")
#define PG8_WAIT_L(n) asm volatile("s_waitcnt lgkmcnt(" #n ")" ::: "memory")
#define PG8_BAR __builtin_amdgcn_s_barrier()
#define PG8_SCHED __builtin_amdgcn_sched_barrier(0)
    Unit cur, nxt; int ui = 0;
    if (!S.next(0, cur)) return;
    f32x4 acc[2][2][4][2];
#pragma unroll
    for (int a = 0; a < 2; ++a)
#pragma unroll
        for (int b = 0; b < 2; ++b)
#pragma unroll
            for (int m = 0; m < 4; ++m)
#pragma unroll
                for (int n = 0; n < 2; ++n) acc[a][b][m][n] = (f32x4){0.f, 0.f, 0.f, 0.f};
    bf16x8 At[4][2], B0[2][2], B1[2][2];
    const char* cA = (const char*)g.A + cur.ao; const char* cB = (const char*)g.Bt + cur.bo;
    PG8_STAGE(PG8_SB(0, 0), cB, voffB); PG8_STAGE(PG8_SB(0, 1), cB + hsB, voffB); PG8_STAGE(PG8_SA(0, 0), cA, voffA); PG8_STAGE(PG8_SA(0, 1), cA + hsA, voffA);
    if (wr == 1) PG8_BAR;
    PG8_WAIT_V(2); PG8_BAR;
    PG8_STAGE(PG8_SB(1, 0), cB + kstep, voffB); PG8_STAGE(PG8_SA(1, 0), cA + kstep, voffA); PG8_STAGE(PG8_SB(1, 1), cB + hsB + kstep, voffB);
    PG8_WAIT_V(6); PG8_BAR;
    for (;;) {
        const bool has_next = S.next(ui + 1, nxt);
        const char* nA = has_next ? (const char*)g.A + nxt.ao : cA; const char* nB = has_next ? (const char*)g.Bt + nxt.bo : cB;
        for (int t = 0; t < nt; t += 2) {
            const bool last = (t == nt - 2);
            const char* a1 = cA + (size_t)(t + 1) * kstep;
            const char* a2 = last ? nA : cA + (size_t)(t + 2) * kstep; const char* b2 = last ? nB : cB + (size_t)(t + 2) * kstep;
            const char* a3 = a2 + kstep; const char* b3 = b2 + kstep;
            PG8_LDB(B0, 0, 0); PG8_LDB(B1, 0, 1); PG8_SCHED; PG8_LDA(At, 0, 0); PG8_STAGE(PG8_SA(1, 1), a1 + hsA, voffA);
            PG8_WAIT_V(8); PG8_WAIT_L(0); PG8_BAR; PG8_MMA(0, 0, At, B0); PG8_MMA(0, 1, At, B1); PG8_BAR; PG8_SCHED;
            PG8_LDA(At, 0, 1); PG8_STAGE(PG8_SB(0, 0), b2, voffB); PG8_STAGE(PG8_SB(0, 1), b2 + hsB, voffB); PG8_STAGE(PG8_SA(0, 0), a2, voffA);
            PG8_WAIT_V(8); PG8_WAIT_L(0); PG8_BAR; PG8_MMA(1, 0, At, B0); PG8_MMA(1, 1, At, B1); PG8_BAR; PG8_SCHED;
            PG8_LDB(B0, 1, 0); PG8_LDB(B1, 1, 1); PG8_SCHED; PG8_LDA(At, 1, 0); PG8_STAGE(PG8_SA(0, 1), a2 + hsA, voffA);
            PG8_WAIT_V(8); PG8_WAIT_L(0); PG8_BAR; PG8_MMA(0, 0, At, B0); PG8_MMA(0, 1, At, B1); PG8_BAR; PG8_SCHED;
            PG8_LDA(At, 1, 1); PG8_STAGE(PG8_SB(1, 0), b3, voffB); PG8_STAGE(PG8_SB(1, 1), b3 + hsB, voffB); PG8_STAGE(PG8_SA(1, 0), a3, voffA);
            PG8_WAIT_V(8); PG8_WAIT_L(0); PG8_BAR; PG8_MMA(1, 0, At, B0); PG8_MMA(1, 1, At, B1); PG8_BAR; PG8_SCHED;
        }
        if (wr == 0) PG8_BAR;
        if constexpr (!Epi::AFTER_DRAIN) { E(acc, cur, wr, wc, fr, fq); }
        if (!has_next) break;
#pragma unroll
        for (int a = 0; a < 2; ++a)
#pragma unroll
            for (int b = 0; b < 2; ++b)
#pragma unroll
                for (int m = 0; m < 4; ++m)
#pragma unroll
                    for (int n = 0; n < 2; ++n) acc[a][b][m][n] = (f32x4){0.f, 0.f, 0.f, 0.f};
        cur = nxt; cA = nA; cB = nB; ++ui;
        if (wr == 1) PG8_BAR;
    }
    PG8_WAIT_V(0);
    PG8_BAR;
    if constexpr (Epi::AFTER_DRAIN) { E.fused(acc, cur, wr, wc, fr, fq, lds, wid, lane); }
#undef PG8_SA
#undef PG8_SB
#undef PG8_STAGE
#undef PG8_LDA
#undef PG8_LDB
#undef PG8_MMA
#undef PG8_WAIT_V
#undef PG8_WAIT_L
#undef PG8_BAR
#undef PG8_SCHED
}

template <class F> struct EpiCols8 {
    static constexpr bool PERM = true, AFTER_DRAIN = false; F f;
    __device__ __forceinline__ void operator()(const f32x4 (&acc)[2][2][4][2], const Unit& u, int wr, int wc, int fr, int fq) const {
#pragma unroll
        for (int ai = 0; ai < 2; ++ai)
#pragma unroll
            for (int m = 0; m < 4; ++m) { const int row = u.pm * BM + ai * HALF + wr * 64 + m * 16 + fr;
#pragma unroll
                for (int bj = 0; bj < 2; ++bj) f(u, row, u.pn * BM + bj * HALF + wc * 32 + 8 * fq, acc[ai][bj][m][0], acc[ai][bj][m][1]); }
    }
};
template <int MODE> struct EpiRes {
    static constexpr bool PERM = false, AFTER_DRAIN = false; const float* res; float* out; const f32x2* st; const float* g; const float* b; int ldc; float alpha;
    __device__ __forceinline__ void operator()(const f32x4 (&acc)[2][2][4][2], const Unit& u, int wr, int wc, int fr, int fq) const {
        const unsigned row0 = (unsigned)(u.pm * BM + wr * 64 + fr), col0 = (unsigned)(u.pn * BM + wc * 32 + 4 * fq);
        const unsigned base = row0 * (unsigned)ldc + col0;
        f32x4 gv[2][2], bv[2][2];
        if (MODE == 1) {
#pragma unroll
            for (int bj = 0; bj < 2; ++bj)
#pragma unroll
                for (int n = 0; n < 2; ++n) { gv[bj][n] = *(const f32x4*)(g + col0 + bj * HALF + n * 16); bv[bj][n] = *(const f32x4*)(b + col0 + bj * HALF + n * 16); }
        }
#pragma unroll
        for (int ai = 0; ai < 2; ++ai)
#pragma unroll
            for (int mp = 0; mp < 2; ++mp) {
                f32x4 r[2][2][2]; f32x2 sv[2];
#pragma unroll
                for (int mm = 0; mm < 2; ++mm) { const int m = 2 * mp + mm; const unsigned off = base + (unsigned)(ai * HALF + m * 16) * (unsigned)ldc;
                    if (MODE == 1) sv[mm] = st[row0 + ai * HALF + m * 16];
#pragma unroll
                    for (int bj = 0; bj < 2; ++bj)
#pragma unroll
                        for (int n = 0; n < 2; ++n) r[mm][bj][n] = *(const f32x4*)(res + (off + bj * HALF + n * 16)); }
                asm volatile("" ::: "memory");
#pragma unroll
                for (int mm = 0; mm < 2; ++mm) { const int m = 2 * mp + mm; const unsigned off = base + (unsigned)(ai * HALF + m * 16) * (unsigned)ldc;
#pragma unroll
                    for (int bj = 0; bj < 2; ++bj)
#pragma unroll
                        for (int n = 0; n < 2; ++n) { f32x4 x = r[mm][bj][n];
                            if (MODE == 1) x = (x - sv[mm].x) * sv[mm].y * gv[bj][n] + bv[bj][n];
                            *(f32x4*)(out + (off + bj * HALF + n * 16)) = x * alpha + acc[ai][bj][m][n]; } }
                asm volatile("" ::: "memory");
            }
    }
};
}

struct Args { const float* in[29]; float* out; unsigned char* ws; int ph_lo, ph_hi; };
enum { I_X = 0, I_MEM, I_S5_WIN, I_S5_ARE, I_S5_AIM, I_S5_LOGDT, I_S5_BRE, I_S5_BIM, I_S5_CRE, I_S5_CIM, I_S5_D, I_S5_WGLU, I_S5_WOUT, I_KVW,
       I_CPK, I_CW1K, I_CW2K, I_CPV, I_CW1V, I_CW2V, I_WQG, I_WNO, I_MWQ, I_MWKV, I_MWO, I_WUP, I_WDN, I_LNG, I_LNB };

__device__ __forceinline__ const float* argp(int i) {
    const char* kp = (const char*)__builtin_amdgcn_kernarg_segment_ptr(); const float* p;
    asm volatile("s_load_dwordx2 %0, %1, %2\n\ts_waitcnt lgkmcnt(0)" : "=s"(p) : "s"(kp), "i"(i * 8)); return p; }
#define INP(i) argp(i)

__device__ __forceinline__ void conv_item(const float* W, int ldw, int ncols, bf16_t* WT, int ldt, int k0, int n0, int drow0, LAS float* scr, int lane) {
    const int r8 = lane >> 3, c4 = (lane & 7) * 4; const bool ok = (n0 + c4) < ncols;
    f32x4 v[8];
#pragma unroll
    for (int i = 0; i < 8; ++i) v[i] = ok ? *(const f32x4*)(W + (size_t)(k0 + 8 * i + r8) * ldw + n0 + c4) : (f32x4){0.f, 0.f, 0.f, 0.f};
#pragma unroll
    for (int i = 0; i < 8; ++i) { LAS float* d = scr + (8 * i + r8) * 33 + c4; d[0] = v[i].x; d[1] = v[i].y; d[2] = v[i].z; d[3] = v[i].w; }
    LDS_WAIT(); asm volatile("" ::: "memory");
    const int c = lane & 7;
#pragma unroll
    for (int j = 0; j < 4; ++j) { const int n = (lane >> 3) + 8 * j; const LAS float* s = scr + (8 * c) * 33 + n;
        u32x4 o; o.x = pk2(s[0 * 33], s[1 * 33]); o.y = pk2(s[2 * 33], s[3 * 33]); o.z = pk2(s[4 * 33], s[5 * 33]); o.w = pk2(s[6 * 33], s[7 * 33]);
        *(u32x4*)(WT + (size_t)(drow0 + n) * ldt + k0 + 8 * c) = o; }
    LDS_WAIT(); asm volatile("" ::: "memory");
}
template <int MODE>
__device__ __forceinline__ void conv_matrix(const float* W, int K, int ldw, int ncols, bf16_t* WT, int ldt, int row_off, LAS float* scr, int gw, int NGW, int lane) {
    const int nblk = (ncols + 31) / 32, nitems = (K / 64) * nblk;
    for (int it = gw; it < nitems; it += NGW) {
        const int kb = it / nblk, nb = it % nblk, n0 = 32 * nb;
        int drow0;
        if (MODE == 1) { const int bj = n0 >> 11, j = n0 & 2047; drow0 = 256 * (j >> 7) + 128 * bj + (j & 127); } else drow0 = row_off + n0;
        conv_item(W, ldw, ncols, WT, ldt, 64 * kb, n0, drow0, scr, lane);
    }
}
__device__ __forceinline__ void cvt_rows(const float* src, bf16_t* dst, size_t n, int gtid, int gthreads) {
    for (size_t i = (size_t)gtid * 8; i < n; i += (size_t)gthreads * 8) {
        const f32x4 a = *(const f32x4*)(src + i), b = *(const f32x4*)(src + i + 4);
        u32x4 o; o.x = pk2(a.x, a.y); o.y = pk2(a.z, a.w); o.z = pk2(b.x, b.y); o.w = pk2(b.z, b.w);
        *(u32x4*)(dst + i) = o;
    }
}
template <bool WF32>
__device__ __forceinline__ void ln_phase(const float* src, float prescale, float* XF, bf16_t* XB, f32x2* ST, const float* g, const float* b, int gw, int NGW, int lane) {
    asm volatile("" : "+v"(lane));
    f32x4 gvv[8], bvv[8];
#pragma unroll
    for (int j = 0; j < 8; ++j) { gvv[j] = ((const f32x4*)g)[lane + 64 * j]; bvv[j] = ((const f32x4*)b)[lane + 64 * j]; }
    for (int row = gw; row < MTOK; row += NGW) {
        const f32x4* xr = (const f32x4*)(src + (size_t)row * DM) + lane;
        f32x4 v[8]; float s = 0.f;
#pragma unroll
        for (int j = 0; j < 8; ++j) { v[j] = xr[64 * j] * prescale; s += (v[j].x + v[j].y) + (v[j].z + v[j].w); }
        const float mean = wave_sum(s) * (1.f / DM); float s2 = 0.f;
#pragma unroll
        for (int j = 0; j < 8; ++j) { v[j] = v[j] - mean; s2 += (v[j].x * v[j].x + v[j].y * v[j].y) + (v[j].z * v[j].z + v[j].w * v[j].w); }
        const float rstd = 1.f / sqrtf(wave_sum(s2) * (1.f / DM) + LN_EPS);
        if (!WF32 && lane == 0) ST[row] = (f32x2){mean, rstd};
        f32x4* xo = (f32x4*)(XF + (size_t)row * DM) + lane; u32x2* bo = (u32x2*)(XB + (size_t)row * DM) + lane;
#pragma unroll
        for (int j = 0; j < 8; ++j) { const f32x4 gv = gvv[j], bv = bvv[j];
            const f32x4 o = v[j] * rstd * gv + bv; if (WF32) xo[64 * j] = o; else { u32x2 w; w.x = pk2(o.x, o.y); w.y = pk2(o.z, o.w); bo[64 * j] = w; } }
    }
}

struct StoreBf16 { bf16_t* O; int ldc; float scale;
    __device__ __forceinline__ void operator()(const pg8::Unit&, int row, int col, f32x4 v0, f32x4 v1) const {
        u32x4 w; w.x = pg8::cvt_pk_bf16(v0[0] * scale, v0[1] * scale); w.y = pg8::cvt_pk_bf16(v0[2] * scale, v0[3] * scale); w.z = pg8::cvt_pk_bf16(v1[0] * scale, v1[1] * scale); w.w = pg8::cvt_pk_bf16(v1[2] * scale, v1[3] * scale);
        *(u32x4*)(O + (size_t)row * ldc + col) = w; } };
struct StoreRelu2 { bf16_t* O; int ldc;
    __device__ __forceinline__ void operator()(const pg8::Unit&, int row, int col, f32x4 v0, f32x4 v1) const {
#pragma unroll
        for (int i = 0; i < 4; ++i) { const float a = v0[i] > 0.f ? v0[i] : 0.f, c = v1[i] > 0.f ? v1[i] : 0.f; v0[i] = a * a; v1[i] = c * c; }
        u32x4 w; w.x = pg8::cvt_pk_bf16(v0[0], v0[1]); w.y = pg8::cvt_pk_bf16(v0[2], v0[3]); w.z = pg8::cvt_pk_bf16(v1[0], v1[1]); w.w = pg8::cvt_pk_bf16(v1[2], v1[3]);
        *(u32x4*)(O + (size_t)row * ldc + col) = w; } };


__device__ __forceinline__ void s5_tables(const float* a_re, const float* a_im, const float* log_dt, const float* b_re, const float* b_im, const float* c_re, const float* c_im,
                                          unsigned char* ws, int gtid, int gthreads) {
    f32x2* AB = (f32x2*)(ws + MS_S5AB); f32x2* ABL = (f32x2*)(ws + MS_S5ABL); bf16_t* BM = (bf16_t*)(ws + MS_S5BM); bf16_t* CM = (bf16_t*)(ws + MS_S5CM);
    for (int i = gtid; i < 128 * 64 * 16; i += gthreads) {
        const int h = i & 15, p = (i >> 4) & 63, g = i >> 10;
        const float dt = expf(log_dt[g]), lr = a_re[g * 64 + p], li = a_im[g * 64 + p];
        const float mag = expf(lr * dt), abr = mag * cosf(li * dt), abi = mag * sinf(li * dt);
        const float den = lr * lr + li * li, nr = abr - 1.0f, ni = abi;
        const float fre = (nr * lr + ni * li) / den, fim = (ni * lr - nr * li) / den;
        const float br = b_re[(g * 64 + p) * 16 + h], bi = b_im[(g * 64 + p) * 16 + h];
        BM[(g * 128 + p) * 16 + h] = (bf16_t)f2bf(fre * br - fim * bi);
        BM[(g * 128 + 64 + p) * 16 + h] = (bf16_t)f2bf(fre * bi + fim * br);
        CM[(g * 16 + h) * 128 + p] = (bf16_t)f2bf(c_re[(g * 16 + h) * 64 + p]);
        CM[(g * 16 + h) * 128 + 64 + p] = (bf16_t)f2bf(-c_im[(g * 16 + h) * 64 + p]);
        if (h == 0) { AB[g * 64 + p] = (f32x2){abr, abi}; float xr = abr, xi = abi;
            for (int k = S5_LC; k > 1; k >>= 1) { const float t = xr * xr - xi * xi; xi = 2.f * xr * xi; xr = t; }
            ABL[g * 64 + p] = (f32x2){xr, xi}; }
    }
}
__device__ __forceinline__ float gelu_tanh(float y) { const float z = 0.7978845608028654f * (y + 0.044715f * y * y * y); const float e = __expf(2.f * z); return y * (1.f - __builtin_amdgcn_rcpf(1.f + e)); }
template <bool FINAL>
__device__ __forceinline__ void s5_pass(const bf16_t* U, bf16_t* Y, const float* dskip, unsigned char* ws, LAS unsigned char* lds, int gw, int NGW, int wave, int lane) {
    asm volatile("" : "+v"(lane));
    const int fr = lane & 15, fq = lane >> 4;
    LAS float* BU = (LAS float*)(lds + wave * 12800); LAS bf16_t* SB = (LAS bf16_t*)(lds + wave * 12800 + 8448);
    constexpr int LDB = 132, LDSB = 136;
    for (int item = gw; item < 2 * 128 * S5_NCH; item += NGW) {
        const int g = item & 127, b = (item >> 7) & 1, ch = item >> 8;
        const bf16_t* BMg = (const bf16_t*)(ws + MS_S5BM) + (size_t)g * 128 * 16; const bf16_t* CMg = (const bf16_t*)(ws + MS_S5CM) + (size_t)g * 16 * 128;
        bf16x8 bmf[8];
#pragma unroll
        for (int nt = 0; nt < 8; ++nt) { bmf[nt] = (bf16x8){0, 0, 0, 0, 0, 0, 0, 0}; if (fq < 2) bmf[nt] = *(const bf16x8*)(BMg + (16 * nt + fr) * 16 + 8 * fq); }
        bf16x8 cmf[4];
        if (FINAL) {
#pragma unroll
            for (int kk = 0; kk < 4; ++kk) cmf[kk] = *(const bf16x8*)(CMg + fr * 128 + 32 * kk + 8 * fq);
        }
        const f32x2 ab = ((const f32x2*)(ws + MS_S5AB))[g * 64 + lane];
        const float ar = ab.x, ai = ab.y;
        float sr = 0.f, si = 0.f;
        if (FINAL) { const f32x2 al = ((const f32x2*)(ws + MS_S5ABL))[g * 64 + lane]; const f32x2* E = (const f32x2*)(ws + MS_S5E) + (size_t)(b * 128 + g) * S5_NCH * 64 + lane;
            for (int c = 0; c < ch; ++c) { const f32x2 e = E[c * 64]; const float nr = al.x * sr - al.y * si + e.x, ni = al.x * si + al.y * sr + e.y; sr = nr; si = ni; } }
        const float dsk = FINAL ? dskip[g * 16 + fr] : 0.f;
        const size_t row0 = (size_t)b * SEQ + (size_t)ch * S5_LC;
        const bf16_t* Up = U + (row0 + fr) * DM + g * 16 + 8 * fq;
        bf16x8 uf = (bf16x8){0, 0, 0, 0, 0, 0, 0, 0}; if (fq < 2) uf = *(const bf16x8*)Up;
        for (int t0 = 0; t0 < S5_LC; t0 += 16) {
            bf16x8 un = (bf16x8){0, 0, 0, 0, 0, 0, 0, 0};
            if (fq < 2 && t0 + 16 < S5_LC) un = *(const bf16x8*)(Up + (size_t)(t0 + 16) * DM);
#pragma unroll
            for (int nt = 0; nt < 8; ++nt) { const f32x4 d = __builtin_amdgcn_mfma_f32_16x16x32_bf16(uf, bmf[nt], (f32x4){0.f, 0.f, 0.f, 0.f}, 0, 0, 0);
#pragma unroll
                for (int r = 0; r < 4; ++r) BU[(4 * fq + r) * LDB + 16 * nt + fr] = d[r]; }
#pragma unroll
            for (int t = 0; t < 16; ++t) { const float br = BU[t * LDB + lane], bi = BU[t * LDB + 64 + lane];
                const float nr = ar * sr - ai * si + br, ni = ar * si + ai * sr + bi; sr = nr; si = ni;
                if (FINAL) { SB[t * LDSB + lane] = (bf16_t)f2bf(sr); SB[t * LDSB + 64 + lane] = (bf16_t)f2bf(si); } }
            if (FINAL) {
                f32x4 y = (f32x4){0.f, 0.f, 0.f, 0.f};
#pragma unroll
                for (int kk = 0; kk < 4; ++kk) { const bf16x8 sf = *(const LAS bf16x8*)(SB + fr * LDSB + 32 * kk + 8 * fq); y = __builtin_amdgcn_mfma_f32_16x16x32_bf16(sf, cmf[kk], y, 0, 0, 0); }
#pragma unroll
                for (int r = 0; r < 4; ++r) { const size_t o = (row0 + t0 + 4 * fq + r) * DM + g * 16 + fr; const float uu = bf2f(U[o]); Y[o] = (bf16_t)f2bf(gelu_tanh(y[r] + dsk * uu)); }
            }
            uf = un;
        }
        if (!FINAL) ((f32x2*)(ws + MS_S5E))[((b * 128 + g) * S5_NCH + ch) * 64 + lane] = (f32x2){sr, si};
    }
}
__device__ __forceinline__ void s5_carry(unsigned char* ws, int gtid, int gthreads) {
    for (int i = gtid; i < 2 * 128 * 64; i += gthreads) {
        const int p = i & 63, bg = i >> 6, g = bg & 127;
        const f32x2 al = ((const f32x2*)(ws + MS_S5ABL))[g * 64 + p];
        const f32x2* E = (const f32x2*)(ws + MS_S5E) + (size_t)bg * S5_NCH * 64 + p; f32x2* SI = (f32x2*)(ws + MS_S5SIN) + (size_t)bg * S5_NCH * 64 + p;
        float sr = 0.f, si = 0.f;
        for (int c = 0; c < S5_NCH; ++c) { SI[c * 64] = (f32x2){sr, si}; const f32x2 e = E[c * 64]; const float nr = al.x * sr - al.y * si + e.x, ni = al.x * si + al.y * sr + e.y; sr = nr; si = ni; }
    }
}

struct EpiGlu {
    static constexpr bool PERM = true, AFTER_DRAIN = false; bf16_t* O; int ldc;
    __device__ __forceinline__ void operator()(const f32x4 (&acc)[2][2][4][2], const pg8::Unit& u, int wr, int wc, int fr, int fq) const {
        const int col = u.pn * 128 + wc * 32 + 8 * fq;
#pragma unroll
        for (int ai = 0; ai < 2; ++ai)
#pragma unroll
            for (int m = 0; m < 4; ++m) { const int row = u.pm * 256 + ai * 128 + wr * 64 + m * 16 + fr; float o[8];
#pragma unroll
                for (int n = 0; n < 2; ++n)
#pragma unroll
                    for (int i = 0; i < 4; ++i) { const float v = acc[ai][0][m][n][i], gt = acc[ai][1][m][n][i]; o[4 * n + i] = v * __builtin_amdgcn_rcpf(1.f + __expf(-gt)); }
                u32x4 w; w.x = pg8::cvt_pk_bf16(o[0], o[1]); w.y = pg8::cvt_pk_bf16(o[2], o[3]); w.z = pg8::cvt_pk_bf16(o[4], o[5]); w.w = pg8::cvt_pk_bf16(o[6], o[7]);
                *(u32x4*)(O + (size_t)row * ldc + col) = w; }
    }
};
struct EpiSoftmax {
    static constexpr bool PERM = false, AFTER_DRAIN = true; bf16_t* P;
    __device__ __forceinline__ void fused(f32x4 (&acc)[2][2][4][2], const pg8::Unit& u, int wr, int wc, int fr, int fq, LAS unsigned char* lds, int wid, int lane) const {
        LAS f32x2* X = (LAS f32x2*)lds;
        float mw[2][4];
#pragma unroll
        for (int ai = 0; ai < 2; ++ai)
#pragma unroll
            for (int m = 0; m < 4; ++m) {
                float mx = -3.0e38f;
#pragma unroll
                for (int bj = 0; bj < 2; ++bj)
#pragma unroll
                    for (int n = 0; n < 2; ++n)
#pragma unroll
                        for (int i = 0; i < 4; ++i) mx = fmaxf(mx, acc[ai][bj][m][n][i]);
                mx = fmaxf(mx, my_shfl_xor(mx, 16)); mx = fmaxf(mx, my_shfl_xor(mx, 32));
                float sm = 0.f;
#pragma unroll
                for (int bj = 0; bj < 2; ++bj)
#pragma unroll
                    for (int n = 0; n < 2; ++n)
#pragma unroll
                        for (int i = 0; i < 4; ++i) { const float e = __builtin_amdgcn_exp2f(acc[ai][bj][m][n][i] - mx); acc[ai][bj][m][n][i] = e; sm += e; }
                sm += my_shfl_xor(sm, 16); sm += my_shfl_xor(sm, 32);
                mw[ai][m] = mx;
                if (fq == 0) X[(ai * 128 + wr * 64 + m * 16 + fr) * 4 + wc] = (f32x2){mx, sm};
            }
        LDS_WAIT(); __builtin_amdgcn_s_barrier(); asm volatile("" ::: "memory");
#pragma unroll
        for (int ai = 0; ai < 2; ++ai)
#pragma unroll
            for (int m = 0; m < 4; ++m) { const int r = ai * 128 + wr * 64 + m * 16 + fr;
                const f32x2 a = X[r * 4 + 0], b = X[r * 4 + 1], c = X[r * 4 + 2], d = X[r * 4 + 3];
                const float M = fmaxf(fmaxf(a.x, b.x), fmaxf(c.x, d.x));
                const float tot = a.y * __builtin_amdgcn_exp2f(a.x - M) + b.y * __builtin_amdgcn_exp2f(b.x - M) + c.y * __builtin_amdgcn_exp2f(c.x - M) + d.y * __builtin_amdgcn_exp2f(d.x - M);
                const float f = __builtin_amdgcn_exp2f(mw[ai][m] - M) / tot;
                bf16_t* rowp = P + (size_t)(u.pm * 256 + r) * 1024 + u.z * 256 + wc * 32 + 4 * fq;
#pragma unroll
                for (int bj = 0; bj < 2; ++bj)
#pragma unroll
                    for (int n = 0; n < 2; ++n) { const f32x4 v = acc[ai][bj][m][n] * f; u32x2 w; w.x = pg8::cvt_pk_bf16(v[0], v[1]); w.y = pg8::cvt_pk_bf16(v[2], v[3]); *(u32x2*)(rowp + bj * 128 + n * 16) = w; } }
        LDS_WAIT(); __builtin_amdgcn_s_barrier(); asm volatile("" ::: "memory");
    }
};
struct CmpSched {
    int G, c;
    __device__ bool next(int i, pg8::Unit& u) const {
        const int L = i * G + c; if (L >= 128) return false;
        const int which = L >> 6, ks = (L >> 4) & 3, pm = L & 15; u.pm = pm; u.pn = 0; u.z = which * 4 + ks;
        u.ao = (unsigned)(((size_t)which * KVH_SLOT + (size_t)pm * 256 * 2048 + ks * 512) * 2); u.bo = (unsigned)(((size_t)which * 256 * 2048 + ks * 512) * 2);
        return true;
    }
};
struct StoreBf16Z { bf16_t* O; int ldc; float scale; size_t zstride;
    __device__ __forceinline__ void operator()(const pg8::Unit& u, int row, int col, f32x4 v0, f32x4 v1) const {
        u32x4 w; w.x = pg8::cvt_pk_bf16(v0[0] * scale, v0[1] * scale); w.y = pg8::cvt_pk_bf16(v0[2] * scale, v0[3] * scale); w.z = pg8::cvt_pk_bf16(v1[0] * scale, v1[1] * scale); w.w = pg8::cvt_pk_bf16(v1[2] * scale, v1[3] * scale);
        *(u32x4*)(O + (size_t)u.z * zstride + (size_t)row * ldc + col) = w; } };
struct KvSched { int G, c;
    __device__ bool next(int i, pg8::Unit& u) const { const int L = i * G + c; if (L >= 64) return false;
        const int l = L >> 5, pm = (L >> 4) & 1, pn = L & 15; u.pm = pm; u.pn = pn; u.z = l;
        u.ao = (unsigned)((size_t)pm * 256 * 2048 * 2); u.bo = (unsigned)((size_t)l * 16 * MiB + (size_t)pn * 256 * 2048 * 2); return true; } };
struct MtSched { int G, c;
    __device__ bool next(int i, pg8::Unit& u) const { const int L = i * G + c; if (L >= 128 || L < 0) return false;
        const int l = L >> 6, b = (L >> 5) & 1, h = (L >> 3) & 3, pn = L & 7; u.pm = h; u.pn = pn; u.z = l * 2 + b;
        u.ao = (unsigned)((size_t)l * 4 * MiB + ((size_t)(b * 256) * 4096 + h * 512) * 2); u.bo = (unsigned)((size_t)l * 8 * MiB + ((size_t)(pn * 256) * 2048 + h * 512) * 2); return true; } };
struct VwSched { int G, c;
    __device__ bool next(int i, pg8::Unit& u) const { const int L = i * G + c; if (L >= 128 || L < 0) return false;
        const int l = L >> 6, b = (L >> 5) & 1, h = (L >> 3) & 3, pmn = L & 7; u.pm = pmn; u.pn = h; u.z = l * 2 + b;
        u.ao = (unsigned)((size_t)l * 8 * MiB + ((size_t)(pmn * 256) * 2048 + h * 512) * 2); u.bo = (unsigned)((size_t)l * 4 * MiB + ((size_t)(b * 256) * 4096 + 2048 + h * 512) * 2); return true; } };
struct ScoreSched { int G, c, base, lim, layer;
    __device__ bool next(int i, pg8::Unit& u) const { const int L0 = base + i * G + c; if (L0 >= lim) return false;
        const int L = (G == 256) ? ((L0 & 7) * 32 + (L0 >> 3)) : L0;
        const int b = L >> 7, pmp = (L >> 2) & 31, h = L & 3; u.pm = b * 32 + pmp; u.pn = 0; u.z = h;
        u.ao = (unsigned)((size_t)(b * SEQ + 256 * pmp) * 2048 * 2); u.bo = (unsigned)((size_t)(layer * 2 + b) * 4 * MiB + (size_t)(h * 256) * 2048 * 2); return true; } };
struct PvoSched { pg8::StaticOrder so; int layer;
    __device__ bool next(int i, pg8::Unit& u) const { if (!so.next(i, u)) return false; u.bo += (unsigned)((size_t)(layer * 2 + (u.pm >> 5)) * 4 * MiB); return true; } };
template <int MODE> struct MemSched {
    int G, c, base, lim;
    __device__ bool next(int i, pg8::Unit& u) const {
        const int L = base + i * G + c; if (L >= lim) return false;
        if (MODE == 0) { const int b = L >> 7, h = (L >> 5) & 3, pmp = L & 31; u.pm = b * 32 + pmp; u.pn = 0; u.z = h;
            u.ao = (unsigned)(((b * SEQ + 256 * pmp) * 2048 + h * 512) * 2); u.bo = (unsigned)(((b * 256) * 2048 + h * 512) * 2); }
        else { const int pn = L & 1, pmp = (L >> 1) & 31, h = (L >> 6) & 3, b = L >> 8; u.pm = b * 32 + pmp; u.pn = h * 2 + pn; u.z = 0;
            u.ao = (unsigned)(((b * SEQ + 256 * pmp) * 1024 + h * 256) * 2); u.bo = (unsigned)(((h * 512 + 256 * pn) * 512 + b * 256) * 2); }
        return true;
    }
};


struct StoreKVQ { bf16_t* KVH; bf16_t* QH; float* GATES; float qscale;
    __device__ __forceinline__ void operator()(const pg8::Unit&, int row, int col, f32x4 v0, f32x4 v1) const {
        const int b = row >> 13, t = row & 8191;
        if (col < 3072) { const int slot = col >> 9, g = (col >> 7) & 3, d = col & 127;
            u32x4 w; w.x = pg8::cvt_pk_bf16(v0[0], v0[1]); w.y = pg8::cvt_pk_bf16(v0[2], v0[3]); w.z = pg8::cvt_pk_bf16(v1[0], v1[1]); w.w = pg8::cvt_pk_bf16(v1[2], v1[3]);
            *(u32x4*)(KVH + ((((size_t)slot * 2 + b) * 4 + g) * 8192 + t) * 128 + d) = w; }
        else if (col < 5120) { const int c2 = col - 3072, head = c2 >> 7, d = c2 & 127, g = head >> 2, r = head & 3; v0 = v0 * qscale; v1 = v1 * qscale;
            u32x4 w; w.x = pg8::cvt_pk_bf16(v0[0], v0[1]); w.y = pg8::cvt_pk_bf16(v0[2], v0[3]); w.z = pg8::cvt_pk_bf16(v1[0], v1[1]); w.w = pg8::cvt_pk_bf16(v1[2], v1[3]);
            *(u32x4*)(QH + ((((size_t)b * 4 + g) * 8192 + t) * 4 + r) * 128 + d) = w; }
        else if (col < 5168) { float* gp = GATES + (size_t)row * 48 + (col - 5120);
#pragma unroll
            for (int i = 0; i < 4; ++i) { v0[i] = __builtin_amdgcn_rcpf(1.f + __expf(-v0[i])); v1[i] = __builtin_amdgcn_rcpf(1.f + __expf(-v1[i])); }
            *(f32x4*)gp = v0; *(f32x4*)(gp + 4) = v1; }
    } };
struct StoreF32 { float* O; int ldc; size_t zstride;
    __device__ __forceinline__ void operator()(const pg8::Unit& u, int row, int col, f32x4 v0, f32x4 v1) const { float* p = O + (size_t)u.z * zstride + (size_t)row * ldc + col; *(f32x4*)p = v0; *(f32x4*)(p + 4) = v1; } };
__device__ __forceinline__ void cmp_bias(const float* pos_k, const float* w1_k, const float* pos_v, const float* w1_v, float* CB, int tid) {
    if (tid < 256) { const int which = tid >> 7, n = tid & 127; const float* pos = which ? pos_v : pos_k; const float* w1 = which ? w1_v : w1_k; float a = 0.f;
        for (int k = 0; k < 4096; ++k) a += pos[k] * w1[(size_t)k * 128 + n];
        CB[tid] = a; }
}
__device__ __forceinline__ void cmp_combine(const float* PAB, const float* CB, const float* w2k, const float* w2v, bf16_t* KCMP, int gw, int NGW, int lane) {
    asm volatile("" : "+v"(lane));
    for (int it = gw; it < 2 * 4096; it += NGW) {
        const int which = it >> 12, row = it & 4095, c = row & 511;
        bf16_t* out = KCMP + ((size_t)which * 4096 + row) * 128;
        if (c == 511) { out[lane] = 0; out[lane + 64] = 0; continue; }
        const float* P = PAB + (size_t)which * 4 * 4096 * 256; const float* w2 = which ? w2v : w2k;
        float sa = CB[which * 128 + lane], sb = CB[which * 128 + 64 + lane];
#pragma unroll
        for (int ks = 0; ks < 4; ++ks) { const float* Pk = P + (size_t)ks * 4096 * 256;
            sa += Pk[(size_t)row * 256 + lane] + Pk[(size_t)(row + 1) * 256 + 128 + lane]; sb += Pk[(size_t)row * 256 + 64 + lane] + Pk[(size_t)(row + 1) * 256 + 192 + lane]; }
        const float va = gelu_tanh(sa), vb = gelu_tanh(sb);
        float o0 = 0.f, o1 = 0.f;
        for (int n = 0; n < 64; ++n) { const float x = my_shfl(va, n); o0 += x * w2[n * 128 + lane]; o1 += x * w2[n * 128 + 64 + lane]; }
        for (int n = 0; n < 64; ++n) { const float x = my_shfl(vb, n); o0 += x * w2[(64 + n) * 128 + lane]; o1 += x * w2[(64 + n) * 128 + 64 + lane]; }
        out[lane] = (bf16_t)f2bf(o0); out[lane + 64] = (bf16_t)f2bf(o1);
    }
}

namespace nsa {
constexpr int L_K0 = 0, L_V0 = 32768, L_IMP = 65536, IMP_LD = 132, IMP_WAVE = 8 * IMP_LD * 4, L_SELM = L_IMP + 8 * IMP_WAVE, L_UNI = L_SELM + 8 * 128, L_NTL = L_UNI + 16, L_TL = L_NTL + 16, L_WSF = L_TL + 512;
constexpr float NEGB = -1.0e30f;
typedef short v4i16_t __attribute__((ext_vector_type(4)));
__device__ __forceinline__ unsigned off_b(unsigned row, unsigned ch) { return 256u * row + 16u * (ch ^ (((row & 3) << 2) | ((row >> 2) & 3))); }
__device__ __forceinline__ int crow(int r, int hi) { return (r & 3) + 8 * (r >> 2) + 4 * hi; }
__device__ __forceinline__ float xhalf(float v) { return my_shfl_xor(v, 32); }

template <int BR, int MODE>
__device__ __forceinline__ void run_tiles(LAS unsigned char* lds, const bf16_t* Kb, const bf16_t* Vb, int ntiles, int first, int qt, const bf16x8 (&qf)[8], f32x16 (&o)[4], float& l_run,
                                          int t, unsigned selw0, unsigned selw1, unsigned selw2, unsigned selw3, float pscale, float gate, int tid, int wave, int lane) {
    const int l32 = lane & 31, hi = lane >> 5;
    LAS const int* TL = (LAS const int*)(lds + L_TL);
    LAS float* imp = (LAS float*)(lds + L_IMP + wave * IMP_WAVE) + ((l32 >> 2) * IMP_LD);
    const unsigned soff = (unsigned)((4 * wave + (lane >> 4)) * 128 + (((lane & 15) ^ (((lane >> 4) << 2) | (wave & 3))) * 8));
    auto tile_of = [&](int i) -> int { return (BR == 1) ? TL[i] : first + i; };
    auto stage = [&](int tile, int buf) { const bf16_t* ks = Kb + (size_t)tile * 8192 + soff; LAS unsigned char* kd = lds + L_K0 + buf * 16384 + wave * 1024;
        __builtin_amdgcn_global_load_lds((const unsigned*)ks, (LAS unsigned*)kd, 16, 0, 0); __builtin_amdgcn_global_load_lds((const unsigned*)(ks + 4096), (LAS unsigned*)(kd + 8192), 16, 0, 0);
        if (MODE != 0) { const bf16_t* vs = Vb + (size_t)tile * 8192 + soff; LAS unsigned char* vd = lds + L_V0 + buf * 16384 + wave * 1024;
            __builtin_amdgcn_global_load_lds((const unsigned*)vs, (LAS unsigned*)vd, 16, 0, 0); __builtin_amdgcn_global_load_lds((const unsigned*)(vs + 4096), (LAS unsigned*)(vd + 8192), 16, 0, 0); } };
    if (ntiles <= 0) return;
    stage(tile_of(0), 0);
    asm volatile("s_waitcnt vmcnt(0) lgkmcnt(0)" ::: "memory"); __builtin_amdgcn_s_barrier(); asm volatile("" ::: "memory");
    const unsigned kx = ((l32 & 3) << 2) | ((l32 >> 2) & 3);
    const int blk = (lane >> 4) & 1, tq = (lane & 15) >> 2, tp = lane & 3;
    for (int i = 0; i < ntiles; ++i) {
        const int tile = tile_of(i), buf = i & 1;
        if (i + 1 < ntiles) stage(tile_of(i + 1), buf ^ 1);
        bool selbit = true;
        if (BR == 1) { const unsigned w = (tile < 32) ? selw0 : (tile < 64) ? selw1 : (tile < 96) ? selw2 : selw3; selbit = (w >> (tile & 31)) & 1u; }
        const bool active = (BR == 1) ? (bool)__any((int)selbit) : true;
        if (active) {
            LAS const unsigned char* kb = lds + L_K0 + buf * 16384; LAS const unsigned char* vb = lds + L_V0 + buf * 16384;
            f32x16 p0, p1;
#pragma unroll
            for (int r = 0; r < 16; ++r) { p0[r] = 0.f; p1[r] = 0.f; }
            {
                bf16x8 kq0[3], kq1[3];
#define NSA_LDK(s_, slot_) do { const unsigned ko_ = 256u * l32 + 16u * ((unsigned)(2 * (s_) + hi) ^ kx); kq0[slot_] = *(LAS const bf16x8*)(kb + ko_); kq1[slot_] = *(LAS const bf16x8*)(kb + 8192 + ko_); } while (0)
                NSA_LDK(0, 0); NSA_LDK(1, 1);
                __builtin_amdgcn_sched_barrier(0);
#pragma unroll
                for (int s = 0; s < 8; ++s) {
                    if (s + 2 < 8) NSA_LDK(s + 2, (s + 2) % 3);
                    __builtin_amdgcn_sched_barrier(0);
                    p0 = __builtin_amdgcn_mfma_f32_32x32x16_bf16(kq0[s % 3], qf[s], p0, 0, 0, 0); p1 = __builtin_amdgcn_mfma_f32_32x32x16_bf16(kq1[s % 3], qf[s], p1, 0, 0, 0);
                    __builtin_amdgcn_sched_barrier(0);
                }
#undef NSA_LDK
            }
            const int kbase = tile * 64;
            const bool need_mask = (BR == 0) ? true : (BR == 1) ? (tile == qt) : ((tile == qt) || (tile == first && qt >= 8));
            const float ps = (BR == 1) ? 1.f : pscale;
            if (need_mask) {
                const int cmax = (t - 31) >> 4;
#pragma unroll
                for (int r = 0; r < 16; ++r) { const int k0i = kbase + crow(r, hi), k1i = k0i + 32; bool v0, v1;
                    if (BR == 0) { v0 = k0i <= cmax; v1 = k1i <= cmax; }
                    else if (BR == 1) { v0 = (k0i <= t); v1 = (k1i <= t); }
                    else { v0 = (k0i <= t) && (k0i > t - 512); v1 = (k1i <= t) && (k1i > t - 512); }
                    p0[r] = v0 ? __builtin_amdgcn_exp2f(p0[r]) * ps : 0.f; p1[r] = v1 ? __builtin_amdgcn_exp2f(p1[r]) * ps : 0.f; }
            } else {
#pragma unroll
                for (int r = 0; r < 16; ++r) { p0[r] = __builtin_amdgcn_exp2f(p0[r]) * ps; p1[r] = __builtin_amdgcn_exp2f(p1[r]) * ps; }
            }
            if (MODE != 1) { float sum = 0.f;
#pragma unroll
                for (int r = 0; r < 16; ++r) sum += p0[r] + p1[r];
                l_run += (BR == 1) ? (selbit ? sum : 0.f) : sum; }
            if (MODE == 1) {
#pragma unroll
                for (int h2 = 0; h2 < 2; ++h2)
#pragma unroll
                    for (int a = 0; a < 4; ++a) { const f32x16& pp = h2 ? p1 : p0; float gs = (pp[4 * a] + pp[4 * a + 1]) + (pp[4 * a + 2] + pp[4 * a + 3]), ls = pp[4 * a + 3];
                        gs += my_shfl_xor(gs, 1); gs += my_shfl_xor(gs, 2); ls += my_shfl_xor(ls, 1); ls += my_shfl_xor(ls, 2);
                        if ((lane & 3) == 0) { const int sidx = 16 * tile + 2 * a + hi + 8 * h2; atomicAdd((float*)(imp + sidx), gs); atomicAdd((float*)(imp + sidx + 1), ls); } }
#pragma unroll
                for (int r = 0; r < 16; ++r) { p0[r] *= gate; p1[r] *= gate; }
            }
            if (MODE != 0) {
                bf16x8 pa[4];
#pragma unroll
                for (int ks = 0; ks < 4; ++ks) { const f32x16& pp = (ks < 2) ? p0 : p1; const int b0 = 8 * (ks & 1); u32x4 w;
                    w.x = pg8::cvt_pk_bf16(pp[b0], pp[b0 + 1]); w.y = pg8::cvt_pk_bf16(pp[b0 + 2], pp[b0 + 3]); w.z = pg8::cvt_pk_bf16(pp[b0 + 4], pp[b0 + 5]); w.w = pg8::cvt_pk_bf16(pp[b0 + 6], pp[b0 + 7]);
                    if (BR == 1) { const unsigned msk = selbit ? 0xffffffffu : 0u; w.x &= msk; w.y &= msk; w.z &= msk; w.w &= msk; }
                    pa[ks] = __builtin_bit_cast(bf16x8, w); }
                bf16x8 vfr[2][4];
#define NSA_LDV(d_, slot_) do { _Pragma("unroll") for (int ks_ = 0; ks_ < 4; ++ks_) { \
                        const unsigned a0_ = off_b(16 * ks_ + 4 * hi + tq, 4 * (d_) + 2 * blk + (tp >> 1)) + 8 * (tp & 1); \
                        const unsigned a1_ = off_b(16 * ks_ + 8 + 4 * hi + tq, 4 * (d_) + 2 * blk + (tp >> 1)) + 8 * (tp & 1); \
                        const v4i16_t lo_ = __builtin_amdgcn_ds_read_tr16_b64_v4i16((LAS v4i16_t*)(vb + a0_)); \
                        const v4i16_t hv_ = __builtin_amdgcn_ds_read_tr16_b64_v4i16((LAS v4i16_t*)(vb + a1_)); \
                        vfr[slot_][ks_] = (bf16x8){lo_[0], lo_[1], lo_[2], lo_[3], hv_[0], hv_[1], hv_[2], hv_[3]}; } } while (0)
                NSA_LDV(0, 0);
                __builtin_amdgcn_sched_barrier(0);
#pragma unroll
                for (int d = 0; d < 4; ++d) {
                    if (d + 1 < 4) NSA_LDV(d + 1, (d + 1) & 1);
                    __builtin_amdgcn_sched_barrier(0);
#pragma unroll
                    for (int ks = 0; ks < 4; ++ks) o[d] = __builtin_amdgcn_mfma_f32_32x32x16_bf16(pa[ks], vfr[d & 1][ks], o[d], 0, 0, 0);
                    __builtin_amdgcn_sched_barrier(0);
                }
#undef NSA_LDV
            }
        }
        asm volatile("s_waitcnt vmcnt(0) lgkmcnt(0)" ::: "memory"); __builtin_amdgcn_s_barrier(); asm volatile("" ::: "memory");
    }
}

template <int BR>
__device__ __forceinline__ void run_tiles_stag(LAS unsigned char* lds, const bf16_t* Kb, const bf16_t* Vb, int ntiles, int first, int qt, const bf16x8 (&qf)[8], f32x16 (&o)[4], float& l_run,
                                               int t, unsigned selw0, unsigned selw1, unsigned selw2, unsigned selw3, int tid, int wave, int lane) {
    int wv_ = wave; asm volatile("" : "+s"(wv_)); const bool halfB = wv_ >= 4;
    LAS const int* TL = (LAS const int*)(lds + L_TL);
    const unsigned soff = (unsigned)((4 * wave + (lane >> 4)) * 128 + (((lane & 15) ^ (((lane >> 4) << 2) | (wave & 3))) * 8));
    auto tile_of = [&](int i) -> int { return (BR == 1) ? TL[i] : first + i; };
    auto stageK = [&](int tile, int buf) { const bf16_t* ks = Kb + (size_t)tile * 8192 + soff; LAS unsigned char* kd = lds + L_K0 + buf * 16384 + wave * 1024;
        __builtin_amdgcn_global_load_lds((const unsigned*)ks, (LAS unsigned*)kd, 16, 0, 0); __builtin_amdgcn_global_load_lds((const unsigned*)(ks + 4096), (LAS unsigned*)(kd + 8192), 16, 0, 0); };
    auto stageV = [&](int tile, int buf) { const bf16_t* vs = Vb + (size_t)tile * 8192 + soff; LAS unsigned char* vd = lds + L_V0 + buf * 16384 + wave * 1024;
        __builtin_amdgcn_global_load_lds((const unsigned*)vs, (LAS unsigned*)vd, 16, 0, 0); __builtin_amdgcn_global_load_lds((const unsigned*)(vs + 4096), (LAS unsigned*)(vd + 8192), 16, 0, 0); };
    if (ntiles <= 0) return;
    { const int t0_ = tile_of(0); stageK(t0_, 0); stageV(t0_, 0); }
    asm volatile("s_waitcnt vmcnt(0) lgkmcnt(0)" ::: "memory"); __builtin_amdgcn_s_barrier(); asm volatile("" ::: "memory");
    bf16x8 pa[4]; bool act = false;
#pragma unroll
    for (int ks = 0; ks < 4; ++ks) pa[ks] = (bf16x8){0, 0, 0, 0, 0, 0, 0, 0};
    auto qk_sm = [&](int tile, int buf) {
        bool selbit = true;
        if (BR == 1) { const unsigned w = (tile < 32) ? selw0 : (tile < 64) ? selw1 : (tile < 96) ? selw2 : selw3; selbit = (w >> (tile & 31)) & 1u; }
        act = (BR == 1) ? (bool)__any((int)selbit) : true;
        if (!act) return;
        int lv = lane; asm volatile("" : "+v"(lv));
        const int l32 = lv & 31, hi = lv >> 5; const unsigned kx = ((l32 & 3) << 2) | ((l32 >> 2) & 3);
        LAS const unsigned char* kb = lds + L_K0 + buf * 16384;
        const int kbase = tile * 64;
        const bool need_mask = (BR == 1) ? (tile == qt) : ((tile == qt) || (tile == first && qt >= 8));
        const float ps = (BR == 1) ? (selbit ? 1.f : 0.f) : 1.f;
        float sum = 0.f;
#pragma unroll
        for (int h2 = 0; h2 < 2; ++h2) {
            f32x16 pp;
#pragma unroll
            for (int r = 0; r < 16; ++r) pp[r] = 0.f;
            {
                bf16x8 kq[2];
#define NSA_LDK(s_, slot_) do { const unsigned ko_ = 256u * l32 + 16u * ((unsigned)(2 * (s_) + hi) ^ kx); kq[slot_] = *(LAS const bf16x8*)(kb + h2 * 8192 + ko_); } while (0)
                NSA_LDK(0, 0); NSA_LDK(1, 1);
                __builtin_amdgcn_sched_barrier(0);
#pragma unroll
                for (int s = 0; s < 8; s += 2) {
                    pp = __builtin_amdgcn_mfma_f32_32x32x16_bf16(kq[0], qf[s], pp, 0, 0, 0);
                    if (s + 2 < 8) NSA_LDK(s + 2, 0);
                    pp = __builtin_amdgcn_mfma_f32_32x32x16_bf16(kq[1], qf[s + 1], pp, 0, 0, 0);
                    if (s + 3 < 8) NSA_LDK(s + 3, 1);
                    __builtin_amdgcn_sched_barrier(0);
                }
#undef NSA_LDK
            }
            if (need_mask) {
#pragma unroll
                for (int r = 0; r < 16; ++r) { const int ki = kbase + 32 * h2 + crow(r, hi); bool v0;
                    if (BR == 1) v0 = (ki <= t); else v0 = (ki <= t) && (ki > t - 512);
                    pp[r] = v0 ? __builtin_amdgcn_exp2f(pp[r]) * ps : 0.f; }
            } else {
#pragma unroll
                for (int r = 0; r < 16; ++r) pp[r] = __builtin_amdgcn_exp2f(pp[r]) * ps;
            }
#pragma unroll
            for (int r = 0; r < 16; ++r) sum += pp[r];
#pragma unroll
            for (int kk = 0; kk < 2; ++kk) { const int b0 = 8 * kk; u32x4 w;
                w.x = pg8::cvt_pk_bf16(pp[b0], pp[b0 + 1]); w.y = pg8::cvt_pk_bf16(pp[b0 + 2], pp[b0 + 3]); w.z = pg8::cvt_pk_bf16(pp[b0 + 4], pp[b0 + 5]); w.w = pg8::cvt_pk_bf16(pp[b0 + 6], pp[b0 + 7]);
                pa[2 * h2 + kk] = __builtin_bit_cast(bf16x8, w); }
        }
        l_run += sum;
    };
    auto pv = [&](int buf) {
        int lv = lane; asm volatile("" : "+v"(lv));
        const int hi = lv >> 5, blk = (lv >> 4) & 1, tq = (lv & 15) >> 2, tp = lv & 3;
        LAS const unsigned char* vb = lds + L_V0 + buf * 16384;
        bf16x8 vfr[3];
#define NSA_LDV(j_, slot_) do { const int d_ = (j_) >> 2, ks_ = (j_) & 3; \
                const unsigned a0_ = off_b(16 * ks_ + 4 * hi + tq, 4 * d_ + 2 * blk + (tp >> 1)) + 8 * (tp & 1); \
                const unsigned a1_ = off_b(16 * ks_ + 8 + 4 * hi + tq, 4 * d_ + 2 * blk + (tp >> 1)) + 8 * (tp & 1); \
                const v4i16_t lo_ = __builtin_amdgcn_ds_read_tr16_b64_v4i16((LAS v4i16_t*)(vb + a0_)); \
                const v4i16_t hv_ = __builtin_amdgcn_ds_read_tr16_b64_v4i16((LAS v4i16_t*)(vb + a1_)); \
                vfr[slot_] = (bf16x8){lo_[0], lo_[1], lo_[2], lo_[3], hv_[0], hv_[1], hv_[2], hv_[3]}; } while (0)
        NSA_LDV(0, 0); NSA_LDV(1, 1);
        __builtin_amdgcn_sched_barrier(0);
#pragma unroll
        for (int j = 0; j < 16; ++j) {
            if (j + 2 < 16) NSA_LDV(j + 2, (j + 2) % 3);
            __builtin_amdgcn_sched_barrier(0);
            o[j >> 2] = __builtin_amdgcn_mfma_f32_32x32x16_bf16(pa[j & 3], vfr[j % 3], o[j >> 2], 0, 0, 0);
            __builtin_amdgcn_sched_barrier(0);
        }
#undef NSA_LDV
    };
#define NSA_SLOT_END() do { asm volatile("s_waitcnt vmcnt(0) lgkmcnt(0)" ::: "memory"); __builtin_amdgcn_s_barrier(); asm volatile("" ::: "memory"); } while (0)
    const int hsel = halfB ? 1 : 0;
    for (int sl = 0; sl <= 2 * ntiles; ++sl) {
        const int inext = (sl >> 1) + 1;
        const bool staged = inext < ntiles;
        if (staged) { const int tn = tile_of(inext); if (sl & 1) stageV(tn, inext & 1); else stageK(tn, inext & 1); }
        if ((sl & 1) == hsel) { const int i = (sl - hsel) >> 1; if (i < ntiles) qk_sm(tile_of(i), i & 1); }
        else { const int i = (sl - 1 - hsel) >> 1; if (sl - 1 - hsel >= 0 && i < ntiles && act) pv(i & 1); }
        if (staged) asm volatile("s_waitcnt vmcnt(2) lgkmcnt(0)" ::: "memory"); else asm volatile("s_waitcnt vmcnt(0) lgkmcnt(0)" ::: "memory");
        __builtin_amdgcn_s_barrier(); asm volatile("" ::: "memory");
    }
#undef NSA_SLOT_END
}

template <bool FIRST>
__device__ __forceinline__ void flush(f32x16 (&o)[4], float fac, bf16_t* Obase, LAS float* wsf, int l32, int hi) {
    if (hi == 0) wsf[l32] = fac;
    LDS_WAIT(); asm volatile("" ::: "memory");
    bf16_t* pa = Obase + (size_t)hi * DM + l32;
    unsigned short old[4][16];
    if (!FIRST) {
        bf16_t* pl = pa;
#pragma unroll
        for (int a = 0; a < 4; ++a) {
            asm volatile("" : "+v"(pl));
#pragma unroll
            for (int i2 = 0; i2 < 4; ++i2)
#pragma unroll
                for (int d = 0; d < 4; ++d) old[a][i2 * 4 + d] = pl[i2 * 128 + 32 * d];
            pl += 2 * DM; }
        asm volatile("" ::: "memory");
    }
#pragma unroll
    for (int a = 0; a < 4; ++a) { const f32x4 f = *(LAS const f32x4*)(wsf + 8 * a + 4 * hi);
        asm volatile("" : "+v"(pa));
#pragma unroll
        for (int i2 = 0; i2 < 4; ++i2)
#pragma unroll
            for (int d = 0; d < 4; ++d) { bf16_t* op = pa + i2 * 128 + 32 * d; float v = o[d][4 * a + i2] * f[i2]; if (!FIRST) v += bf2f(old[a][i2 * 4 + d]); *op = (bf16_t)f2bf(v); o[d][4 * a + i2] = 0.f; }
        pa += 2 * DM; }
    LDS_WAIT(); asm volatile("" ::: "memory");
}

__device__ __forceinline__ void unit(LAS unsigned char* lds, const bf16_t* KVH, const bf16_t* QH, const bf16_t* KCMP, const float* GATES, bf16_t* O, int b, int g, int qt, int tid, int wave, int lane) {
    asm volatile("" : "+v"(tid)); lane = tid & 63; wave = __builtin_amdgcn_readfirstlane(tid >> 6);
    const int l32 = lane & 31, hi = lane >> 5, tokl = l32 >> 2, rr = l32 & 3;
    const int t0 = qt * 64, t = t0 + wave * 8 + tokl;
    const size_t bg = (size_t)b * 4 + g;
    LAS float* impw = (LAS float*)(lds + L_IMP + wave * IMP_WAVE);
    LAS unsigned* selm = (LAS unsigned*)(lds + L_SELM + wave * 128);
    LAS unsigned* uni = (LAS unsigned*)(lds + L_UNI);
    LAS int* NTL = (LAS int*)(lds + L_NTL); LAS int* TL = (LAS int*)(lds + L_TL);
    LAS float* wsf = (LAS float*)(lds + L_WSF + wave * 128);
    for (int i = lane; i < 8 * IMP_LD; i += 64) impw[i] = 0.f;
    if (tid < 4) uni[tid] = 0u;
    bf16x8 qf[8];
    { const bf16_t* qp = QH + ((bg * 8192 + t0 + wave * 8) * 4 + l32) * 128 + 8 * hi;
#pragma unroll
      for (int s = 0; s < 8; ++s) qf[s] = *(const bf16x8*)(qp + 16 * s); }
    const float* gp = GATES + ((size_t)b * 8192 + t) * 48 + (g * 4 + rr) * 3;
    const float g_cmp = gp[0], g_slc = gp[1], g_win = gp[2];
    bf16_t* Obase = O + ((size_t)b * 8192 + t0 + wave * 8) * DM + g * 512;
    f32x16 o[4];
#pragma unroll
    for (int d = 0; d < 4; ++d)
#pragma unroll
        for (int r = 0; r < 16; ++r) o[d][r] = 0.f;
    LDS_WAIT(); __builtin_amdgcn_s_barrier(); asm volatile("" ::: "memory");
    const bf16_t* Kc = KCMP + bg * 512 * 128; const bf16_t* Vc = KCMP + (size_t)4096 * 128 + bg * 512 * 128;
    const int ntc = ((4 * qt + 2) >> 6) + 1;
    { float l = 0.f;
      run_tiles<0, 0>(lds, Kc, Vc, ntc, 0, qt, qf, o, l, t, 0u, 0u, 0u, 0u, 1.f, 1.f, tid, wave, lane);
      const float ltot = l + xhalf(l); const float inv = ltot > 0.f ? 1.f / ltot : 0.f;
      run_tiles<0, 1>(lds, Kc, Vc, ntc, 0, qt, qf, o, l, t, 0u, 0u, 0u, 0u, inv, g_cmp, tid, wave, lane); }
    flush<true>(o, 1.f, Obase, wsf, l32, hi);
    {
        const int tk = lane >> 3, j = lane & 7; const int nvalid = qt + 1;
        unsigned m0 = 0u, m1 = 0u, m2 = 0u, m3 = 0u;
        auto setbit = [&](int s) { const unsigned bit = 1u << (s & 31); const int w = s >> 5; m0 |= (w == 0) ? bit : 0u; m1 |= (w == 1) ? bit : 0u; m2 |= (w == 2) ? bit : 0u; m3 |= (w == 3) ? bit : 0u; };
        if (nvalid <= 16) { for (int s2 = 0; s2 < nvalid; ++s2) setbit(s2); }
        else {
            setbit(0); setbit(qt); setbit(qt - 1);
            unsigned key[16];
#pragma unroll
            for (int i = 0; i < 16; ++i) { const int s2 = 16 * j + i; const float v = impw[tk * IMP_LD + s2];
                const bool cand = (s2 < nvalid) && (s2 != 0) && (s2 != qt) && (s2 != qt - 1);
                key[i] = cand ? ((__float_as_uint(fmaxf(v, 0.f)) & ~0x7Fu) + (unsigned)(128 - s2)) : 0u; }
            for (int round = 0; round < 13; ++round) {
                unsigned mx = key[0];
#pragma unroll
                for (int i = 1; i < 16; ++i) mx = mx > key[i] ? mx : key[i];
                unsigned o1 = (unsigned)my_shfl_xor((int)mx, 1); mx = mx > o1 ? mx : o1;
                o1 = (unsigned)my_shfl_xor((int)mx, 2); mx = mx > o1 ? mx : o1;
                o1 = (unsigned)my_shfl_xor((int)mx, 4); mx = mx > o1 ? mx : o1;
                if (mx != 0u) { const int sw = (128 - (int)(mx & 0x7Fu)) & 127; setbit(sw); }
#pragma unroll
                for (int i = 0; i < 16; ++i) key[i] = (key[i] == mx) ? 0u : key[i];
            }
        }
        if (j == 0) { selm[tk * 4 + 0] = m0; selm[tk * 4 + 1] = m1; selm[tk * 4 + 2] = m2; selm[tk * 4 + 3] = m3;
            atomicOr((unsigned*)(uni + 0), m0); atomicOr((unsigned*)(uni + 1), m1); atomicOr((unsigned*)(uni + 2), m2); atomicOr((unsigned*)(uni + 3), m3); }
    }
    LDS_WAIT(); __builtin_amdgcn_s_barrier(); asm volatile("" ::: "memory");
    if (tid == 0) { int n = 0; for (int w = 0; w < 4; ++w) { unsigned u = uni[w]; while (u) { const int bpos = __builtin_ctz(u); u &= u - 1; TL[n++] = 32 * w + bpos; } } NTL[0] = n; }
    LDS_WAIT(); __builtin_amdgcn_s_barrier(); asm volatile("" ::: "memory");
    const unsigned sw0 = selm[tokl * 4 + 0], sw1 = selm[tokl * 4 + 1], sw2 = selm[tokl * 4 + 2], sw3 = selm[tokl * 4 + 3];
    const int nsel = __builtin_amdgcn_readfirstlane(NTL[0]);
    { const bf16_t* Ks = KVH + 2 * KVH_SLOT + bg * 8192 * 128; const bf16_t* Vs = KVH + 3 * KVH_SLOT + bg * 8192 * 128;
      float l = 0.f;
      run_tiles<1, 2>(lds, Ks, Vs, nsel, 0, qt, qf, o, l, t, sw0, sw1, sw2, sw3, 1.f, 1.f, tid, wave, lane);
      const float ltot = l + xhalf(l);
      flush<false>(o, ltot > 0.f ? g_slc / ltot : 0.f, Obase, wsf, l32, hi); }
    { const bf16_t* Kw = KVH + 4 * KVH_SLOT + bg * 8192 * 128; const bf16_t* Vw = KVH + 5 * KVH_SLOT + bg * 8192 * 128;
      const int first = qt >= 8 ? qt - 8 : 0; float l = 0.f;
      run_tiles<2, 2>(lds, Kw, Vw, qt - first + 1, first, qt, qf, o, l, t, 0u, 0u, 0u, 0u, 1.f, 1.f, tid, wave, lane);
      const float ltot = l + xhalf(l);
      flush<false>(o, ltot > 0.f ? g_win / ltot : 0.f, Obase, wsf, l32, hi); }
    LDS_WAIT(); __builtin_amdgcn_s_barrier(); asm volatile("" ::: "memory");
}
}


constexpr size_t WS_CTL = WS_MISC + 63 * MiB; constexpr size_t CTL_ZERO_BYTES = 16384;
#define XB_TMO      128
#define XB_XCNT(j)  (256  + 64 * (j))
#define XB_XSUB(j)  (1280 + 64 * (j))
#define XB_XGEN(j)  (2304 + 64 * (j))
#define XB_TOP      3328
#define XB_TOPGEN   3392
#define XB_SPIN_CAP (1u << 18)
__device__ __forceinline__ unsigned xb_ld(unsigned* p)              { return __hip_atomic_load(p, __ATOMIC_RELAXED, __HIP_MEMORY_SCOPE_AGENT); }
__device__ __forceinline__ unsigned xb_add(unsigned* p, unsigned v) { return __hip_atomic_fetch_add(p, v, __ATOMIC_RELAXED, __HIP_MEMORY_SCOPE_AGENT); }
__device__ __forceinline__ unsigned xb_xcc_id() { return (unsigned)__builtin_amdgcn_s_getreg((3 << 11) | 20) & 0xFu; }
#define XB_SPIN(cond, bar) do { unsigned _sp = 0; while (cond) { __builtin_amdgcn_s_sleep(1); \
    if ((++_sp & 255u) == 0u) { if (xb_ld(&(bar)[XB_TMO])) break; if (_sp > XB_SPIN_CAP) { atomicAdd(&(bar)[XB_TMO], 1u); break; } } } } while (0)
struct XcdBarrier { unsigned* bar; unsigned x; volatile LAS unsigned* st; };
__device__ __forceinline__ XcdBarrier xcd_barrier_post(unsigned* bar, volatile LAS unsigned* st, bool t0) {
    XcdBarrier b; b.bar = bar; b.x = xb_xcc_id(); b.st = st;
    if (t0) (void)xb_add(&bar[XB_XCNT(b.x)], 1u);
    return b;
}
__device__ __forceinline__ void xcd_barrier_complete(unsigned* bar, unsigned x, unsigned& nloc, unsigned& nx) {
    const unsigned G = gridDim.x * gridDim.y * gridDim.z;
    unsigned sum, cnt, mine, sp = 0u;
    for (;;) {
        sum = 0u; cnt = 0u; mine = 0u;
#pragma unroll
        for (unsigned j = 0; j < 16; ++j) { const unsigned c = xb_ld(&bar[XB_XCNT(j)]); sum += c; cnt += (c > 0u) ? 1u : 0u; mine = (j == x) ? c : mine; }
        if (sum == G) break;
        __builtin_amdgcn_s_sleep(1);
        if ((++sp & 255u) == 0u) { if (xb_ld(&bar[XB_TMO])) break; if (sp > XB_SPIN_CAP) { atomicAdd(&bar[XB_TMO], 1u); break; } }
    }
    nloc = mine > 0u ? mine : 1u; nx = cnt > 0u ? cnt : 1u;
}
__device__ __forceinline__ void xcd_barrier(const XcdBarrier& b, bool t0) {
    asm volatile("s_waitcnt vmcnt(0)" ::: "memory");
    __syncthreads();
    if (t0) {
        unsigned* bar = b.bar;
        __builtin_amdgcn_s_waitcnt(0);
        unsigned nloc = b.st[0], nx = b.st[1];
        if (nloc == 0u) { xcd_barrier_complete(bar, b.x, nloc, nx); b.st[0] = nloc; b.st[1] = nx; }
        const unsigned old = xb_add(&bar[XB_XSUB(b.x)], 1u);
        const unsigned gen = old / nloc;
        if (old + 1u == (gen + 1u) * nloc) {
            __builtin_amdgcn_fence(__ATOMIC_RELEASE, "agent");
            asm volatile("s_waitcnt vmcnt(0)" ::: "memory");
            const unsigned og = xb_add(&bar[XB_TOP], 1u);
            const unsigned tg = og / nx;
            if (og + 1u == (tg + 1u) * nx) xb_add(&bar[XB_TOPGEN], 1u);
            else XB_SPIN(xb_ld(&bar[XB_TOPGEN]) == tg, bar);
            __builtin_amdgcn_fence(__ATOMIC_ACQUIRE, "agent");
            xb_add(&bar[XB_XGEN(b.x)], 1u);
            asm volatile("s_waitcnt vmcnt(0)" ::: "memory");
        } else {
            XB_SPIN(xb_ld(&bar[XB_XGEN(b.x)]) == gen, bar);
            __builtin_amdgcn_fence(__ATOMIC_ACQUIRE, "agent");
            asm volatile("s_waitcnt vmcnt(0)" ::: "memory");
        }
    }
    __syncthreads();
}

__global__ void __launch_bounds__(NTHREADS, 2) fwd_kernel(Args args) {
    extern __shared__ __attribute__((aligned(16))) unsigned char lds_raw[];
    LAS unsigned char* lds = (LAS unsigned char*)lds_raw;
    cg::grid_group grid = cg::this_grid();
    const int G = gridDim.x;
    const int NGW = G * NWAVES, gthreads = G * NTHREADS;
#define bid ({ int b_ = (int)blockIdx.x; asm volatile("" : "+s"(b_)); b_; })
    const int wave0 = __builtin_amdgcn_readfirstlane((int)threadIdx.x >> 6);
#define lane ({ int l_; asm volatile("v_mbcnt_lo_u32_b32 %0, -1, 0\n\tv_mbcnt_hi_u32_b32 %0, -1, %0" : "=v"(l_)); l_; })
#define wave wave0
#define tid (wave0 * 64 + lane)
#define gw (bid * NWAVES + wave)
#define gtid (bid * NTHREADS + tid)
#define ws ((unsigned char*)argp(30))
#define XF ((float*)argp(29))
#define XB ((bf16_t*)(ws + WS_XB))
#define HID ((bf16_t*)(ws + OV_HID))
#define ln_g INP(I_LNG)
#define ln_b INP(I_LNB)
#define T1 ((bf16_t*)(ws + OV_T1))
#define T2 ((bf16_t*)(ws + OV_T2))
#define T3 ((bf16_t*)(ws + OV_T3))
#define STP ((f32x2*)(ws + MS_STATS))
#define GSYNC_CG() do { asm volatile("s_waitcnt vmcnt(0) lgkmcnt(0)" ::: "memory"); grid.sync(); asm volatile("s_waitcnt vmcnt(0) lgkmcnt(0)" ::: "memory"); __builtin_amdgcn_s_barrier(); asm volatile("" ::: "memory"); } while (0)
#define GSYNC() do { asm volatile("s_waitcnt vmcnt(0) lgkmcnt(0)" ::: "memory"); XcdBarrier xb_; xb_.bar = (unsigned*)(ws + WS_CTL); xb_.x = xb_xcc_id(); xb_.st = (volatile LAS unsigned*)(lds + LDS_BYTES - 64); xcd_barrier(xb_, tid == 0); asm volatile("" ::: "memory"); } while (0)
    volatile LAS unsigned* xst = (volatile LAS unsigned*)(lds + LDS_BYTES - 64);
    if (tid == 0) { xst[0] = 0u; xst[1] = 0u; }
    __syncthreads();
    (void)xcd_barrier_post((unsigned*)(ws + WS_CTL), xst, tid == 0);

    {
        LAS float* scr = (LAS float*)(lds + wave * 16384);
        conv_matrix<0>(INP(I_S5_WIN), 2048, 2048, 2048, (bf16_t*)(ws + WS_WIN), 2048, 0, scr, gw, NGW, lane);
        conv_matrix<1>(INP(I_S5_WGLU), 2048, 4096, 4096, (bf16_t*)(ws + WS_WGLU), 2048, 0, scr, gw, NGW, lane);
        conv_matrix<0>(INP(I_S5_WOUT), 2048, 2048, 2048, (bf16_t*)(ws + WS_WOUT), 2048, 0, scr, gw, NGW, lane);
        conv_matrix<0>(INP(I_KVW), 2048, 3072, 3072, (bf16_t*)(ws + WS_WKVQ), 2048, 0, scr, gw, NGW, lane);
        conv_matrix<0>(INP(I_WQG), 2048, 2096, 2048, (bf16_t*)(ws + WS_WKVQ), 2048, 3072, scr, gw, NGW, lane);
        conv_matrix<0>(INP(I_WQG) + 2048, 2048, 2096, 48, (bf16_t*)(ws + WS_WKVQ), 2048, 5120, scr, gw, NGW, lane);
        conv_matrix<0>(INP(I_WNO), 2048, 2048, 2048, (bf16_t*)(ws + WS_WNO), 2048, 0, scr, gw, NGW, lane);
        for (int l = 0; l < 2; ++l) {
            cvt_rows(INP(I_MWQ) + (size_t)l * 2048 * 2048, (bf16_t*)(ws + WS_WMQ + l * 8 * MiB), (size_t)2048 * 2048, gtid, gthreads);
            conv_matrix<0>(INP(I_MWKV) + (size_t)l * 2048 * 4096, 2048, 4096, 4096, (bf16_t*)(ws + WS_WMKV + l * 16 * MiB), 2048, 0, scr, gw, NGW, lane);
            conv_matrix<0>(INP(I_MWO) + (size_t)l * 2048 * 2048, 2048, 2048, 2048, (bf16_t*)(ws + WS_WMO + l * 8 * MiB), 2048, 0, scr, gw, NGW, lane);
            conv_matrix<0>(INP(I_WUP) + (size_t)l * 2048 * 8192, 2048, 8192, 8192, (bf16_t*)(ws + WS_WUP + l * 32 * MiB), 2048, 0, scr, gw, NGW, lane);
            conv_matrix<0>(INP(I_WDN) + (size_t)l * 8192 * 2048, 8192, 2048, 2048, (bf16_t*)(ws + WS_WDN + l * 32 * MiB), 8192, 0, scr, gw, NGW, lane);
        }
        cvt_rows(INP(I_X), XB, (size_t)MTOK * DM, gtid, gthreads);
        cvt_rows(INP(I_MEM), (bf16_t*)(ws + MS_MEMB), (size_t)512 * DM, gtid, gthreads);
        for (int q = 0; q < 4; ++q) { const int which = q >> 1, half = q & 1;
            conv_matrix<0>((which ? INP(I_CW1V) : INP(I_CW1K)) + (size_t)half * 2048 * 128, 2048, 128, 128, (bf16_t*)(ws + WS_WC1 + which * MiB), 2048, 128 * half, scr, gw, NGW, lane); }
        if (bid == G - 1) cmp_bias(INP(I_CPK), INP(I_CW1K), INP(I_CPV), INP(I_CW1V), (float*)(ws + MS_CB), tid);
        s5_tables(INP(I_S5_ARE), INP(I_S5_AIM), INP(I_S5_LOGDT), INP(I_S5_BRE), INP(I_S5_BIM), INP(I_S5_CRE), INP(I_S5_CIM), ws, gtid, gthreads);
    }
    GSYNC_CG();
    for (int layer = 0; layer < 2; ++layer) {

        if (layer == 0) {
            { pg8::Gemm g{XB, (const bf16_t*)(ws + WS_WIN), DM, DM, DM}; pg8::StaticOrder S; S.init(MTOK, DM, DM, DM, G, bid);
              pg8::EpiCols8<StoreBf16> E{StoreBf16{T1, DM, 1.f}}; pg8::gemm_phase(lds, g, S, E, wave0); }
            { pg8::Gemm g{(const bf16_t*)(ws + MS_MEMB), (const bf16_t*)(ws + WS_WMKV), DM, DM, DM}; KvSched S{G, bid};
              pg8::EpiCols8<StoreBf16Z> E{StoreBf16Z{(bf16_t*)(ws + MS_MKV), 4096, 1.f, (size_t)512 * 4096}}; pg8::gemm_phase(lds, g, S, E, wave0); }
            GSYNC();
            s5_pass<false>(T1, T2, INP(I_S5_D), ws, lds, gw, NGW, wave, lane);
            GSYNC();
            s5_pass<true>(T1, T2, INP(I_S5_D), ws, lds, gw, NGW, wave, lane);
            GSYNC();
            { pg8::Gemm g{T2, (const bf16_t*)(ws + WS_WGLU), DM, DM, DM}; pg8::StaticOrder S; S.init(MTOK, 2 * DM, DM, DM, G, bid);
              EpiGlu E{T1, DM}; pg8::gemm_phase(lds, g, S, E, wave0); }
            { pg8::Gemm g{(const bf16_t*)(ws + MS_MKV), (const bf16_t*)(ws + WS_WMQ), 4096, 2048, 512}; MtSched S{G, bid};
              pg8::EpiCols8<StoreBf16Z> E{StoreBf16Z{(bf16_t*)(ws + WS_MT), 2048, 0.044194173824159216f * 1.4426950408889634f, (size_t)1024 * 2048}}; pg8::gemm_phase(lds, g, S, E, wave0); }
            { pg8::Gemm g{(const bf16_t*)(ws + WS_WMO), (const bf16_t*)(ws + MS_MKV), 2048, 4096, 512}; VwSched S{G, (G == 256) ? ((bid + 128) & 255) : bid};
              pg8::EpiCols8<StoreBf16Z> E{StoreBf16Z{(bf16_t*)(ws + WS_VWT), 1024, 1.f, (size_t)2048 * 1024}}; pg8::gemm_phase(lds, g, S, E, wave0); }
            GSYNC();
            { pg8::Gemm g{T1, (const bf16_t*)(ws + WS_WOUT), DM, DM, DM}; pg8::StaticOrder S; S.init(MTOK, DM, DM, DM, G, bid);
              pg8::EpiRes<0> E{INP(I_X), XF, nullptr, nullptr, nullptr, DM, DN_ALPHA}; pg8::gemm_phase(lds, g, S, E, wave0); }
            GSYNC();
            ln_phase<false>(XF, 1.f, XF, XB, STP, ln_g + (layer * 3 + 0) * DM, ln_b + (layer * 3 + 0) * DM, gw, NGW, lane);
        } else {
            { pg8::Gemm g{XB, (const bf16_t*)(ws + WS_WKVQ), DM, DM, DM}; pg8::StaticOrder S; S.init(MTOK, 5376, DM, DM, G, bid);
              pg8::EpiCols8<StoreKVQ> E{StoreKVQ{(bf16_t*)(ws + OV_KVH), (bf16_t*)(ws + OV_QH), (float*)(ws + MS_GATES), 0.08838834764831845f * 1.4426950408889634f}}; pg8::gemm_phase(lds, g, S, E, wave0); }
            GSYNC();
            { pg8::Gemm g{(const bf16_t*)(ws + OV_KVH), (const bf16_t*)(ws + WS_WC1), 2048, 2048, 512}; CmpSched S{G, bid};
              pg8::EpiCols8<StoreF32> E{StoreF32{(float*)(ws + MS_PAB), 256, (size_t)4096 * 256}}; pg8::gemm_phase(lds, g, S, E, wave0); }
            GSYNC();
            cmp_combine((const float*)(ws + MS_PAB), (const float*)(ws + MS_CB), INP(I_CW2K), INP(I_CW2V), (bf16_t*)(ws + MS_KCMP), gw, NGW, lane);
            GSYNC();
            for (int vb = bid; vb < 256; vb += G) {
                const int bgi = vb >> 5, sidx = vb & 31;
                for (int i = 0; i < 4; ++i) { const int qt = (i == 0) ? sidx : (i == 1) ? 63 - sidx : (i == 2) ? 64 + sidx : 127 - sidx;
                    nsa::unit(lds, (const bf16_t*)(ws + OV_KVH), (const bf16_t*)(ws + OV_QH), (const bf16_t*)(ws + MS_KCMP), (const float*)(ws + MS_GATES), T1, bgi >> 2, bgi & 3, qt, tid, wave, lane); }
            }
            GSYNC();
            { pg8::Gemm g{T1, (const bf16_t*)(ws + WS_WNO), DM, DM, DM}; pg8::StaticOrder S; S.init(MTOK, DM, DM, DM, G, bid);
              pg8::EpiRes<1> E{XF, XF, STP, ln_g + 2 * DM, ln_b + 2 * DM, DM, DN_ALPHA}; pg8::gemm_phase(lds, g, S, E, wave0); }
            GSYNC();
            ln_phase<false>(XF, 1.f, XF, XB, STP, ln_g + (layer * 3 + 0) * DM, ln_b + (layer * 3 + 0) * DM, gw, NGW, lane);
        }
        GSYNC();
        for (int base = 0; base < 256; base += G) {
            pg8::Gemm g{XB, (const bf16_t*)(ws + WS_MT), DM, DM, DM}; ScoreSched S{G, bid, base, (base + G < 256) ? base + G : 256, layer};
            EpiSoftmax E{T2}; pg8::gemm_phase(lds, g, S, E, wave0);
        }
        GSYNC();
        { pg8::Gemm g{T2, (const bf16_t*)(ws + WS_VWT), 1024, 1024, 1024}; PvoSched S; S.so.init(MTOK, DM, 1024, 1024, G, bid); S.layer = layer;
          pg8::EpiRes<1> E{XF, XF, STP, ln_g + (layer * 3 + 0) * DM, ln_b + (layer * 3 + 0) * DM, DM, DN_ALPHA}; pg8::gemm_phase(lds, g, S, E, wave0); }
        GSYNC();
        ln_phase<false>(XF, 1.f, XF, XB, STP, ln_g + (layer * 3 + 1) * DM, ln_b + (layer * 3 + 1) * DM, gw, NGW, lane);
        GSYNC();
        {
            pg8::Gemm g{XB, (const bf16_t*)(ws + WS_WUP + layer * 32 * MiB), DM, DM, DM};
            pg8::StaticOrder S; S.init(MTOK, DFF, DM, DM, G, bid);
            pg8::EpiCols8<StoreRelu2> E{StoreRelu2{HID, DFF}};
            pg8::gemm_phase(lds, g, S, E, wave0);
        }
        GSYNC();
        {
            pg8::Gemm g{HID, (const bf16_t*)(ws + WS_WDN + layer * 32 * MiB), DFF, DFF, DFF};
            pg8::StaticOrder S; S.init(MTOK, DM, DFF, DFF, G, bid);
            pg8::EpiRes<1> E{XF, XF, STP, ln_g + (layer * 3 + 1) * DM, ln_b + (layer * 3 + 1) * DM, DM, DN_ALPHA};
            pg8::gemm_phase(lds, g, S, E, wave0);
        }
        GSYNC();
        if (layer == 1) ln_phase<true>(XF, 1.f, XF, XB, STP, ln_g + (layer * 3 + 2) * DM, ln_b + (layer * 3 + 2) * DM, gw, NGW, lane);
        else ln_phase<false>(XF, 1.f, XF, XB, STP, ln_g + (layer * 3 + 2) * DM, ln_b + (layer * 3 + 2) * DM, gw, NGW, lane);
        if (layer == 0) GSYNC();
    }
}

#undef ws
#undef XF
#undef XB
#undef HID
#undef ln_g
#undef ln_b
#undef T1
#undef T2
#undef T3
#undef STP
#undef bid
#undef tid
#undef lane
#undef wave
#undef gw
#undef gtid
extern "C" void kernel_launch(void* const* d_in, const int* in_sizes, int n_in, void* d_out, int out_size, void* d_ws, size_t ws_size, hipStream_t stream) {
    static int grid = 0;
    if (grid == 0) {
        if (n_in != 29 || ws_size < WS_END) { fprintf(stderr, "kernel_launch: unexpected n_in %d or ws %zu (< %zu)\n", n_in, ws_size, (size_t)WS_END); grid = -1; return; }
        int dev = 0, cus = 0, per_cu = 0;
        hipGetDevice(&dev); hipDeviceGetAttribute(&cus, hipDeviceAttributeMultiprocessorCount, dev);
        hipFuncSetAttribute((const void*)fwd_kernel, hipFuncAttributeMaxDynamicSharedMemorySize, LDS_BYTES);
        hipOccupancyMaxActiveBlocksPerMultiprocessor(&per_cu, (const void*)fwd_kernel, NTHREADS, LDS_BYTES);
        if (per_cu < 1) { fprintf(stderr, "kernel_launch: occupancy query says %d blocks/CU\n", per_cu); per_cu = 1; }
        (void)hipGetLastError();
        grid = cus;
    }
    if (grid < 0) return;
    if (hipMemsetAsync((char*)d_ws + WS_CTL, 0, CTL_ZERO_BYTES, stream) != hipSuccess) { fprintf(stderr, "kernel_launch: memset of the barrier words failed\n"); return; }
    Args a{};
    for (int i = 0; i < 29; ++i) a.in[i] = (const float*)d_in[i];
    a.out = (float*)d_out; a.ws = (unsigned char*)d_ws; a.ph_lo = 0; a.ph_hi = 100;
    void* kargs[] = {&a};
    hipError_t e = hipLaunchCooperativeKernel((const void*)fwd_kernel, dim3(grid), dim3(NTHREADS), kargs, LDS_BYTES, stream);
    if (e != hipSuccess) fprintf(stderr, "cooperative launch failed: %s (grid %d)\n", hipGetErrorString(e), grid);
}
```

```cpp
#include <hip/hip_runtime.h>
#include <hip/hip_cooperative_groups.h>
#include <cstdio>
#include <cstdint>
namespace cg = cooperative_groups;

#define LAS __attribute__((address_space(3)))
typedef unsigned short bf16_t;
typedef short bf16x8 __attribute__((ext_vector_type(8)));
typedef float f32x4 __attribute__((ext_vector_type(4)));
typedef float f32x2 __attribute__((ext_vector_type(2)));
typedef float f32x16 __attribute__((ext_vector_type(16)));
typedef unsigned u32x4 __attribute__((ext_vector_type(4)));
typedef unsigned u32x2 __attribute__((ext_vector_type(2)));

constexpr int SEQ = 8192, BATCH = 2, DM = 2048, MTOK = BATCH * SEQ, DFF = 8192;
constexpr float LN_EPS = 1e-5f;
constexpr float DN_ALPHA = 1.4142135623730951f;
constexpr int NWAVES = 8, NTHREADS = 512;
constexpr int LDS_BYTES = 147456;

constexpr size_t MiB = 1u << 20;
constexpr size_t WS_WIN = 0;
constexpr size_t WS_WGLU = WS_WIN + 8 * MiB;
constexpr size_t WS_WOUT = WS_WGLU + 16 * MiB;
constexpr size_t WS_WKVQ = WS_WOUT + 8 * MiB;
constexpr size_t WS_WNO = WS_WKVQ + 22 * MiB;
constexpr size_t WS_WMQ = WS_WNO + 8 * MiB;
constexpr size_t WS_WMKV = WS_WMQ + 16 * MiB;
constexpr size_t WS_WMO = WS_WMKV + 32 * MiB;
constexpr size_t WS_WUP = WS_WMO + 16 * MiB;
constexpr size_t WS_WDN = WS_WUP + 64 * MiB;
constexpr size_t WS_WC1 = WS_WDN + 64 * MiB;
constexpr size_t WS_XB = WS_WC1 + 2 * MiB;
constexpr size_t WS_OVL = WS_XB + 64 * MiB;
constexpr size_t WS_MISC = WS_OVL + 256 * MiB;
constexpr size_t WS_END = WS_MISC + 64 * MiB;
constexpr size_t OV_T1 = WS_OVL;
constexpr size_t OV_T2 = WS_OVL + 64 * MiB;
constexpr size_t OV_T3 = WS_OVL + 128 * MiB;
constexpr size_t OV_KV = WS_OVL + 128 * MiB;
constexpr size_t OV_HID = WS_OVL;
constexpr size_t MS_MEMB = WS_MISC;
constexpr size_t MS_MKV = WS_MISC + 2 * MiB;
constexpr size_t MS_MK = WS_MISC + 2 * MiB;
constexpr size_t MS_MVT = WS_MISC + 6 * MiB;
constexpr size_t MS_S5AB = WS_MISC + 10 * MiB;
constexpr size_t MS_S5ABL = MS_S5AB + 65536;
constexpr size_t MS_S5BM = MS_S5ABL + 65536;
constexpr size_t MS_S5CM = MS_S5BM + 524288;
constexpr size_t MS_S5E = MS_S5CM + 524288;
constexpr size_t MS_S5SIN = MS_S5E + 1048576;
constexpr int S5_NCH = 8, S5_LC = SEQ / S5_NCH;
constexpr size_t MS_STATS = WS_MISC + 14 * MiB;
constexpr size_t WS_MT = WS_MISC + 22 * MiB;
constexpr size_t WS_VWT = WS_MISC + 38 * MiB;
constexpr size_t MS_GATES = WS_MISC + 16 * MiB;
constexpr size_t MS_CB = WS_MISC + 20 * MiB;
constexpr size_t MS_PAB = OV_T1;
constexpr size_t MS_KCMP = WS_MISC + 54 * MiB;
constexpr size_t OV_KVH = WS_OVL + 64 * MiB;
constexpr size_t OV_QH = WS_OVL + 160 * MiB;
constexpr size_t KVH_SLOT = (size_t)2 * 4 * 8192 * 128;

__device__ __forceinline__ unsigned f2bf(float f) { unsigned u = __builtin_bit_cast(unsigned, f); return (u + 0x7fffu + ((u >> 16) & 1u)) >> 16; }
__device__ __forceinline__ unsigned pk2(float lo, float hi) { unsigned r; asm volatile("v_cvt_pk_bf16_f32 %0, %1, %2" : "=v"(r) : "v"(lo), "v"(hi)); return r; }
__device__ __forceinline__ float bf2f(unsigned short h) { return __builtin_bit_cast(float, (unsigned)h << 16); }

__device__ __forceinline__ int lane_now() { int l_; asm volatile("v_mbcnt_lo_u32_b32 %0, -1, 0\n\tv_mbcnt_hi_u32_b32 %0, -1, %0" : "=v"(l_)); return l_; }
__device__ __forceinline__ float my_shfl_xor(float v, int o) { return __builtin_bit_cast(float, __builtin_amdgcn_ds_bpermute((lane_now() ^ o) << 2, __builtin_bit_cast(int, v))); }
__device__ __forceinline__ int my_shfl_xor(int v, int o) { return __builtin_amdgcn_ds_bpermute((lane_now() ^ o) << 2, v); }
__device__ __forceinline__ float my_shfl(float v, int src) { return __builtin_bit_cast(float, __builtin_amdgcn_ds_bpermute(src << 2, __builtin_bit_cast(int, v))); }
__device__ __forceinline__ float wave_sum(float v) {
#pragma unroll
    for (int o = 1; o < 64; o <<= 1) v += my_shfl_xor(v, o);
    return v;
}
#define LDS_WAIT() asm volatile("s_waitcnt lgkmcnt(0)" ::: "memory")

namespace pg8 {
constexpr int BM = 256, BK = 64, HALF = 128, HTB = HALF * BK * 2, STAGE_BYTES = 8 * HTB, NXCD = 8, WGM = 8;
__host__ __device__ __forceinline__ int lds_byte(int r, int c) { const int st = (r >> 4) * 2 + (c >> 5), rr = r & 15, cc = c & 31, ob = rr * 64 + cc * 2; return st * 1024 + (ob ^ (((ob >> 9) & 1) << 5)); }
__host__ __device__ __forceinline__ void stage_rc(int b, int& R, int& C) { const int st = b / 1024, sb = b % 1024, swz = sb ^ (((sb >> 9) & 1) << 5); R = (st >> 1) * 16 + swz / 64; C = (st & 1) * 32 + (swz % 64) / 2; }
__host__ __device__ __forceinline__ int perm32(int rho) { const int n = rho >> 4, i = rho & 15; return 8 * (i >> 2) + 4 * n + (i & 3); }

struct Unit { int pm, pn, z; unsigned ao, bo; };
struct Gemm { const bf16_t* A; const bf16_t* Bt; int lda, ldb, K; };

struct StaticOrder {
    int nM, nN, nwg, G, c; unsigned ta, tb;
    __device__ void init(int M, int N, int lda, int ldb, int G_, int c_) { nM = M / BM; nN = N / BM; nwg = nM * nN; G = G_; c = c_; ta = (unsigned)BM * lda * 2; tb = (unsigned)BM * ldb * 2; }
    __device__ bool next(int i, Unit& u) const {
        const long L = (long)i * G + c; if (L >= nwg) return false;
        int wgid = (int)L; { const int q = nwg / NXCD, r = nwg % NXCD, xcd = wgid % NXCD, off = wgid / NXCD; wgid = (xcd < r ? xcd * (q + 1) : r * (q + 1) + (xcd - r) * q) + off; }
        const int nig = WGM * nN, gid = wgid / nig, fm = gid * WGM, gsz = (nM - fm) < WGM ? (nM - fm) : WGM;
        u.pm = fm + ((wgid % nig) % gsz); u.pn = (wgid % nig) / gsz; u.z = 0; u.ao = (unsigned)u.pm * ta; u.bo = (unsigned)u.pn * tb; return true;
    }
};

__device__ __forceinline__ unsigned cvt_pk_bf16(float lo, float hi) { unsigned r; asm volatile("v_cvt_pk_bf16_f32 %0, %1, %2" : "=v"(r) : "v"(lo), "v"(hi)); return r; }


template <class Epi, class Sched>
__device__ __forceinline__ void gemm_phase(LAS unsigned char* lds, const Gemm g, const Sched& S, const Epi& E, int wv) {
    int tid; asm volatile("v_mbcnt_lo_u32_b32 %0, -1, 0\n\tv_mbcnt_hi_u32_b32 %0, -1, %0" : "=v"(tid)); tid += wv * 64;
    const int wid = __builtin_amdgcn_readfirstlane(tid >> 6), lane = tid & 63, wr = wid >> 2, wc = wid & 3, fr = lane & 15, fq = lane >> 4;
    int nt = g.K / BK; asm volatile("" : "+s"(nt));
    unsigned voffA[2], voffB[2];
#pragma unroll
    for (int i = 0; i < 2; ++i) { int R, C; stage_rc(tid * 16 + i * 8192, R, C); const int Rb = Epi::PERM ? ((R & ~31) + perm32(R & 31)) : R;
        voffA[i] = (unsigned)(R * g.lda + C) * 2u; voffB[i] = (unsigned)(Rb * g.ldb + C) * 2u; }
    const size_t kstep = (size_t)(BK * 2);
    const size_t hsA = (size_t)HALF * g.lda * 2, hsB = (size_t)HALF * g.ldb * 2;
    const unsigned ldsw = (unsigned)wid * 1024u;
    const int aoff = lds_byte(wr * 64 + fr, fq * 8), boff = lds_byte(wc * 32 + fr, fq * 8);
#define PG8_SA(b, h) (((b) * 2 + (h)) * HTB)
#define PG8_SB(b, h) ((4 + (b) * 2 + (h)) * HTB)
#define PG8_STAGE(bufoff, gbase, voff) do { _Pragma("unroll") for (int _i = 0; _i < 2; ++_i) \
        __builtin_amdgcn_global_load_lds((const unsigned*)((const char*)(gbase) + (voff)[_i]), (LAS unsigned*)(lds + (bufoff) + ldsw + _i * 8192), 16, 0, 0); } while (0)
#define PG8_LDA(dst, b, h) do { _Pragma("unroll") for (int m = 0; m < 4; ++m) _Pragma("unroll") for (int k = 0; k < 2; ++k) dst[m][k] = *(const LAS bf16x8*)(lds + PG8_SA(b, h) + aoff + m * 2048 + k * 1024); } while (0)
#define PG8_LDB(dst, b, h) do { _Pragma("unroll") for (int n = 0; n < 2; ++n) _Pragma("unroll") for (int k = 0; k < 2; ++k) dst[n][k] = *(const LAS bf16x8*)(lds + PG8_SB(b, h) + boff + n * 2048 + k * 1024); } while (0)
#define PG8_MMA(ai, bj, At, Bt) do { __builtin_amdgcn_s_setprio(1); _Pragma("unroll") for (int m = 0; m < 4; ++m) _Pragma("unroll") for (int n = 0; n < 2; ++n) _Pragma("unroll") for (int k = 0; k < 2; ++k) \
        acc[ai][bj][m][n] = __builtin_amdgcn_mfma_f32_16x16x32_bf16(Bt[n][k], At[m][k], acc[ai][bj][m][n], 0, 0, 0); __builtin_amdgcn_s_setprio(0); } while (0)
#define PG8_WAIT_V(n) asm volatile("s_waitcnt vmcnt(" #n ")" ::: "memory")
#define PG8_WAIT_L(n) asm volatile("s_waitcnt lgkmcnt(" #n ")" ::: "memory")
#define PG8_BAR __builtin_amdgcn_s_barrier()
#define PG8_SCHED __builtin_amdgcn_sched_barrier(0)
    Unit cur, nxt; int ui = 0;
    if (!S.next(0, cur)) return;
    f32x4 acc[2][2][4][2];
#pragma unroll
    for (int a = 0; a < 2; ++a)
#pragma unroll
        for (int b = 0; b < 2; ++b)
#pragma unroll
            for (int m = 0; m < 4; ++m)
#pragma unroll
                for (int n = 0; n < 2; ++n) acc[a][b][m][n] = (f32x4){0.f, 0.f, 0.f, 0.f};
    bf16x8 At[4][2], B0[2][2], B1[2][2];
    const char* cA = (const char*)g.A + cur.ao; const char* cB = (const char*)g.Bt + cur.bo;
    PG8_STAGE(PG8_SB(0, 0), cB, voffB); PG8_STAGE(PG8_SB(0, 1), cB + hsB, voffB); PG8_STAGE(PG8_SA(0, 0), cA, voffA); PG8_STAGE(PG8_SA(0, 1), cA + hsA, voffA);
    if (wr == 1) PG8_BAR;
    PG8_WAIT_V(2); PG8_BAR;
    PG8_STAGE(PG8_SB(1, 0), cB + kstep, voffB); PG8_STAGE(PG8_SA(1, 0), cA + kstep, voffA); PG8_STAGE(PG8_SB(1, 1), cB + hsB + kstep, voffB);
    PG8_WAIT_V(6); PG8_BAR;
    for (;;) {
        const bool has_next = S.next(ui + 1, nxt);
        const char* nA = has_next ? (const char*)g.A + nxt.ao : cA; const char* nB = has_next ? (const char*)g.Bt + nxt.bo : cB;
        for (int t = 0; t < nt; t += 2) {
            const bool last = (t == nt - 2);
            const char* a1 = cA + (size_t)(t + 1) * kstep;
            const char* a2 = last ? nA : cA + (size_t)(t + 2) * kstep; const char* b2 = last ? nB : cB + (size_t)(t + 2) * kstep;
            const char* a3 = a2 + kstep; const char* b3 = b2 + kstep;
            PG8_LDB(B0, 0, 0); PG8_LDB(B1, 0, 1); PG8_SCHED; PG8_LDA(At, 0, 0); PG8_STAGE(PG8_SA(1, 1), a1 + hsA, voffA);
            PG8_WAIT_V(8); PG8_WAIT_L(0); PG8_BAR; PG8_MMA(0, 0, At, B0); PG8_MMA(0, 1, At, B1); PG8_BAR; PG8_SCHED;
            PG8_LDA(At, 0, 1); PG8_STAGE(PG8_SB(0, 0), b2, voffB); PG8_STAGE(PG8_SB(0, 1), b2 + hsB, voffB); PG8_STAGE(PG8_SA(0, 0), a2, voffA);
            PG8_WAIT_V(8); PG8_WAIT_L(0); PG8_BAR; PG8_MMA(1, 0, At, B0); PG8_MMA(1, 1, At, B1); PG8_BAR; PG8_SCHED;
            PG8_LDB(B0, 1, 0); PG8_LDB(B1, 1, 1); PG8_SCHED; PG8_LDA(At, 1, 0); PG8_STAGE(PG8_SA(0, 1), a2 + hsA, voffA);
            PG8_WAIT_V(8); PG8_WAIT_L(0); PG8_BAR; PG8_MMA(0, 0, At, B0); PG8_MMA(0, 1, At, B1); PG8_BAR; PG8_SCHED;
            PG8_LDA(At, 1, 1); PG8_STAGE(PG8_SB(1, 0), b3, voffB); PG8_STAGE(PG8_SB(1, 1), b3 + hsB, voffB); PG8_STAGE(PG8_SA(1, 0), a3, voffA);
            PG8_WAIT_V(8); PG8_WAIT_L(0); PG8_BAR; PG8_MMA(1, 0, At, B0); PG8_MMA(1, 1, At, B1); PG8_BAR; PG8_SCHED;
        }
        if (wr == 0) PG8_BAR;
        if constexpr (!Epi::AFTER_DRAIN) { E(acc, cur, wr, wc, fr, fq); }
        if (!has_next) break;
#pragma unroll
        for (int a = 0; a < 2; ++a)
#pragma unroll
            for (int b = 0; b < 2; ++b)
#pragma unroll
                for (int m = 0; m < 4; ++m)
#pragma unroll
                    for (int n = 0; n < 2; ++n) acc[a][b][m][n] = (f32x4){0.f, 0.f, 0.f, 0.f};
        cur = nxt; cA = nA; cB = nB; ++ui;
        if (wr == 1) PG8_BAR;
    }
    PG8_WAIT_V(0);
    PG8_BAR;
    if constexpr (Epi::AFTER_DRAIN) { E.fused(acc, cur, wr, wc, fr, fq, lds, wid, lane); }
#undef PG8_SA
#undef PG8_SB
#undef PG8_STAGE
#undef PG8_LDA
#undef PG8_LDB
#undef PG8_MMA
#undef PG8_WAIT_V
#undef PG8_WAIT_L
#undef PG8_BAR
#undef PG8_SCHED
}

template <class F> struct EpiCols8 {
    static constexpr bool PERM = true, AFTER_DRAIN = false; F f;
    __device__ __forceinline__ void operator()(const f32x4 (&acc)[2][2][4][2], const Unit& u, int wr, int wc, int fr, int fq) const {
#pragma unroll
        for (int ai = 0; ai < 2; ++ai)
#pragma unroll
            for (int m = 0; m < 4; ++m) { const int row = u.pm * BM + ai * HALF + wr * 64 + m * 16 + fr;
#pragma unroll
                for (int bj = 0; bj < 2; ++bj) f(u, row, u.pn * BM + bj * HALF + wc * 32 + 8 * fq, acc[ai][bj][m][0], acc[ai][bj][m][1]); }
    }
};
template <int MODE> struct EpiRes {
    static constexpr bool PERM = false, AFTER_DRAIN = false; const float* res; float* out; const f32x2* st; const float* g; const float* b; int ldc; float alpha;
    __device__ __forceinline__ void operator()(const f32x4 (&acc)[2][2][4][2], const Unit& u, int wr, int wc, int fr, int fq) const {
        const unsigned row0 = (unsigned)(u.pm * BM + wr * 64 + fr), col0 = (unsigned)(u.pn * BM + wc * 32 + 4 * fq);
        const unsigned base = row0 * (unsigned)ldc + col0;
        f32x4 gv[2][2], bv[2][2];
        if (MODE == 1) {
#pragma unroll
            for (int bj = 0; bj < 2; ++bj)
#pragma unroll
                for (int n = 0; n < 2; ++n) { gv[bj][n] = *(const f32x4*)(g + col0 + bj * HALF + n * 16); bv[bj][n] = *(const f32x4*)(b + col0 + bj * HALF + n * 16); }
        }
#pragma unroll
        for (int ai = 0; ai < 2; ++ai)
#pragma unroll
            for (int mp = 0; mp < 2; ++mp) {
                f32x4 r[2][2][2]; f32x2 sv[2];
#pragma unroll
                for (int mm = 0; mm < 2; ++mm) { const int m = 2 * mp + mm; const unsigned off = base + (unsigned)(ai * HALF + m * 16) * (unsigned)ldc;
                    if (MODE == 1) sv[mm] = st[row0 + ai * HALF + m * 16];
#pragma unroll
                    for (int bj = 0; bj < 2; ++bj)
#pragma unroll
                        for (int n = 0; n < 2; ++n) r[mm][bj][n] = *(const f32x4*)(res + (off + bj * HALF + n * 16)); }
                asm volatile("" ::: "memory");
#pragma unroll
                for (int mm = 0; mm < 2; ++mm) { const int m = 2 * mp + mm; const unsigned off = base + (unsigned)(ai * HALF + m * 16) * (unsigned)ldc;
#pragma unroll
                    for (int bj = 0; bj < 2; ++bj)
#pragma unroll
                        for (int n = 0; n < 2; ++n) { f32x4 x = r[mm][bj][n];
                            if (MODE == 1) x = (x - sv[mm].x) * sv[mm].y * gv[bj][n] + bv[bj][n];
                            *(f32x4*)(out + (off + bj * HALF + n * 16)) = x * alpha + acc[ai][bj][m][n]; } }
                asm volatile("" ::: "memory");
            }
    }
};
}

struct Args { const float* in[29]; float* out; unsigned char* ws; int ph_lo, ph_hi; };
enum { I_X = 0, I_MEM, I_S5_WIN, I_S5_ARE, I_S5_AIM, I_S5_LOGDT, I_S5_BRE, I_S5_BIM, I_S5_CRE, I_S5_CIM, I_S5_D, I_S5_WGLU, I_S5_WOUT, I_KVW,
       I_CPK, I_CW1K, I_CW2K, I_CPV, I_CW1V, I_CW2V, I_WQG, I_WNO, I_MWQ, I_MWKV, I_MWO, I_WUP, I_WDN, I_LNG, I_LNB };

__device__ __forceinline__ const float* argp(int i) {
    const char* kp = (const char*)__builtin_amdgcn_kernarg_segment_ptr(); const float* p;
    asm volatile("s_load_dwordx2 %0, %1, %2\n\ts_waitcnt lgkmcnt(0)" : "=s"(p) : "s"(kp), "i"(i * 8)); return p; }
#define INP(i) argp(i)

__device__ __forceinline__ void conv_item(const float* W, int ldw, int ncols, bf16_t* WT, int ldt, int k0, int n0, int drow0, LAS float* scr, int lane) {
    const int r8 = lane >> 3, c4 = (lane & 7) * 4; const bool ok = (n0 + c4) < ncols;
    f32x4 v[8];
#pragma unroll
    for (int i = 0; i < 8; ++i) v[i] = ok ? *(const f32x4*)(W + (size_t)(k0 + 8 * i + r8) * ldw + n0 + c4) : (f32x4){0.f, 0.f, 0.f, 0.f};
#pragma unroll
    for (int i = 0; i < 8; ++i) { LAS float* d = scr + (8 * i + r8) * 33 + c4; d[0] = v[i].x; d[1] = v[i].y; d[2] = v[i].z; d[3] = v[i].w; }
    LDS_WAIT(); asm volatile("" ::: "memory");
    const int c = lane & 7;
#pragma unroll
    for (int j = 0; j < 4; ++j) { const int n = (lane >> 3) + 8 * j; const LAS float* s = scr + (8 * c) * 33 + n;
        u32x4 o; o.x = pk2(s[0 * 33], s[1 * 33]); o.y = pk2(s[2 * 33], s[3 * 33]); o.z = pk2(s[4 * 33], s[5 * 33]); o.w = pk2(s[6 * 33], s[7 * 33]);
        *(u32x4*)(WT + (size_t)(drow0 + n) * ldt + k0 + 8 * c) = o; }
    LDS_WAIT(); asm volatile("" ::: "memory");
}
template <int MODE>
__device__ __forceinline__ void conv_matrix(const float* W, int K, int ldw, int ncols, bf16_t* WT, int ldt, int row_off, LAS float* scr, int gw, int NGW, int lane) {
    const int nblk = (ncols + 31) / 32, nitems = (K / 64) * nblk;
    for (int it = gw; it < nitems; it += NGW) {
        const int kb = it / nblk, nb = it % nblk, n0 = 32 * nb;
        int drow0;
        if (MODE == 1) { const int bj = n0 >> 11, j = n0 & 2047; drow0 = 256 * (j >> 7) + 128 * bj + (j & 127); } else drow0 = row_off + n0;
        conv_item(W, ldw, ncols, WT, ldt, 64 * kb, n0, drow0, scr, lane);
    }
}
__device__ __forceinline__ void cvt_rows(const float* src, bf16_t* dst, size_t n, int gtid, int gthreads) {
    for (size_t i = (size_t)gtid * 8; i < n; i += (size_t)gthreads * 8) {
        const f32x4 a = *(const f32x4*)(src + i), b = *(const f32x4*)(src + i + 4);
        u32x4 o; o.x = pk2(a.x, a.y); o.y = pk2(a.z, a.w); o.z = pk2(b.x, b.y); o.w = pk2(b.z, b.w);
        *(u32x4*)(dst + i) = o;
    }
}
template <bool WF32>
__device__ __forceinline__ void ln_phase(const float* src, float prescale, float* XF, bf16_t* XB, f32x2* ST, const float* g, const float* b, int gw, int NGW, int lane) {
    asm volatile("" : "+v"(lane));
    f32x4 gvv[8], bvv[8];
#pragma unroll
    for (int j = 0; j < 8; ++j) { gvv[j] = ((const f32x4*)g)[lane + 64 * j]; bvv[j] = ((const f32x4*)b)[lane + 64 * j]; }
    f32x4 vn[8];
    if (gw < MTOK) { const f32x4* xr = (const f32x4*)(src + (size_t)gw * DM) + lane;
#pragma unroll
        for (int j = 0; j < 8; ++j) vn[j] = xr[64 * j]; }
    for (int row = gw; row < MTOK; row += NGW) {
        f32x4 v[8]; float s = 0.f;
#pragma unroll
        for (int j = 0; j < 8; ++j) { v[j] = vn[j] * prescale; s += (v[j].x + v[j].y) + (v[j].z + v[j].w); }
        if (row + NGW < MTOK) { const f32x4* xr = (const f32x4*)(src + (size_t)(row + NGW) * DM) + lane;
#pragma unroll
            for (int j = 0; j < 8; ++j) vn[j] = xr[64 * j]; }
        const float mean = wave_sum(s) * (1.f / DM); float s2 = 0.f;
#pragma unroll
        for (int j = 0; j < 8; ++j) { v[j] = v[j] - mean; s2 += (v[j].x * v[j].x + v[j].y * v[j].y) + (v[j].z * v[j].z + v[j].w * v[j].w); }
        const float rstd = 1.f / sqrtf(wave_sum(s2) * (1.f / DM) + LN_EPS);
        if (!WF32 && lane == 0) ST[row] = (f32x2){mean, rstd};
        f32x4* xo = (f32x4*)(XF + (size_t)row * DM) + lane; u32x2* bo = (u32x2*)(XB + (size_t)row * DM) + lane;
#pragma unroll
        for (int j = 0; j < 8; ++j) { const f32x4 gv = gvv[j], bv = bvv[j];
            const f32x4 o = v[j] * rstd * gv + bv; if (WF32) xo[64 * j] = o; else { u32x2 w; w.x = pk2(o.x, o.y); w.y = pk2(o.z, o.w); bo[64 * j] = w; } }
    }
}

struct StoreBf16 { bf16_t* O; int ldc; float scale;
    __device__ __forceinline__ void operator()(const pg8::Unit&, int row, int col, f32x4 v0, f32x4 v1) const {
        u32x4 w; w.x = pg8::cvt_pk_bf16(v0[0] * scale, v0[1] * scale); w.y = pg8::cvt_pk_bf16(v0[2] * scale, v0[3] * scale); w.z = pg8::cvt_pk_bf16(v1[0] * scale, v1[1] * scale); w.w = pg8::cvt_pk_bf16(v1[2] * scale, v1[3] * scale);
        *(u32x4*)(O + (size_t)row * ldc + col) = w; } };
struct StoreRelu2 { bf16_t* O; int ldc;
    __device__ __forceinline__ void operator()(const pg8::Unit&, int row, int col, f32x4 v0, f32x4 v1) const {
#pragma unroll
        for (int i = 0; i < 4; ++i) { const float a = v0[i] > 0.f ? v0[i] : 0.f, c = v1[i] > 0.f ? v1[i] : 0.f; v0[i] = a * a; v1[i] = c * c; }
        u32x4 w; w.x = pg8::cvt_pk_bf16(v0[0], v0[1]); w.y = pg8::cvt_pk_bf16(v0[2], v0[3]); w.z = pg8::cvt_pk_bf16(v1[0], v1[1]); w.w = pg8::cvt_pk_bf16(v1[2], v1[3]);
        *(u32x4*)(O + (size_t)row * ldc + col) = w; } };


__device__ __forceinline__ void s5_tables(const float* a_re, const float* a_im, const float* log_dt, const float* b_re, const float* b_im, const float* c_re, const float* c_im,
                                          unsigned char* ws, int gtid, int gthreads) {
    f32x2* AB = (f32x2*)(ws + MS_S5AB); f32x2* ABL = (f32x2*)(ws + MS_S5ABL); bf16_t* BM = (bf16_t*)(ws + MS_S5BM); bf16_t* CM = (bf16_t*)(ws + MS_S5CM);
    for (int i = gtid; i < 128 * 64 * 16; i += gthreads) {
        const int h = i & 15, p = (i >> 4) & 63, g = i >> 10;
        const float dt = expf(log_dt[g]), lr = a_re[g * 64 + p], li = a_im[g * 64 + p];
        const float mag = expf(lr * dt), abr = mag * cosf(li * dt), abi = mag * sinf(li * dt);
        const float den = lr * lr + li * li, nr = abr - 1.0f, ni = abi;
        const float fre = (nr * lr + ni * li) / den, fim = (ni * lr - nr * li) / den;
        const float br = b_re[(g * 64 + p) * 16 + h], bi = b_im[(g * 64 + p) * 16 + h];
        BM[(g * 128 + p) * 16 + h] = (bf16_t)f2bf(fre * br - fim * bi);
        BM[(g * 128 + 64 + p) * 16 + h] = (bf16_t)f2bf(fre * bi + fim * br);
        CM[(g * 16 + h) * 128 + p] = (bf16_t)f2bf(c_re[(g * 16 + h) * 64 + p]);
        CM[(g * 16 + h) * 128 + 64 + p] = (bf16_t)f2bf(-c_im[(g * 16 + h) * 64 + p]);
        if (h == 0) { AB[g * 64 + p] = (f32x2){abr, abi}; float xr = abr, xi = abi;
            for (int k = S5_LC; k > 1; k >>= 1) { const float t = xr * xr - xi * xi; xi = 2.f * xr * xi; xr = t; }
            ABL[g * 64 + p] = (f32x2){xr, xi}; }
    }
}
__device__ __forceinline__ float gelu_tanh(float y) { const float z = 0.7978845608028654f * (y + 0.044715f * y * y * y); const float e = __expf(2.f * z); return y * (1.f - __builtin_amdgcn_rcpf(1.f + e)); }
template <bool FINAL>
__device__ __forceinline__ void s5_pass(const bf16_t* U, bf16_t* Y, const float* dskip, unsigned char* ws, LAS unsigned char* lds, int gw, int NGW, int wave, int lane) {
    asm volatile("" : "+v"(lane));
    const int fr = lane & 15, fq = lane >> 4;
    LAS float* BU = (LAS float*)(lds + wave * 12800); LAS bf16_t* SB = (LAS bf16_t*)(lds + wave * 12800 + 8448);
    constexpr int LDB = 132, LDSB = 136;
    for (int item = gw; item < 2 * 128 * S5_NCH; item += NGW) {
        const int g = item & 127, b = (item >> 7) & 1, ch = item >> 8;
        const bf16_t* BMg = (const bf16_t*)(ws + MS_S5BM) + (size_t)g * 128 * 16; const bf16_t* CMg = (const bf16_t*)(ws + MS_S5CM) + (size_t)g * 16 * 128;
        bf16x8 bmf[8];
#pragma unroll
        for (int nt = 0; nt < 8; ++nt) { bmf[nt] = (bf16x8){0, 0, 0, 0, 0, 0, 0, 0}; if (fq < 2) bmf[nt] = *(const bf16x8*)(BMg + (16 * nt + fr) * 16 + 8 * fq); }
        bf16x8 cmf[4];
        if (FINAL) {
#pragma unroll
            for (int kk = 0; kk < 4; ++kk) cmf[kk] = *(const bf16x8*)(CMg + fr * 128 + 32 * kk + 8 * fq);
        }
        const f32x2 ab = ((const f32x2*)(ws + MS_S5AB))[g * 64 + lane];
        const float ar = ab.x, ai = ab.y;
        float sr = 0.f, si = 0.f;
        if (FINAL) { const f32x2 al = ((const f32x2*)(ws + MS_S5ABL))[g * 64 + lane]; const f32x2* E = (const f32x2*)(ws + MS_S5E) + (size_t)(b * 128 + g) * S5_NCH * 64 + lane;
            for (int c = 0; c < ch; ++c) { const f32x2 e = E[c * 64]; const float nr = al.x * sr - al.y * si + e.x, ni = al.x * si + al.y * sr + e.y; sr = nr; si = ni; } }
        const float dsk = FINAL ? dskip[g * 16 + fr] : 0.f;
        const size_t row0 = (size_t)b * SEQ + (size_t)ch * S5_LC;
        const bf16_t* Up = U + (row0 + fr) * DM + g * 16 + 8 * fq;
        bf16x8 uf = (bf16x8){0, 0, 0, 0, 0, 0, 0, 0}; if (fq < 2) uf = *(const bf16x8*)Up;
        for (int t0 = 0; t0 < S5_LC; t0 += 16) {
            bf16x8 un = (bf16x8){0, 0, 0, 0, 0, 0, 0, 0};
            if (fq < 2 && t0 + 16 < S5_LC) un = *(const bf16x8*)(Up + (size_t)(t0 + 16) * DM);
#pragma unroll
            for (int nt = 0; nt < 8; ++nt) { const f32x4 d = __builtin_amdgcn_mfma_f32_16x16x32_bf16(uf, bmf[nt], (f32x4){0.f, 0.f, 0.f, 0.f}, 0, 0, 0);
#pragma unroll
                for (int r = 0; r < 4; ++r) BU[(4 * fq + r) * LDB + 16 * nt + fr] = d[r]; }
#pragma unroll
            for (int t = 0; t < 16; ++t) { const float br = BU[t * LDB + lane], bi = BU[t * LDB + 64 + lane];
                const float nr = ar * sr - ai * si + br, ni = ar * si + ai * sr + bi; sr = nr; si = ni;
                if (FINAL) { SB[t * LDSB + lane] = (bf16_t)f2bf(sr); SB[t * LDSB + 64 + lane] = (bf16_t)f2bf(si); } }
            if (FINAL) {
                f32x4 y = (f32x4){0.f, 0.f, 0.f, 0.f};
#pragma unroll
                for (int kk = 0; kk < 4; ++kk) { const bf16x8 sf = *(const LAS bf16x8*)(SB + fr * LDSB + 32 * kk + 8 * fq); y = __builtin_amdgcn_mfma_f32_16x16x32_bf16(sf, cmf[kk], y, 0, 0, 0); }
#pragma unroll
                for (int r = 0; r < 4; ++r) { const size_t o = (row0 + t0 + 4 * fq + r) * DM + g * 16 + fr; const float uu = bf2f(U[o]); Y[o] = (bf16_t)f2bf(gelu_tanh(y[r] + dsk * uu)); }
            }
            uf = un;
        }
        if (!FINAL) ((f32x2*)(ws + MS_S5E))[((b * 128 + g) * S5_NCH + ch) * 64 + lane] = (f32x2){sr, si};
    }
}
__device__ __forceinline__ void s5_carry(unsigned char* ws, int gtid, int gthreads) {
    for (int i = gtid; i < 2 * 128 * 64; i += gthreads) {
        const int p = i & 63, bg = i >> 6, g = bg & 127;
        const f32x2 al = ((const f32x2*)(ws + MS_S5ABL))[g * 64 + p];
        const f32x2* E = (const f32x2*)(ws + MS_S5E) + (size_t)bg * S5_NCH * 64 + p; f32x2* SI = (f32x2*)(ws + MS_S5SIN) + (size_t)bg * S5_NCH * 64 + p;
        float sr = 0.f, si = 0.f;
        for (int c = 0; c < S5_NCH; ++c) { SI[c * 64] = (f32x2){sr, si}; const f32x2 e = E[c * 64]; const float nr = al.x * sr - al.y * si + e.x, ni = al.x * si + al.y * sr + e.y; sr = nr; si = ni; }
    }
}

struct EpiGlu {
    static constexpr bool PERM = true, AFTER_DRAIN = false; bf16_t* O; int ldc;
    __device__ __forceinline__ void operator()(const f32x4 (&acc)[2][2][4][2], const pg8::Unit& u, int wr, int wc, int fr, int fq) const {
        const int col = u.pn * 128 + wc * 32 + 8 * fq;
#pragma unroll
        for (int ai = 0; ai < 2; ++ai)
#pragma unroll
            for (int m = 0; m < 4; ++m) { const int row = u.pm * 256 + ai * 128 + wr * 64 + m * 16 + fr; float o[8];
#pragma unroll
                for (int n = 0; n < 2; ++n)
#pragma unroll
                    for (int i = 0; i < 4; ++i) { const float v = acc[ai][0][m][n][i], gt = acc[ai][1][m][n][i]; o[4 * n + i] = v * __builtin_amdgcn_rcpf(1.f + __expf(-gt)); }
                u32x4 w; w.x = pg8::cvt_pk_bf16(o[0], o[1]); w.y = pg8::cvt_pk_bf16(o[2], o[3]); w.z = pg8::cvt_pk_bf16(o[4], o[5]); w.w = pg8::cvt_pk_bf16(o[6], o[7]);
                *(u32x4*)(O + (size_t)row * ldc + col) = w; }
    }
};
struct EpiSoftmax {
    static constexpr bool PERM = false, AFTER_DRAIN = true; bf16_t* P;
    __device__ __forceinline__ void fused(f32x4 (&acc)[2][2][4][2], const pg8::Unit& u, int wr, int wc, int fr, int fq, LAS unsigned char* lds, int wid, int lane) const {
        LAS f32x2* X = (LAS f32x2*)lds;
        float mw[2][4];
#pragma unroll
        for (int ai = 0; ai < 2; ++ai)
#pragma unroll
            for (int m = 0; m < 4; ++m) {
                float mx = -3.0e38f;
#pragma unroll
                for (int bj = 0; bj < 2; ++bj)
#pragma unroll
                    for (int n = 0; n < 2; ++n)
#pragma unroll
                        for (int i = 0; i < 4; ++i) mx = fmaxf(mx, acc[ai][bj][m][n][i]);
                mx = fmaxf(mx, my_shfl_xor(mx, 16)); mx = fmaxf(mx, my_shfl_xor(mx, 32));
                float sm = 0.f;
#pragma unroll
                for (int bj = 0; bj < 2; ++bj)
#pragma unroll
                    for (int n = 0; n < 2; ++n)
#pragma unroll
                        for (int i = 0; i < 4; ++i) { const float e = __builtin_amdgcn_exp2f(acc[ai][bj][m][n][i] - mx); acc[ai][bj][m][n][i] = e; sm += e; }
                sm += my_shfl_xor(sm, 16); sm += my_shfl_xor(sm, 32);
                mw[ai][m] = mx;
                if (fq == 0) X[(ai * 128 + wr * 64 + m * 16 + fr) * 4 + wc] = (f32x2){mx, sm};
            }
        LDS_WAIT(); __builtin_amdgcn_s_barrier(); asm volatile("" ::: "memory");
#pragma unroll
        for (int ai = 0; ai < 2; ++ai)
#pragma unroll
            for (int m = 0; m < 4; ++m) { const int r = ai * 128 + wr * 64 + m * 16 + fr;
                const f32x2 a = X[r * 4 + 0], b = X[r * 4 + 1], c = X[r * 4 + 2], d = X[r * 4 + 3];
                const float M = fmaxf(fmaxf(a.x, b.x), fmaxf(c.x, d.x));
                const float tot = a.y * __builtin_amdgcn_exp2f(a.x - M) + b.y * __builtin_amdgcn_exp2f(b.x - M) + c.y * __builtin_amdgcn_exp2f(c.x - M) + d.y * __builtin_amdgcn_exp2f(d.x - M);
                const float f = __builtin_amdgcn_exp2f(mw[ai][m] - M) / tot;
                bf16_t* rowp = P + (size_t)(u.pm * 256 + r) * 1024 + u.z * 256 + wc * 32 + 4 * fq;
#pragma unroll
                for (int bj = 0; bj < 2; ++bj)
#pragma unroll
                    for (int n = 0; n < 2; ++n) { const f32x4 v = acc[ai][bj][m][n] * f; u32x2 w; w.x = pg8::cvt_pk_bf16(v[0], v[1]); w.y = pg8::cvt_pk_bf16(v[2], v[3]); *(u32x2*)(rowp + bj * 128 + n * 16) = w; } }
        LDS_WAIT(); __builtin_amdgcn_s_barrier(); asm volatile("" ::: "memory");
    }
};
struct CmpSched {
    int G, c;
    __device__ bool next(int i, pg8::Unit& u) const {
        const int L = i * G + c; if (L >= 128) return false;
        const int which = L >> 6, ks = (L >> 4) & 3, pm = L & 15; u.pm = pm; u.pn = 0; u.z = which * 4 + ks;
        u.ao = (unsigned)(((size_t)which * KVH_SLOT + (size_t)pm * 256 * 2048 + ks * 512) * 2); u.bo = (unsigned)(((size_t)which * 256 * 2048 + ks * 512) * 2);
        return true;
    }
};
struct StoreBf16Z { bf16_t* O; int ldc; float scale; size_t zstride;
    __device__ __forceinline__ void operator()(const pg8::Unit& u, int row, int col, f32x4 v0, f32x4 v1) const {
        u32x4 w; w.x = pg8::cvt_pk_bf16(v0[0] * scale, v0[1] * scale); w.y = pg8::cvt_pk_bf16(v0[2] * scale, v0[3] * scale); w.z = pg8::cvt_pk_bf16(v1[0] * scale, v1[1] * scale); w.w = pg8::cvt_pk_bf16(v1[2] * scale, v1[3] * scale);
        *(u32x4*)(O + (size_t)u.z * zstride + (size_t)row * ldc + col) = w; } };
struct KvSched { int G, c;
    __device__ bool next(int i, pg8::Unit& u) const { const int L = i * G + c; if (L >= 64) return false;
        const int l = L >> 5, pm = (L >> 4) & 1, pn = L & 15; u.pm = pm; u.pn = pn; u.z = l;
        u.ao = (unsigned)((size_t)pm * 256 * 2048 * 2); u.bo = (unsigned)((size_t)l * 16 * MiB + (size_t)pn * 256 * 2048 * 2); return true; } };
struct MtSched { int G, c;
    __device__ bool next(int i, pg8::Unit& u) const { const int L = i * G + c; if (L >= 128 || L < 0) return false;
        const int l = L >> 6, b = (L >> 5) & 1, h = (L >> 3) & 3, pn = L & 7; u.pm = h; u.pn = pn; u.z = l * 2 + b;
        u.ao = (unsigned)((size_t)l * 4 * MiB + ((size_t)(b * 256) * 4096 + h * 512) * 2); u.bo = (unsigned)((size_t)l * 8 * MiB + ((size_t)(pn * 256) * 2048 + h * 512) * 2); return true; } };
struct VwSched { int G, c;
    __device__ bool next(int i, pg8::Unit& u) const { const int L = i * G + c; if (L >= 128 || L < 0) return false;
        const int l = L >> 6, b = (L >> 5) & 1, h = (L >> 3) & 3, pmn = L & 7; u.pm = pmn; u.pn = h; u.z = l * 2 + b;
        u.ao = (unsigned)((size_t)l * 8 * MiB + ((size_t)(pmn * 256) * 2048 + h * 512) * 2); u.bo = (unsigned)((size_t)l * 4 * MiB + ((size_t)(b * 256) * 4096 + 2048 + h * 512) * 2); return true; } };
struct ScoreSched { int G, c, base, lim, layer;
    __device__ bool next(int i, pg8::Unit& u) const { const int L0 = base + i * G + c; if (L0 >= lim) return false;
        const int L = (G == 256) ? ((L0 & 7) * 32 + (L0 >> 3)) : L0;
        const int b = L >> 7, pmp = (L >> 2) & 31, h = L & 3; u.pm = b * 32 + pmp; u.pn = 0; u.z = h;
        u.ao = (unsigned)((size_t)(b * SEQ + 256 * pmp) * 2048 * 2); u.bo = (unsigned)((size_t)(layer * 2 + b) * 4 * MiB + (size_t)(h * 256) * 2048 * 2); return true; } };
struct PvoSched { pg8::StaticOrder so; int layer;
    __device__ bool next(int i, pg8::Unit& u) const { if (!so.next(i, u)) return false; u.bo += (unsigned)((size_t)(layer * 2 + (u.pm >> 5)) * 4 * MiB); return true; } };
template <int MODE> struct MemSched {
    int G, c, base, lim;
    __device__ bool next(int i, pg8::Unit& u) const {
        const int L = base + i * G + c; if (L >= lim) return false;
        if (MODE == 0) { const int b = L >> 7, h = (L >> 5) & 3, pmp = L & 31; u.pm = b * 32 + pmp; u.pn = 0; u.z = h;
            u.ao = (unsigned)(((b * SEQ + 256 * pmp) * 2048 + h * 512) * 2); u.bo = (unsigned)(((b * 256) * 2048 + h * 512) * 2); }
        else { const int pn = L & 1, pmp = (L >> 1) & 31, h = (L >> 6) & 3, b = L >> 8; u.pm = b * 32 + pmp; u.pn = h * 2 + pn; u.z = 0;
            u.ao = (unsigned)(((b * SEQ + 256 * pmp) * 1024 + h * 256) * 2); u.bo = (unsigned)(((h * 512 + 256 * pn) * 512 + b * 256) * 2); }
        return true;
    }
};


struct StoreKVQ { bf16_t* KVH; bf16_t* QH; float* GATES; float qscale;
    __device__ __forceinline__ void operator()(const pg8::Unit&, int row, int col, f32x4 v0, f32x4 v1) const {
        const int b = row >> 13, t = row & 8191;
        if (col < 3072) { const int slot = col >> 9, g = (col >> 7) & 3, d = col & 127;
            u32x4 w; w.x = pg8::cvt_pk_bf16(v0[0], v0[1]); w.y = pg8::cvt_pk_bf16(v0[2], v0[3]); w.z = pg8::cvt_pk_bf16(v1[0], v1[1]); w.w = pg8::cvt_pk_bf16(v1[2], v1[3]);
            *(u32x4*)(KVH + ((((size_t)slot * 2 + b) * 4 + g) * 8192 + t) * 128 + d) = w; }
        else if (col < 5120) { const int c2 = col - 3072, head = c2 >> 7, d = c2 & 127, g = head >> 2, r = head & 3; v0 = v0 * qscale; v1 = v1 * qscale;
            u32x4 w; w.x = pg8::cvt_pk_bf16(v0[0], v0[1]); w.y = pg8::cvt_pk_bf16(v0[2], v0[3]); w.z = pg8::cvt_pk_bf16(v1[0], v1[1]); w.w = pg8::cvt_pk_bf16(v1[2], v1[3]);
            *(u32x4*)(QH + ((((size_t)b * 4 + g) * 8192 + t) * 4 + r) * 128 + d) = w; }
        else if (col < 5168) { float* gp = GATES + (size_t)row * 48 + (col - 5120);
#pragma unroll
            for (int i = 0; i < 4; ++i) { v0[i] = __builtin_amdgcn_rcpf(1.f + __expf(-v0[i])); v1[i] = __builtin_amdgcn_rcpf(1.f + __expf(-v1[i])); }
            *(f32x4*)gp = v0; *(f32x4*)(gp + 4) = v1; }
    } };
struct StoreF32 { float* O; int ldc; size_t zstride;
    __device__ __forceinline__ void operator()(const pg8::Unit& u, int row, int col, f32x4 v0, f32x4 v1) const { float* p = O + (size_t)u.z * zstride + (size_t)row * ldc + col; *(f32x4*)p = v0; *(f32x4*)(p + 4) = v1; } };
__device__ __forceinline__ void cmp_bias(const float* pos_k, const float* w1_k, const float* pos_v, const float* w1_v, float* CB, int tid) {
    if (tid < 256) { const int which = tid >> 7, n = tid & 127; const float* pos = which ? pos_v : pos_k; const float* w1 = which ? w1_v : w1_k; float a = 0.f;
        for (int k = 0; k < 4096; ++k) a += pos[k] * w1[(size_t)k * 128 + n];
        CB[tid] = a; }
}
__device__ __forceinline__ void cmp_combine(const float* PAB, const float* CB, const float* w2k, const float* w2v, bf16_t* KCMP, int gw, int NGW, int lane) {
    asm volatile("" : "+v"(lane));
    for (int it = gw; it < 2 * 4096; it += NGW) {
        const int which = it >> 12, row = it & 4095, c = row & 511;
        bf16_t* out = KCMP + ((size_t)which * 4096 + row) * 128;
        if (c == 511) { out[lane] = 0; out[lane + 64] = 0; continue; }
        const float* P = PAB + (size_t)which * 4 * 4096 * 256; const float* w2 = which ? w2v : w2k;
        float sa = CB[which * 128 + lane], sb = CB[which * 128 + 64 + lane];
#pragma unroll
        for (int ks = 0; ks < 4; ++ks) { const float* Pk = P + (size_t)ks * 4096 * 256;
            sa += Pk[(size_t)row * 256 + lane] + Pk[(size_t)(row + 1) * 256 + 128 + lane]; sb += Pk[(size_t)row * 256 + 64 + lane] + Pk[(size_t)(row + 1) * 256 + 192 + lane]; }
        const float va = gelu_tanh(sa), vb = gelu_tanh(sb);
        float o0 = 0.f, o1 = 0.f;
        for (int n = 0; n < 64; ++n) { const float x = my_shfl(va, n); o0 += x * w2[n * 128 + lane]; o1 += x * w2[n * 128 + 64 + lane]; }
        for (int n = 0; n < 64; ++n) { const float x = my_shfl(vb, n); o0 += x * w2[(64 + n) * 128 + lane]; o1 += x * w2[(64 + n) * 128 + 64 + lane]; }
        out[lane] = (bf16_t)f2bf(o0); out[lane + 64] = (bf16_t)f2bf(o1);
    }
}

namespace nsa {
constexpr int L_K0 = 0, L_V0 = 32768, L_IMP = 65536, IMP_LD = 132, IMP_WAVE = 8 * IMP_LD * 4, L_SELM = L_IMP + 8 * IMP_WAVE, L_UNI = L_SELM + 8 * 128, L_NTL = L_UNI + 16, L_TL = L_NTL + 16, L_WSF = L_TL + 512;
constexpr float NEGB = -1.0e30f;
typedef short v4i16_t __attribute__((ext_vector_type(4)));
__device__ __forceinline__ unsigned off_b(unsigned row, unsigned ch) { return 256u * row + 16u * (ch ^ (((row & 3) << 2) | ((row >> 2) & 3))); }
__device__ __forceinline__ int crow(int r, int hi) { return (r & 3) + 8 * (r >> 2) + 4 * hi; }
__device__ __forceinline__ float xhalf(float v) { return my_shfl_xor(v, 32); }

template <int BR, int MODE>
__device__ __forceinline__ void run_tiles(LAS unsigned char* lds, const bf16_t* Kb, const bf16_t* Vb, int ntiles, int first, int qt, const bf16x8 (&qf)[8], f32x16 (&o)[4], float& l_run,
                                          int t, unsigned selw0, unsigned selw1, unsigned selw2, unsigned selw3, float pscale, float gate, int tid, int wave, int lane) {
    const int l32 = lane & 31, hi = lane >> 5;
    LAS const int* TL = (LAS const int*)(lds + L_TL);
    LAS float* imp = (LAS float*)(lds + L_IMP + wave * IMP_WAVE) + ((l32 >> 2) * IMP_LD);
    const unsigned soff = (unsigned)((4 * wave + (lane >> 4)) * 128 + (((lane & 15) ^ (((lane >> 4) << 2) | (wave & 3))) * 8));
    auto tile_of = [&](int i) -> int { return (BR == 1) ? TL[i] : first + i; };
    auto stage = [&](int tile, int buf) { const bf16_t* ks = Kb + (size_t)tile * 8192 + soff; LAS unsigned char* kd = lds + L_K0 + buf * 16384 + wave * 1024;
        __builtin_amdgcn_global_load_lds((const unsigned*)ks, (LAS unsigned*)kd, 16, 0, 0); __builtin_amdgcn_global_load_lds((const unsigned*)(ks + 4096), (LAS unsigned*)(kd + 8192), 16, 0, 0);
        if (MODE != 0) { const bf16_t* vs = Vb + (size_t)tile * 8192 + soff; LAS unsigned char* vd = lds + L_V0 + buf * 16384 + wave * 1024;
            __builtin_amdgcn_global_load_lds((const unsigned*)vs, (LAS unsigned*)vd, 16, 0, 0); __builtin_amdgcn_global_load_lds((const unsigned*)(vs + 4096), (LAS unsigned*)(vd + 8192), 16, 0, 0); } };
    if (ntiles <= 0) return;
    stage(tile_of(0), 0);
    asm volatile("s_waitcnt vmcnt(0) lgkmcnt(0)" ::: "memory"); __builtin_amdgcn_s_barrier(); asm volatile("" ::: "memory");
    const unsigned kx = ((l32 & 3) << 2) | ((l32 >> 2) & 3);
    const int blk = (lane >> 4) & 1, tq = (lane & 15) >> 2, tp = lane & 3;
    for (int i = 0; i < ntiles; ++i) {
        const int tile = tile_of(i), buf = i & 1;
        if (i + 1 < ntiles) stage(tile_of(i + 1), buf ^ 1);
        bool selbit = true;
        if (BR == 1) { const unsigned w = (tile < 32) ? selw0 : (tile < 64) ? selw1 : (tile < 96) ? selw2 : selw3; selbit = (w >> (tile & 31)) & 1u; }
        const bool active = (BR == 1) ? (bool)__any((int)selbit) : true;
        if (active) {
            LAS const unsigned char* kb = lds + L_K0 + buf * 16384; LAS const unsigned char* vb = lds + L_V0 + buf * 16384;
            f32x16 p0, p1;
#pragma unroll
            for (int r = 0; r < 16; ++r) { p0[r] = 0.f; p1[r] = 0.f; }
            {
                bf16x8 kq0[3], kq1[3];
#define NSA_LDK(s_, slot_) do { const unsigned ko_ = 256u * l32 + 16u * ((unsigned)(2 * (s_) + hi) ^ kx); kq0[slot_] = *(LAS const bf16x8*)(kb + ko_); kq1[slot_] = *(LAS const bf16x8*)(kb + 8192 + ko_); } while (0)
                NSA_LDK(0, 0); NSA_LDK(1, 1);
                __builtin_amdgcn_sched_barrier(0);
#pragma unroll
                for (int s = 0; s < 8; ++s) {
                    if (s + 2 < 8) NSA_LDK(s + 2, (s + 2) % 3);
                    __builtin_amdgcn_sched_barrier(0);
                    p0 = __builtin_amdgcn_mfma_f32_32x32x16_bf16(kq0[s % 3], qf[s], p0, 0, 0, 0); p1 = __builtin_amdgcn_mfma_f32_32x32x16_bf16(kq1[s % 3], qf[s], p1, 0, 0, 0);
                    __builtin_amdgcn_sched_barrier(0);
                }
#undef NSA_LDK
            }
            const int kbase = tile * 64;
            const bool need_mask = (BR == 0) ? true : (BR == 1) ? (tile == qt) : ((tile == qt) || (tile == first && qt >= 8));
            const float ps = (BR == 1) ? 1.f : pscale;
            if (need_mask) {
                const int cmax = (t - 31) >> 4;
#pragma unroll
                for (int r = 0; r < 16; ++r) { const int k0i = kbase + crow(r, hi), k1i = k0i + 32; bool v0, v1;
                    if (BR == 0) { v0 = k0i <= cmax; v1 = k1i <= cmax; }
                    else if (BR == 1) { v0 = (k0i <= t); v1 = (k1i <= t); }
                    else { v0 = (k0i <= t) && (k0i > t - 512); v1 = (k1i <= t) && (k1i > t - 512); }
                    p0[r] = v0 ? __builtin_amdgcn_exp2f(p0[r]) * ps : 0.f; p1[r] = v1 ? __builtin_amdgcn_exp2f(p1[r]) * ps : 0.f; }
            } else {
#pragma unroll
                for (int r = 0; r < 16; ++r) { p0[r] = __builtin_amdgcn_exp2f(p0[r]) * ps; p1[r] = __builtin_amdgcn_exp2f(p1[r]) * ps; }
            }
            if (MODE != 1) { float sum = 0.f;
#pragma unroll
                for (int r = 0; r < 16; ++r) sum += p0[r] + p1[r];
                l_run += (BR == 1) ? (selbit ? sum : 0.f) : sum; }
            if (MODE == 1) {
#pragma unroll
                for (int h2 = 0; h2 < 2; ++h2)
#pragma unroll
                    for (int a = 0; a < 4; ++a) { const f32x16& pp = h2 ? p1 : p0; float gs = (pp[4 * a] + pp[4 * a + 1]) + (pp[4 * a + 2] + pp[4 * a + 3]), ls = pp[4 * a + 3];
                        gs += my_shfl_xor(gs, 1); gs += my_shfl_xor(gs, 2); ls += my_shfl_xor(ls, 1); ls += my_shfl_xor(ls, 2);
                        if ((lane & 3) == 0) { const int sidx = 16 * tile + 2 * a + hi + 8 * h2; atomicAdd((float*)(imp + sidx), gs); atomicAdd((float*)(imp + sidx + 1), ls); } }
#pragma unroll
                for (int r = 0; r < 16; ++r) { p0[r] *= gate; p1[r] *= gate; }
            }
            if (MODE != 0) {
                bf16x8 pa[4];
#pragma unroll
                for (int ks = 0; ks < 4; ++ks) { const f32x16& pp = (ks < 2) ? p0 : p1; const int b0 = 8 * (ks & 1); u32x4 w;
                    w.x = pg8::cvt_pk_bf16(pp[b0], pp[b0 + 1]); w.y = pg8::cvt_pk_bf16(pp[b0 + 2], pp[b0 + 3]); w.z = pg8::cvt_pk_bf16(pp[b0 + 4], pp[b0 + 5]); w.w = pg8::cvt_pk_bf16(pp[b0 + 6], pp[b0 + 7]);
                    if (BR == 1) { const unsigned msk = selbit ? 0xffffffffu : 0u; w.x &= msk; w.y &= msk; w.z &= msk; w.w &= msk; }
                    pa[ks] = __builtin_bit_cast(bf16x8, w); }
                bf16x8 vfr[2][4];
#define NSA_LDV(d_, slot_) do { _Pragma("unroll") for (int ks_ = 0; ks_ < 4; ++ks_) { \
                        const unsigned a0_ = off_b(16 * ks_ + 4 * hi + tq, 4 * (d_) + 2 * blk + (tp >> 1)) + 8 * (tp & 1); \
                        const unsigned a1_ = off_b(16 * ks_ + 8 + 4 * hi + tq, 4 * (d_) + 2 * blk + (tp >> 1)) + 8 * (tp & 1); \
                        const v4i16_t lo_ = __builtin_amdgcn_ds_read_tr16_b64_v4i16((LAS v4i16_t*)(vb + a0_)); \
                        const v4i16_t hv_ = __builtin_amdgcn_ds_read_tr16_b64_v4i16((LAS v4i16_t*)(vb + a1_)); \
                        vfr[slot_][ks_] = (bf16x8){lo_[0], lo_[1], lo_[2], lo_[3], hv_[0], hv_[1], hv_[2], hv_[3]}; } } while (0)
                NSA_LDV(0, 0);
                __builtin_amdgcn_sched_barrier(0);
#pragma unroll
                for (int d = 0; d < 4; ++d) {
                    if (d + 1 < 4) NSA_LDV(d + 1, (d + 1) & 1);
                    __builtin_amdgcn_sched_barrier(0);
#pragma unroll
                    for (int ks = 0; ks < 4; ++ks) o[d] = __builtin_amdgcn_mfma_f32_32x32x16_bf16(pa[ks], vfr[d & 1][ks], o[d], 0, 0, 0);
                    __builtin_amdgcn_sched_barrier(0);
                }
#undef NSA_LDV
            }
        }
        asm volatile("s_waitcnt vmcnt(0) lgkmcnt(0)" ::: "memory"); __builtin_amdgcn_s_barrier(); asm volatile("" ::: "memory");
    }
}

template <int BR>
__device__ __forceinline__ void run_tiles_stag(LAS unsigned char* lds, const bf16_t* Kb, const bf16_t* Vb, int ntiles, int first, int qt, const bf16x8 (&qf)[8], f32x16 (&o)[4], float& l_run,
                                               int t, unsigned selw0, unsigned selw1, unsigned selw2, unsigned selw3, int tid, int wave, int lane) {
    int wv_ = wave; asm volatile("" : "+s"(wv_)); const bool halfB = wv_ >= 4;
    LAS const int* TL = (LAS const int*)(lds + L_TL);
    const unsigned soff = (unsigned)((4 * wave + (lane >> 4)) * 128 + (((lane & 15) ^ (((lane >> 4) << 2) | (wave & 3))) * 8));
    auto tile_of = [&](int i) -> int { return (BR == 1) ? TL[i] : first + i; };
    auto stageK = [&](int tile, int buf) { const bf16_t* ks = Kb + (size_t)tile * 8192 + soff; LAS unsigned char* kd = lds + L_K0 + buf * 16384 + wave * 1024;
        __builtin_amdgcn_global_load_lds((const unsigned*)ks, (LAS unsigned*)kd, 16, 0, 0); __builtin_amdgcn_global_load_lds((const unsigned*)(ks + 4096), (LAS unsigned*)(kd + 8192), 16, 0, 0); };
    auto stageV = [&](int tile, int buf) { const bf16_t* vs = Vb + (size_t)tile * 8192 + soff; LAS unsigned char* vd = lds + L_V0 + buf * 16384 + wave * 1024;
        __builtin_amdgcn_global_load_lds((const unsigned*)vs, (LAS unsigned*)vd, 16, 0, 0); __builtin_amdgcn_global_load_lds((const unsigned*)(vs + 4096), (LAS unsigned*)(vd + 8192), 16, 0, 0); };
    if (ntiles <= 0) return;
    { const int t0_ = tile_of(0); stageK(t0_, 0); stageV(t0_, 0); }
    asm volatile("s_waitcnt vmcnt(0) lgkmcnt(0)" ::: "memory"); __builtin_amdgcn_s_barrier(); asm volatile("" ::: "memory");
    bf16x8 pa[4]; bool act = false;
#pragma unroll
    for (int ks = 0; ks < 4; ++ks) pa[ks] = (bf16x8){0, 0, 0, 0, 0, 0, 0, 0};
    auto qk_sm = [&](int tile, int buf) {
        bool selbit = true;
        if (BR == 1) { const unsigned w = (tile < 32) ? selw0 : (tile < 64) ? selw1 : (tile < 96) ? selw2 : selw3; selbit = (w >> (tile & 31)) & 1u; }
        act = (BR == 1) ? (bool)__any((int)selbit) : true;
        if (!act) return;
        int lv = lane; asm volatile("" : "+v"(lv));
        const int l32 = lv & 31, hi = lv >> 5; const unsigned kx = ((l32 & 3) << 2) | ((l32 >> 2) & 3);
        LAS const unsigned char* kb = lds + L_K0 + buf * 16384;
        const int kbase = tile * 64;
        const bool need_mask = (BR == 1) ? (tile == qt) : ((tile == qt) || (tile == first && qt >= 8));
        const float ps = (BR == 1) ? (selbit ? 1.f : 0.f) : 1.f;
        float sum = 0.f;
#pragma unroll
        for (int h2 = 0; h2 < 2; ++h2) {
            f32x16 pp;
#pragma unroll
            for (int r = 0; r < 16; ++r) pp[r] = 0.f;
            {
                bf16x8 kq[2];
#define NSA_LDK(s_, slot_) do { const unsigned ko_ = 256u * l32 + 16u * ((unsigned)(2 * (s_) + hi) ^ kx); kq[slot_] = *(LAS const bf16x8*)(kb + h2 * 8192 + ko_); } while (0)
                NSA_LDK(0, 0); NSA_LDK(1, 1);
                __builtin_amdgcn_sched_barrier(0);
#pragma unroll
                for (int s = 0; s < 8; s += 2) {
                    pp = __builtin_amdgcn_mfma_f32_32x32x16_bf16(kq[0], qf[s], pp, 0, 0, 0);
                    if (s + 2 < 8) NSA_LDK(s + 2, 0);
                    pp = __builtin_amdgcn_mfma_f32_32x32x16_bf16(kq[1], qf[s + 1], pp, 0, 0, 0);
                    if (s + 3 < 8) NSA_LDK(s + 3, 1);
                    __builtin_amdgcn_sched_barrier(0);
                }
#undef NSA_LDK
            }
            if (need_mask) {
#pragma unroll
                for (int r = 0; r < 16; ++r) { const int ki = kbase + 32 * h2 + crow(r, hi); bool v0;
                    if (BR == 1) v0 = (ki <= t); else v0 = (ki <= t) && (ki > t - 512);
                    pp[r] = v0 ? __builtin_amdgcn_exp2f(pp[r]) * ps : 0.f; }
            } else {
#pragma unroll
                for (int r = 0; r < 16; ++r) pp[r] = __builtin_amdgcn_exp2f(pp[r]) * ps;
            }
#pragma unroll
            for (int r = 0; r < 16; ++r) sum += pp[r];
#pragma unroll
            for (int kk = 0; kk < 2; ++kk) { const int b0 = 8 * kk; u32x4 w;
                w.x = pg8::cvt_pk_bf16(pp[b0], pp[b0 + 1]); w.y = pg8::cvt_pk_bf16(pp[b0 + 2], pp[b0 + 3]); w.z = pg8::cvt_pk_bf16(pp[b0 + 4], pp[b0 + 5]); w.w = pg8::cvt_pk_bf16(pp[b0 + 6], pp[b0 + 7]);
                pa[2 * h2 + kk] = __builtin_bit_cast(bf16x8, w); }
        }
        l_run += sum;
    };
    auto pv = [&](int buf) {
        int lv = lane; asm volatile("" : "+v"(lv));
        const int hi = lv >> 5, blk = (lv >> 4) & 1, tq = (lv & 15) >> 2, tp = lv & 3;
        LAS const unsigned char* vb = lds + L_V0 + buf * 16384;
        bf16x8 vfr[3];
#define NSA_LDV(j_, slot_) do { const int d_ = (j_) >> 2, ks_ = (j_) & 3; \
                const unsigned a0_ = off_b(16 * ks_ + 4 * hi + tq, 4 * d_ + 2 * blk + (tp >> 1)) + 8 * (tp & 1); \
                const unsigned a1_ = off_b(16 * ks_ + 8 + 4 * hi + tq, 4 * d_ + 2 * blk + (tp >> 1)) + 8 * (tp & 1); \
                const v4i16_t lo_ = __builtin_amdgcn_ds_read_tr16_b64_v4i16((LAS v4i16_t*)(vb + a0_)); \
                const v4i16_t hv_ = __builtin_amdgcn_ds_read_tr16_b64_v4i16((LAS v4i16_t*)(vb + a1_)); \
                vfr[slot_] = (bf16x8){lo_[0], lo_[1], lo_[2], lo_[3], hv_[0], hv_[1], hv_[2], hv_[3]}; } while (0)
        NSA_LDV(0, 0); NSA_LDV(1, 1);
        __builtin_amdgcn_sched_barrier(0);
#pragma unroll
        for (int j = 0; j < 16; ++j) {
            if (j + 2 < 16) NSA_LDV(j + 2, (j + 2) % 3);
            __builtin_amdgcn_sched_barrier(0);
            o[j >> 2] = __builtin_amdgcn_mfma_f32_32x32x16_bf16(pa[j & 3], vfr[j % 3], o[j >> 2], 0, 0, 0);
            __builtin_amdgcn_sched_barrier(0);
        }
#undef NSA_LDV
    };
#define NSA_SLOT_END() do { asm volatile("s_waitcnt vmcnt(0) lgkmcnt(0)" ::: "memory"); __builtin_amdgcn_s_barrier(); asm volatile("" ::: "memory"); } while (0)
    const int hsel = halfB ? 1 : 0;
    for (int sl = 0; sl <= 2 * ntiles; ++sl) {
        const int inext = (sl >> 1) + 1;
        const bool staged = inext < ntiles;
        if (staged) { const int tn = tile_of(inext); if (sl & 1) stageV(tn, inext & 1); else stageK(tn, inext & 1); }
        if ((sl & 1) == hsel) { const int i = (sl - hsel) >> 1; if (i < ntiles) qk_sm(tile_of(i), i & 1); }
        else { const int i = (sl - 1 - hsel) >> 1; if (sl - 1 - hsel >= 0 && i < ntiles && act) pv(i & 1); }
        if (staged) asm volatile("s_waitcnt vmcnt(2) lgkmcnt(0)" ::: "memory"); else asm volatile("s_waitcnt vmcnt(0) lgkmcnt(0)" ::: "memory");
        __builtin_amdgcn_s_barrier(); asm volatile("" ::: "memory");
    }
#undef NSA_SLOT_END
}

template <bool FIRST>
__device__ __forceinline__ void flush(f32x16 (&o)[4], float fac, bf16_t* Obase, LAS float* wsf, int l32, int hi) {
    if (hi == 0) wsf[l32] = fac;
    LDS_WAIT(); asm volatile("" ::: "memory");
    bf16_t* pa = Obase + (size_t)hi * DM + l32;
    unsigned short old[4][16];
    if (!FIRST) {
        bf16_t* pl = pa;
#pragma unroll
        for (int a = 0; a < 4; ++a) {
            asm volatile("" : "+v"(pl));
#pragma unroll
            for (int i2 = 0; i2 < 4; ++i2)
#pragma unroll
                for (int d = 0; d < 4; ++d) old[a][i2 * 4 + d] = pl[i2 * 128 + 32 * d];
            pl += 2 * DM; }
        asm volatile("" ::: "memory");
    }
#pragma unroll
    for (int a = 0; a < 4; ++a) { const f32x4 f = *(LAS const f32x4*)(wsf + 8 * a + 4 * hi);
        asm volatile("" : "+v"(pa));
#pragma unroll
        for (int i2 = 0; i2 < 4; ++i2)
#pragma unroll
            for (int d = 0; d < 4; ++d) { bf16_t* op = pa + i2 * 128 + 32 * d; float v = o[d][4 * a + i2] * f[i2]; if (!FIRST) v += bf2f(old[a][i2 * 4 + d]); *op = (bf16_t)f2bf(v); o[d][4 * a + i2] = 0.f; }
        pa += 2 * DM; }
    LDS_WAIT(); asm volatile("" ::: "memory");
}

__device__ __forceinline__ void unit(LAS unsigned char* lds, const bf16_t* KVH, const bf16_t* QH, const bf16_t* KCMP, const float* GATES, bf16_t* O, int b, int g, int qt, int tid, int wave, int lane) {
    asm volatile("" : "+v"(tid)); lane = tid & 63; wave = __builtin_amdgcn_readfirstlane(tid >> 6);
    const int l32 = lane & 31, hi = lane >> 5, tokl = l32 >> 2, rr = l32 & 3;
    const int t0 = qt * 64, t = t0 + wave * 8 + tokl;
    const size_t bg = (size_t)b * 4 + g;
    LAS float* impw = (LAS float*)(lds + L_IMP + wave * IMP_WAVE);
    LAS unsigned* selm = (LAS unsigned*)(lds + L_SELM + wave * 128);
    LAS unsigned* uni = (LAS unsigned*)(lds + L_UNI);
    LAS int* NTL = (LAS int*)(lds + L_NTL); LAS int* TL = (LAS int*)(lds + L_TL);
    LAS float* wsf = (LAS float*)(lds + L_WSF + wave * 128);
    for (int i = lane; i < 8 * IMP_LD; i += 64) impw[i] = 0.f;
    if (tid < 4) uni[tid] = 0u;
    bf16x8 qf[8];
    { const bf16_t* qp = QH + ((bg * 8192 + t0 + wave * 8) * 4 + l32) * 128 + 8 * hi;
#pragma unroll
      for (int s = 0; s < 8; ++s) qf[s] = *(const bf16x8*)(qp + 16 * s); }
    const float* gp = GATES + ((size_t)b * 8192 + t) * 48 + (g * 4 + rr) * 3;
    const float g_cmp = gp[0], g_slc = gp[1], g_win = gp[2];
    bf16_t* Obase = O + ((size_t)b * 8192 + t0 + wave * 8) * DM + g * 512;
    f32x16 o[4];
#pragma unroll
    for (int d = 0; d < 4; ++d)
#pragma unroll
        for (int r = 0; r < 16; ++r) o[d][r] = 0.f;
    LDS_WAIT(); __builtin_amdgcn_s_barrier(); asm volatile("" ::: "memory");
    const bf16_t* Kc = KCMP + bg * 512 * 128; const bf16_t* Vc = KCMP + (size_t)4096 * 128 + bg * 512 * 128;
    const int ntc = ((4 * qt + 2) >> 6) + 1;
    { float l = 0.f;
      run_tiles<0, 0>(lds, Kc, Vc, ntc, 0, qt, qf, o, l, t, 0u, 0u, 0u, 0u, 1.f, 1.f, tid, wave, lane);
      const float ltot = l + xhalf(l); const float inv = ltot > 0.f ? 1.f / ltot : 0.f;
      run_tiles<0, 1>(lds, Kc, Vc, ntc, 0, qt, qf, o, l, t, 0u, 0u, 0u, 0u, inv, g_cmp, tid, wave, lane); }
    flush<true>(o, 1.f, Obase, wsf, l32, hi);
    {
        const int tk = lane >> 3, j = lane & 7; const int nvalid = qt + 1;
        unsigned m0 = 0u, m1 = 0u, m2 = 0u, m3 = 0u;
        auto setbit = [&](int s) { const unsigned bit = 1u << (s & 31); const int w = s >> 5; m0 |= (w == 0) ? bit : 0u; m1 |= (w == 1) ? bit : 0u; m2 |= (w == 2) ? bit : 0u; m3 |= (w == 3) ? bit : 0u; };
        if (nvalid <= 16) { for (int s2 = 0; s2 < nvalid; ++s2) setbit(s2); }
        else {
            setbit(0); setbit(qt); setbit(qt - 1);
            unsigned key[16];
#pragma unroll
            for (int i = 0; i < 16; ++i) { const int s2 = 16 * j + i; const float v = impw[tk * IMP_LD + s2];
                const bool cand = (s2 < nvalid) && (s2 != 0) && (s2 != qt) && (s2 != qt - 1);
                key[i] = cand ? ((__float_as_uint(fmaxf(v, 0.f)) & ~0x7Fu) + (unsigned)(128 - s2)) : 0u; }
            for (int round = 0; round < 13; ++round) {
                unsigned mx = key[0];
#pragma unroll
                for (int i = 1; i < 16; ++i) mx = mx > key[i] ? mx : key[i];
                unsigned o1 = (unsigned)my_shfl_xor((int)mx, 1); mx = mx > o1 ? mx : o1;
                o1 = (unsigned)my_shfl_xor((int)mx, 2); mx = mx > o1 ? mx : o1;
                o1 = (unsigned)my_shfl_xor((int)mx, 4); mx = mx > o1 ? mx : o1;
                if (mx != 0u) { const int sw = (128 - (int)(mx & 0x7Fu)) & 127; setbit(sw); }
#pragma unroll
                for (int i = 0; i < 16; ++i) key[i] = (key[i] == mx) ? 0u : key[i];
            }
        }
        if (j == 0) { selm[tk * 4 + 0] = m0; selm[tk * 4 + 1] = m1; selm[tk * 4 + 2] = m2; selm[tk * 4 + 3] = m3;
            atomicOr((unsigned*)(uni + 0), m0); atomicOr((unsigned*)(uni + 1), m1); atomicOr((unsigned*)(uni + 2), m2); atomicOr((unsigned*)(uni + 3), m3); }
    }
    LDS_WAIT(); __builtin_amdgcn_s_barrier(); asm volatile("" ::: "memory");
    if (tid == 0) { int n = 0; for (int w = 0; w < 4; ++w) { unsigned u = uni[w]; while (u) { const int bpos = __builtin_ctz(u); u &= u - 1; TL[n++] = 32 * w + bpos; } } NTL[0] = n; }
    LDS_WAIT(); __builtin_amdgcn_s_barrier(); asm volatile("" ::: "memory");
    const unsigned sw0 = selm[tokl * 4 + 0], sw1 = selm[tokl * 4 + 1], sw2 = selm[tokl * 4 + 2], sw3 = selm[tokl * 4 + 3];
    const int nsel = __builtin_amdgcn_readfirstlane(NTL[0]);
    { const bf16_t* Ks = KVH + 2 * KVH_SLOT + bg * 8192 * 128; const bf16_t* Vs = KVH + 3 * KVH_SLOT + bg * 8192 * 128;
      float l = 0.f;
      run_tiles<1, 2>(lds, Ks, Vs, nsel, 0, qt, qf, o, l, t, sw0, sw1, sw2, sw3, 1.f, 1.f, tid, wave, lane);
      const float ltot = l + xhalf(l);
      flush<false>(o, ltot > 0.f ? g_slc / ltot : 0.f, Obase, wsf, l32, hi); }
    { const bf16_t* Kw = KVH + 4 * KVH_SLOT + bg * 8192 * 128; const bf16_t* Vw = KVH + 5 * KVH_SLOT + bg * 8192 * 128;
      const int first = qt >= 8 ? qt - 8 : 0; float l = 0.f;
      run_tiles<2, 2>(lds, Kw, Vw, qt - first + 1, first, qt, qf, o, l, t, 0u, 0u, 0u, 0u, 1.f, 1.f, tid, wave, lane);
      const float ltot = l + xhalf(l);
      flush<false>(o, ltot > 0.f ? g_win / ltot : 0.f, Obase, wsf, l32, hi); }
    LDS_WAIT(); __builtin_amdgcn_s_barrier(); asm volatile("" ::: "memory");
}
}


constexpr size_t WS_CTL = WS_MISC + 63 * MiB; constexpr size_t CTL_ZERO_BYTES = 16384;
#define XB_TMO      128
#define XB_XCNT(j)  (256  + 64 * (j))
#define XB_XSUB(j)  (1280 + 64 * (j))
#define XB_XGEN(j)  (2304 + 64 * (j))
#define XB_TOP      3328
#define XB_TOPGEN   3392
#define XB_SPIN_CAP (1u << 18)
__device__ __forceinline__ unsigned xb_ld(unsigned* p)              { return __hip_atomic_load(p, __ATOMIC_RELAXED, __HIP_MEMORY_SCOPE_AGENT); }
__device__ __forceinline__ unsigned xb_add(unsigned* p, unsigned v) { return __hip_atomic_fetch_add(p, v, __ATOMIC_RELAXED, __HIP_MEMORY_SCOPE_AGENT); }
__device__ __forceinline__ unsigned xb_xcc_id() { return (unsigned)__builtin_amdgcn_s_getreg((3 << 11) | 20) & 0xFu; }
#define XB_SPIN(cond, bar) do { unsigned _sp = 0; while (cond) { __builtin_amdgcn_s_sleep(1); \
    if ((++_sp & 255u) == 0u) { if (xb_ld(&(bar)[XB_TMO])) break; if (_sp > XB_SPIN_CAP) { atomicAdd(&(bar)[XB_TMO], 1u); break; } } } } while (0)
struct XcdBarrier { unsigned* bar; unsigned x; volatile LAS unsigned* st; };
__device__ __forceinline__ XcdBarrier xcd_barrier_post(unsigned* bar, volatile LAS unsigned* st, bool t0) {
    XcdBarrier b; b.bar = bar; b.x = xb_xcc_id(); b.st = st;
    if (t0) (void)xb_add(&bar[XB_XCNT(b.x)], 1u);
    return b;
}
__device__ __forceinline__ void xcd_barrier_complete(unsigned* bar, unsigned x, unsigned& nloc, unsigned& nx) {
    const unsigned G = gridDim.x * gridDim.y * gridDim.z;
    unsigned sum, cnt, mine, sp = 0u;
    for (;;) {
        sum = 0u; cnt = 0u; mine = 0u;
#pragma unroll
        for (unsigned j = 0; j < 16; ++j) { const unsigned c = xb_ld(&bar[XB_XCNT(j)]); sum += c; cnt += (c > 0u) ? 1u : 0u; mine = (j == x) ? c : mine; }
        if (sum == G) break;
        __builtin_amdgcn_s_sleep(1);
        if ((++sp & 255u) == 0u) { if (xb_ld(&bar[XB_TMO])) break; if (sp > XB_SPIN_CAP) { atomicAdd(&bar[XB_TMO], 1u); break; } }
    }
    nloc = mine > 0u ? mine : 1u; nx = cnt > 0u ? cnt : 1u;
}
__device__ __forceinline__ void xcd_barrier(const XcdBarrier& b, bool t0) {
    asm volatile("s_waitcnt vmcnt(0)" ::: "memory");
    __syncthreads();
    if (t0) {
        unsigned* bar = b.bar;
        __builtin_amdgcn_s_waitcnt(0);
        unsigned nloc = b.st[0], nx = b.st[1];
        if (nloc == 0u) { xcd_barrier_complete(bar, b.x, nloc, nx); b.st[0] = nloc; b.st[1] = nx; }
        const unsigned old = xb_add(&bar[XB_XSUB(b.x)], 1u);
        const unsigned gen = old / nloc;
        if (old + 1u == (gen + 1u) * nloc) {
            __builtin_amdgcn_fence(__ATOMIC_RELEASE, "agent");
            asm volatile("s_waitcnt vmcnt(0)" ::: "memory");
            const unsigned og = xb_add(&bar[XB_TOP], 1u);
            const unsigned tg = og / nx;
            if (og + 1u == (tg + 1u) * nx) xb_add(&bar[XB_TOPGEN], 1u);
            else XB_SPIN(xb_ld(&bar[XB_TOPGEN]) == tg, bar);
            __builtin_amdgcn_fence(__ATOMIC_ACQUIRE, "agent");
            xb_add(&bar[XB_XGEN(b.x)], 1u);
            asm volatile("s_waitcnt vmcnt(0)" ::: "memory");
        } else {
            XB_SPIN(xb_ld(&bar[XB_XGEN(b.x)]) == gen, bar);
            __builtin_amdgcn_fence(__ATOMIC_ACQUIRE, "agent");
            asm volatile("s_waitcnt vmcnt(0)" ::: "memory");
        }
    }
    __syncthreads();
}

__global__ void __launch_bounds__(NTHREADS, 2) fwd_kernel(Args args) {
    extern __shared__ __attribute__((aligned(16))) unsigned char lds_raw[];
    LAS unsigned char* lds = (LAS unsigned char*)lds_raw;
    cg::grid_group grid = cg::this_grid();
    const int G = gridDim.x;
    const int NGW = G * NWAVES, gthreads = G * NTHREADS;
#define bid ({ int b_ = (int)blockIdx.x; asm volatile("" : "+s"(b_)); b_; })
    const int wave0 = __builtin_amdgcn_readfirstlane((int)threadIdx.x >> 6);
#define lane ({ int l_; asm volatile("v_mbcnt_lo_u32_b32 %0, -1, 0\n\tv_mbcnt_hi_u32_b32 %0, -1, %0" : "=v"(l_)); l_; })
#define wave wave0
#define tid (wave0 * 64 + lane)
#define gw (bid * NWAVES + wave)
#define gtid (bid * NTHREADS + tid)
#define ws ((unsigned char*)argp(30))
#define XF ((float*)argp(29))
#define XB ((bf16_t*)(ws + WS_XB))
#define HID ((bf16_t*)(ws + OV_HID))
#define ln_g INP(I_LNG)
#define ln_b INP(I_LNB)
#define T1 ((bf16_t*)(ws + OV_T1))
#define T2 ((bf16_t*)(ws + OV_T2))
#define T3 ((bf16_t*)(ws + OV_T3))
#define STP ((f32x2*)(ws + MS_STATS))
#define GSYNC_CG() do { asm volatile("s_waitcnt vmcnt(0) lgkmcnt(0)" ::: "memory"); grid.sync(); asm volatile("s_waitcnt vmcnt(0) lgkmcnt(0)" ::: "memory"); __builtin_amdgcn_s_barrier(); asm volatile("" ::: "memory"); } while (0)
#define GSYNC() do { asm volatile("s_waitcnt vmcnt(0) lgkmcnt(0)" ::: "memory"); XcdBarrier xb_; xb_.bar = (unsigned*)(ws + WS_CTL); xb_.x = xb_xcc_id(); xb_.st = (volatile LAS unsigned*)(lds + LDS_BYTES - 64); xcd_barrier(xb_, tid == 0); asm volatile("" ::: "memory"); } while (0)
    volatile LAS unsigned* xst = (volatile LAS unsigned*)(lds + LDS_BYTES - 64);
    if (tid == 0) { xst[0] = 0u; xst[1] = 0u; }
    __syncthreads();
    (void)xcd_barrier_post((unsigned*)(ws + WS_CTL), xst, tid == 0);

    {
        LAS float* scr = (LAS float*)(lds + wave * 16384);
        conv_matrix<0>(INP(I_S5_WIN), 2048, 2048, 2048, (bf16_t*)(ws + WS_WIN), 2048, 0, scr, gw, NGW, lane);
        conv_matrix<1>(INP(I_S5_WGLU), 2048, 4096, 4096, (bf16_t*)(ws + WS_WGLU), 2048, 0, scr, gw, NGW, lane);
        conv_matrix<0>(INP(I_S5_WOUT), 2048, 2048, 2048, (bf16_t*)(ws + WS_WOUT), 2048, 0, scr, gw, NGW, lane);
        conv_matrix<0>(INP(I_KVW), 2048, 3072, 3072, (bf16_t*)(ws + WS_WKVQ), 2048, 0, scr, gw, NGW, lane);
        conv_matrix<0>(INP(I_WQG), 2048, 2096, 2048, (bf16_t*)(ws + WS_WKVQ), 2048, 3072, scr, gw, NGW, lane);
        conv_matrix<0>(INP(I_WQG) + 2048, 2048, 2096, 48, (bf16_t*)(ws + WS_WKVQ), 2048, 5120, scr, gw, NGW, lane);
        conv_matrix<0>(INP(I_WNO), 2048, 2048, 2048, (bf16_t*)(ws + WS_WNO), 2048, 0, scr, gw, NGW, lane);
        for (int l = 0; l < 2; ++l) {
            cvt_rows(INP(I_MWQ) + (size_t)l * 2048 * 2048, (bf16_t*)(ws + WS_WMQ + l * 8 * MiB), (size_t)2048 * 2048, gtid, gthreads);
            conv_matrix<0>(INP(I_MWKV) + (size_t)l * 2048 * 4096, 2048, 4096, 4096, (bf16_t*)(ws + WS_WMKV + l * 16 * MiB), 2048, 0, scr, gw, NGW, lane);
            conv_matrix<0>(INP(I_MWO) + (size_t)l * 2048 * 2048, 2048, 2048, 2048, (bf16_t*)(ws + WS_WMO + l * 8 * MiB), 2048, 0, scr, gw, NGW, lane);
            conv_matrix<0>(INP(I_WUP) + (size_t)l * 2048 * 8192, 2048, 8192, 8192, (bf16_t*)(ws + WS_WUP + l * 32 * MiB), 2048, 0, scr, gw, NGW, lane);
            conv_matrix<0>(INP(I_WDN) + (size_t)l * 8192 * 2048, 8192, 2048, 2048, (bf16_t*)(ws + WS_WDN + l * 32 * MiB), 8192, 0, scr, gw, NGW, lane);
        }
        cvt_rows(INP(I_X), XB, (size_t)MTOK * DM, gtid, gthreads);
        cvt_rows(INP(I_MEM), (bf16_t*)(ws + MS_MEMB), (size_t)512 * DM, gtid, gthreads);
        for (int q = 0; q < 4; ++q) { const int which = q >> 1, half = q & 1;
            conv_matrix<0>((which ? INP(I_CW1V) : INP(I_CW1K)) + (size_t)half * 2048 * 128, 2048, 128, 128, (bf16_t*)(ws + WS_WC1 + which * MiB), 2048, 128 * half, scr, gw, NGW, lane); }
        if (bid == G - 1) cmp_bias(INP(I_CPK), INP(I_CW1K), INP(I_CPV), INP(I_CW1V), (float*)(ws + MS_CB), tid);
        s5_tables(INP(I_S5_ARE), INP(I_S5_AIM), INP(I_S5_LOGDT), INP(I_S5_BRE), INP(I_S5_BIM), INP(I_S5_CRE), INP(I_S5_CIM), ws, gtid, gthreads);
    }
    GSYNC_CG();
    for (int layer = 0; layer < 2; ++layer) {

        if (layer == 0) {
            { pg8::Gemm g{XB, (const bf16_t*)(ws + WS_WIN), DM, DM, DM}; pg8::StaticOrder S; S.init(MTOK, DM, DM, DM, G, bid);
              pg8::EpiCols8<StoreBf16> E{StoreBf16{T1, DM, 1.f}}; pg8::gemm_phase(lds, g, S, E, wave0); }
            { pg8::Gemm g{(const bf16_t*)(ws + MS_MEMB), (const bf16_t*)(ws + WS_WMKV), DM, DM, DM}; KvSched S{G, bid};
              pg8::EpiCols8<StoreBf16Z> E{StoreBf16Z{(bf16_t*)(ws + MS_MKV), 4096, 1.f, (size_t)512 * 4096}}; pg8::gemm_phase(lds, g, S, E, wave0); }
            GSYNC();
            s5_pass<false>(T1, T2, INP(I_S5_D), ws, lds, gw, NGW, wave, lane);
            GSYNC();
            s5_pass<true>(T1, T2, INP(I_S5_D), ws, lds, gw, NGW, wave, lane);
            GSYNC();
            { pg8::Gemm g{T2, (const bf16_t*)(ws + WS_WGLU), DM, DM, DM}; pg8::StaticOrder S; S.init(MTOK, 2 * DM, DM, DM, G, bid);
              EpiGlu E{T1, DM}; pg8::gemm_phase(lds, g, S, E, wave0); }
            { pg8::Gemm g{(const bf16_t*)(ws + MS_MKV), (const bf16_t*)(ws + WS_WMQ), 4096, 2048, 512}; MtSched S{G, bid};
              pg8::EpiCols8<StoreBf16Z> E{StoreBf16Z{(bf16_t*)(ws + WS_MT), 2048, 0.044194173824159216f * 1.4426950408889634f, (size_t)1024 * 2048}}; pg8::gemm_phase(lds, g, S, E, wave0); }
            { pg8::Gemm g{(const bf16_t*)(ws + WS_WMO), (const bf16_t*)(ws + MS_MKV), 2048, 4096, 512}; VwSched S{G, (G == 256) ? ((bid + 128) & 255) : bid};
              pg8::EpiCols8<StoreBf16Z> E{StoreBf16Z{(bf16_t*)(ws + WS_VWT), 1024, 1.f, (size_t)2048 * 1024}}; pg8::gemm_phase(lds, g, S, E, wave0); }
            GSYNC();
            { pg8::Gemm g{T1, (const bf16_t*)(ws + WS_WOUT), DM, DM, DM}; pg8::StaticOrder S; S.init(MTOK, DM, DM, DM, G, bid);
              pg8::EpiRes<0> E{INP(I_X), XF, nullptr, nullptr, nullptr, DM, DN_ALPHA}; pg8::gemm_phase(lds, g, S, E, wave0); }
            GSYNC();
            ln_phase<false>(XF, 1.f, XF, XB, STP, ln_g + (layer * 3 + 0) * DM, ln_b + (layer * 3 + 0) * DM, gw, NGW, lane);
        } else {
            { pg8::Gemm g{XB, (const bf16_t*)(ws + WS_WKVQ), DM, DM, DM}; pg8::StaticOrder S; S.init(MTOK, 5376, DM, DM, G, bid);
              pg8::EpiCols8<StoreKVQ> E{StoreKVQ{(bf16_t*)(ws + OV_KVH), (bf16_t*)(ws + OV_QH), (float*)(ws + MS_GATES), 0.08838834764831845f * 1.4426950408889634f}}; pg8::gemm_phase(lds, g, S, E, wave0); }
            GSYNC();
            { pg8::Gemm g{(const bf16_t*)(ws + OV_KVH), (const bf16_t*)(ws + WS_WC1), 2048, 2048, 512}; CmpSched S{G, bid};
              pg8::EpiCols8<StoreF32> E{StoreF32{(float*)(ws + MS_PAB), 256, (size_t)4096 * 256}}; pg8::gemm_phase(lds, g, S, E, wave0); }
            GSYNC();
            cmp_combine((const float*)(ws + MS_PAB), (const float*)(ws + MS_CB), INP(I_CW2K), INP(I_CW2V), (bf16_t*)(ws + MS_KCMP), gw, NGW, lane);
            GSYNC();
            for (int vb = bid; vb < 256; vb += G) {
                const int bgi = vb >> 5, sidx = vb & 31;
                for (int i = 0; i < 4; ++i) { const int qt = (i == 0) ? sidx : (i == 1) ? 63 - sidx : (i == 2) ? 64 + sidx : 127 - sidx;
                    nsa::unit(lds, (const bf16_t*)(ws + OV_KVH), (const bf16_t*)(ws + OV_QH), (const bf16_t*)(ws + MS_KCMP), (const float*)(ws + MS_GATES), T1, bgi >> 2, bgi & 3, qt, tid, wave, lane); }
            }
            GSYNC();
            { pg8::Gemm g{T1, (const bf16_t*)(ws + WS_WNO), DM, DM, DM}; pg8::StaticOrder S; S.init(MTOK, DM, DM, DM, G, bid);
              pg8::EpiRes<1> E{XF, XF, STP, ln_g + 2 * DM, ln_b + 2 * DM, DM, DN_ALPHA}; pg8::gemm_phase(lds, g, S, E, wave0); }
            GSYNC();
            ln_phase<false>(XF, 1.f, XF, XB, STP, ln_g + (layer * 3 + 0) * DM, ln_b + (layer * 3 + 0) * DM, gw, NGW, lane);
        }
        GSYNC();
        for (int base = 0; base < 256; base += G) {
            pg8::Gemm g{XB, (const bf16_t*)(ws + WS_MT), DM, DM, DM}; ScoreSched S{G, bid, base, (base + G < 256) ? base + G : 256, layer};
            EpiSoftmax E{T2}; pg8::gemm_phase(lds, g, S, E, wave0);
        }
        GSYNC();
        { pg8::Gemm g{T2, (const bf16_t*)(ws + WS_VWT), 1024, 1024, 1024}; PvoSched S; S.so.init(MTOK, DM, 1024, 1024, G, bid); S.layer = layer;
          pg8::EpiRes<1> E{XF, XF, STP, ln_g + (layer * 3 + 0) * DM, ln_b + (layer * 3 + 0) * DM, DM, DN_ALPHA}; pg8::gemm_phase(lds, g, S, E, wave0); }
        GSYNC();
        ln_phase<false>(XF, 1.f, XF, XB, STP, ln_g + (layer * 3 + 1) * DM, ln_b + (layer * 3 + 1) * DM, gw, NGW, lane);
        GSYNC();
        {
            pg8::Gemm g{XB, (const bf16_t*)(ws + WS_WUP + layer * 32 * MiB), DM, DM, DM};
            pg8::StaticOrder S; S.init(MTOK, DFF, DM, DM, G, bid);
            pg8::EpiCols8<StoreRelu2> E{StoreRelu2{HID, DFF}};
            pg8::gemm_phase(lds, g, S, E, wave0);
        }
        GSYNC();
        {
            pg8::Gemm g{HID, (const bf16_t*)(ws + WS_WDN + layer * 32 * MiB), DFF, DFF, DFF};
            pg8::StaticOrder S; S.init(MTOK, DM, DFF, DFF, G, bid);
            pg8::EpiRes<1> E{XF, XF, STP, ln_g + (layer * 3 + 1) * DM, ln_b + (layer * 3 + 1) * DM, DM, DN_ALPHA};
            pg8::gemm_phase(lds, g, S, E, wave0);
        }
        GSYNC();
        if (layer == 1) ln_phase<true>(XF, 1.f, XF, XB, STP, ln_g + (layer * 3 + 2) * DM, ln_b + (layer * 3 + 2) * DM, gw, NGW, lane);
        else ln_phase<false>(XF, 1.f, XF, XB, STP, ln_g + (layer * 3 + 2) * DM, ln_b + (layer * 3 + 2) * DM, gw, NGW, lane);
        if (layer == 0) GSYNC();
    }
}

#undef ws
#undef XF
#undef XB
#undef HID
#undef ln_g
#undef ln_b
#undef T1
#undef T2
#undef T3
#undef STP
#undef bid
#undef tid
#undef lane
#undef wave
#undef gw
#undef gtid
extern "C" void kernel_launch(void* const* d_in, const int* in_sizes, int n_in, void* d_out, int out_size, void* d_ws, size_t ws_size, hipStream_t stream) {
    static int grid = 0;
    if (grid == 0) {
        if (n_in != 29 || ws_size < WS_END) { fprintf(stderr, "kernel_launch: unexpected n_in %d or ws %zu (< %zu)\n", n_in, ws_size, (size_t)WS_END); grid = -1; return; }
        int dev = 0, cus = 0, per_cu = 0;
        hipGetDevice(&dev); hipDeviceGetAttribute(&cus, hipDeviceAttributeMultiprocessorCount, dev);
        hipFuncSetAttribute((const void*)fwd_kernel, hipFuncAttributeMaxDynamicSharedMemorySize, LDS_BYTES);
        hipOccupancyMaxActiveBlocksPerMultiprocessor(&per_cu, (const void*)fwd_kernel, NTHREADS, LDS_BYTES);
        if (per_cu < 1) { fprintf(stderr, "kernel_launch: occupancy query says %d blocks/CU\n", per_cu); per_cu = 1; }
        (void)hipGetLastError();
        grid = cus;
    }
    if (grid < 0) return;
    if (hipMemsetAsync((char*)d_ws + WS_CTL, 0, CTL_ZERO_BYTES, stream) != hipSuccess) { fprintf(stderr, "kernel_launch: memset of the barrier words failed\n"); return; }
    Args a{};
    for (int i = 0; i < 29; ++i) a.in[i] = (const float*)d_in[i];
    a.out = (float*)d_out; a.ws = (unsigned char*)d_ws; a.ph_lo = 0; a.ph_hi = 100;
    void* kargs[] = {&a};
    hipError_t e = hipLaunchCooperativeKernel((const void*)fwd_kernel, dim3(grid), dim3(NTHREADS), kargs, LDS_BYTES, stream);
    if (e != hipSuccess) fprintf(stderr, "cooperative launch failed: %s (grid %d)\n", hipGetErrorString(e), grid);
}
```
